# Optimizing an MI355X kernel written in HIP

```python
import math
import jax, jax.numpy as jnp
from jax import lax
import numpy as np

D_MODEL = 1024
BATCH = 8
SEQ = 4096
DEPTH = 4

MIX_WIDTH = D_MODEL
N_MIXERS = 4
GROUP_WIDTH = MIX_WIDTH // N_MIXERS
ATT_HEADS = 4
ATT_VDIM = GROUP_WIDTH // ATT_HEADS
ATT_QK = ATT_VDIM // 2
Q_BLOCK = 128
CONV_WIDTH = 31
CONV_GROUPS = 4
FNET_GROUPS = 4
SGU_CHUNK = 128
SGU_GROUPS = 4
D_FF = 4 * D_MODEL
EPS = 1e-6
A_COLS = 3 * GROUP_WIDTH
B_COLS = 2 * GROUP_WIDTH
C_COLS = GROUP_WIDTH
D_COLS = 2 * GROUP_WIDTH
IN_COLS = A_COLS + B_COLS + C_COLS + D_COLS

kernel_name = "hybrid_parallel_mixer_encoder"


def _rmsnorm(x, g):
    xf = x.astype(jnp.float32)
    y = xf * lax.rsqrt(jnp.mean(xf * xf, axis=-1, keepdims=True) + EPS)
    return (y * g.astype(jnp.float32)).astype(x.dtype)


def _layernorm(x, g, b):
    xf = x.astype(jnp.float32)
    mu = jnp.mean(xf, axis=-1, keepdims=True)
    xc = xf - mu
    var = jnp.mean(xc * xc, axis=-1, keepdims=True)
    y = xc * lax.rsqrt(var + EPS) * g.astype(jnp.float32) + b.astype(jnp.float32)
    return y.astype(x.dtype)


def _alibi_slopes(n):
    return jnp.asarray([2.0 ** (-8.0 * (i + 1) / n) for i in range(n)], dtype=jnp.float32)


def _diff_attention(q, k, v, lam, lam_init, subln_g):
    bsz, seq = q.shape[0], q.shape[1]
    nb = seq // Q_BLOCK
    scale = ATT_QK ** -0.5
    slopes = _alibi_slopes(ATT_HEADS)
    kpos = jnp.arange(seq, dtype=jnp.float32)
    qb = q.reshape(bsz, nb, Q_BLOCK, ATT_HEADS, 2, ATT_QK).transpose(1, 0, 2, 3, 4, 5)

    def block(args):
        q_blk, i = args
        qpos = (i * Q_BLOCK + jnp.arange(Q_BLOCK)).astype(jnp.float32)
        bias = -slopes[:, None, None] * jnp.abs(qpos[:, None] - kpos[None, :])
        s = jnp.einsum('bqhmd,bkhmd->bhmqk', q_blk, k,
                       preferred_element_type=jnp.float32) * scale + bias[None, :, None]
        p = jax.nn.softmax(s, axis=-1)
        w = p[:, :, 0] - lam * p[:, :, 1]
        return jnp.einsum('bhqk,bkhe->bqhe', w.astype(v.dtype), v)

    o = lax.map(block, (qb, jnp.arange(nb)))
    o = o.transpose(1, 0, 2, 3, 4).reshape(bsz, seq, ATT_HEADS, ATT_VDIM)
    o = _rmsnorm(o, subln_g) * (1.0 - lam_init)
    return o.reshape(bsz, seq, GROUP_WIDTH)


def _conformer_conv(h, dw_w, dw_b, ln_g, ln_b, pw_w, pw_b):
    a, g = jnp.split(h, 2, axis=-1)
    z = a * jax.nn.sigmoid(g)
    z = lax.conv_general_dilated(
        z, dw_w[:, None, :], window_strides=(1,),
        padding=[(CONV_WIDTH // 2, CONV_WIDTH // 2)],
        dimension_numbers=('NWC', 'WIO', 'NWC'),
        feature_group_count=GROUP_WIDTH) + dw_b
    zg = z.reshape(z.shape[0], z.shape[1], CONV_GROUPS, GROUP_WIDTH // CONV_GROUPS)
    zg = _layernorm(zg, ln_g.reshape(CONV_GROUPS, -1), ln_b.reshape(CONV_GROUPS, -1))
    z = jax.nn.silu(zg.reshape(z.shape))
    return z @ pw_w + pw_b


def _fourier_mix(c, w, b):
    bsz, seq = c.shape[0], c.shape[1]
    cg = c.reshape(bsz, seq, FNET_GROUPS, GROUP_WIDTH // FNET_GROUPS).astype(jnp.float32)
    f = jnp.fft.fft2(cg, axes=(1, 3), norm='ortho').real.astype(c.dtype)
    return jnp.einsum('bsgc,gce->bsge', f, w).reshape(bsz, seq, GROUP_WIDTH) + b


def _spatial_gate(h, ln_g, ln_b, w_s, b_s):
    bsz, seq = h.shape[0], h.shape[1]
    u, v = jnp.split(h, 2, axis=-1)
    v = _layernorm(v, ln_g, ln_b)
    nc = seq // SGU_CHUNK
    vg = v.reshape(bsz, nc, SGU_CHUNK, SGU_GROUPS, GROUP_WIDTH // SGU_GROUPS)
    sv = jnp.einsum('gts,bnsgc->bntgc', w_s, vg) + b_s.T[None, None, :, :, None]
    return u * sv.reshape(bsz, seq, GROUP_WIDTH)


def setup_inputs(seed: int = 0) -> dict:
    key = jax.random.key(seed)
    ks = jax.random.split(key, 26)

    def nrm(k, shape, scale):
        return jax.random.normal(k, shape, jnp.float32) * scale

    def gain(k, shape):
        return 1.0 + 0.02 * jax.random.normal(k, shape, jnp.float32)

    gw = GROUP_WIDTH
    return {
        "x": nrm(ks[0], (BATCH, SEQ, D_MODEL), 1.0),
        "norm1_g": gain(ks[1], (DEPTH, D_MODEL)),
        "w_in": nrm(ks[2], (DEPTH, D_MODEL, IN_COLS), D_MODEL ** -0.5),
        "lam_q1": nrm(ks[3], (DEPTH, ATT_QK), 0.1),
        "lam_k1": nrm(ks[4], (DEPTH, ATT_QK), 0.1),
        "lam_q2": nrm(ks[5], (DEPTH, ATT_QK), 0.1),
        "lam_k2": nrm(ks[6], (DEPTH, ATT_QK), 0.1),
        "subln_g": gain(ks[7], (DEPTH, ATT_VDIM)),
        "conv_dw_w": nrm(ks[8], (DEPTH, CONV_WIDTH, gw), CONV_WIDTH ** -0.5),
        "conv_dw_b": nrm(ks[9], (DEPTH, gw), 0.02),
        "conv_ln_g": gain(ks[10], (DEPTH, gw)),
        "conv_ln_b": nrm(ks[11], (DEPTH, gw), 0.02),
        "conv_pw_w": nrm(ks[12], (DEPTH, gw, gw), gw ** -0.5),
        "conv_pw_b": nrm(ks[13], (DEPTH, gw), 0.02),
        "fnet_w": nrm(ks[14], (DEPTH, FNET_GROUPS, gw // FNET_GROUPS, gw // FNET_GROUPS),
                      (gw // FNET_GROUPS) ** -0.5),
        "fnet_b": nrm(ks[15], (DEPTH, gw), 0.02),
        "sgu_ln_g": gain(ks[16], (DEPTH, gw)),
        "sgu_ln_b": nrm(ks[17], (DEPTH, gw), 0.02),
        "sgu_w": nrm(ks[18], (DEPTH, SGU_GROUPS, SGU_CHUNK, SGU_CHUNK), SGU_CHUNK ** -0.5),
        "sgu_b": gain(ks[19], (DEPTH, SGU_GROUPS, SGU_CHUNK)),
        "w_out": nrm(ks[20], (DEPTH, MIX_WIDTH, D_MODEL), MIX_WIDTH ** -0.5),
        "norm2_g": gain(ks[21], (DEPTH, D_MODEL)),
        "w_up": nrm(ks[22], (DEPTH, D_MODEL, D_FF), D_MODEL ** -0.5),
        "w_down": nrm(ks[23], (DEPTH, D_FF, D_MODEL), D_FF ** -0.5),
        "final_g": gain(ks[24], (D_MODEL,)),
    }


def reference(x, norm1_g, w_in, lam_q1, lam_k1, lam_q2, lam_k2, subln_g,
              conv_dw_w, conv_dw_b, conv_ln_g, conv_ln_b, conv_pw_w, conv_pw_b,
              fnet_w, fnet_b, sgu_ln_g, sgu_ln_b, sgu_w, sgu_b,
              w_out, norm2_g, w_up, w_down, final_g):
    bsz, seq = x.shape[0], x.shape[1]
    splits = [GROUP_WIDTH, 2 * GROUP_WIDTH, A_COLS, A_COLS + B_COLS, A_COLS + B_COLS + C_COLS]
    for l in range(DEPTH):
        xn = _rmsnorm(x, norm1_g[l])
        h = xn @ w_in[l]
        hq, hk, hv, hb, hc, hd = jnp.split(h, splits, axis=-1)
        q = hq.reshape(bsz, seq, ATT_HEADS, 2, ATT_QK)
        k = hk.reshape(bsz, seq, ATT_HEADS, 2, ATT_QK)
        v = hv.reshape(bsz, seq, ATT_HEADS, ATT_VDIM)
        lam_init = 0.8 - 0.6 * math.exp(-0.3 * l)
        lam = (jnp.exp(jnp.sum((lam_q1[l] * lam_k1[l]).astype(jnp.float32)))
               - jnp.exp(jnp.sum((lam_q2[l] * lam_k2[l]).astype(jnp.float32)))
               + lam_init)
        y_a = _diff_attention(q, k, v, lam, lam_init, subln_g[l])
        y_b = _conformer_conv(hb, conv_dw_w[l], conv_dw_b[l], conv_ln_g[l], conv_ln_b[l],
                              conv_pw_w[l], conv_pw_b[l])
        y_c = _fourier_mix(hc, fnet_w[l], fnet_b[l])
        y_d = _spatial_gate(hd, sgu_ln_g[l], sgu_ln_b[l], sgu_w[l], sgu_b[l])
        y = jnp.concatenate([y_a, y_b, y_c, y_d], axis=-1)
        x = x + y @ w_out[l]
        xn2 = _rmsnorm(x, norm2_g[l])
        x = x + jnp.square(jax.nn.relu(xn2 @ w_up[l])) @ w_down[l]
    return _rmsnorm(x, final_g)
```

```cpp
#include <hip/hip_runtime.h>
#include <hip/hip_cooperative_groups.h>
#include <cstdint>
#include <cstdio>
#include <cmath>
namespace cg = cooperative_groups;

#ifndef MK_ONE_LAUNCH
#define MK_ONE_LAUNCH 0
#endif

#define DI __device__ __forceinline__
typedef unsigned short bf16_t;
typedef short bf16x8 __attribute__((ext_vector_type(8)));
typedef float f32x4 __attribute__((ext_vector_type(4)));
typedef float f32x16 __attribute__((ext_vector_type(16)));
typedef float f32x2 __attribute__((ext_vector_type(2)));
typedef __bf16 bf16x2v __attribute__((ext_vector_type(2)));
typedef unsigned u32x4 __attribute__((ext_vector_type(4)));
typedef unsigned u32x2 __attribute__((ext_vector_type(2)));

constexpr int BATCH = 8, SEQ = 4096, DM = 1024, DEPTH = 4, NTOK = BATCH * SEQ;
constexpr int HC = 1536;
constexpr int WALL_N = 2304;
constexpr int DFF = 4096;
constexpr float EPS = 1e-6f;
constexpr float LOG2E = 1.4426950408889634f;

DI unsigned pk2(float lo, float hi) { f32x2 v = {lo, hi}; bf16x2v b = __builtin_convertvector(v, bf16x2v); return __builtin_bit_cast(unsigned, b); }
DI float bflo(unsigned u) { return __uint_as_float(u << 16); }
DI float bfhi(unsigned u) { return __uint_as_float(u & 0xffff0000u); }
DI float bf2f(bf16_t u) { return __uint_as_float(((unsigned)u) << 16); }
template <int CTRL> DI float dppf(float v) { return __builtin_bit_cast(float, __builtin_amdgcn_update_dpp(0, __builtin_bit_cast(int, v), CTRL, 0xf, 0xf, true)); }
DI float xch32(float v, int x32) { return __builtin_bit_cast(float, __builtin_amdgcn_ds_bpermute(x32, __builtin_bit_cast(int, v))); }
DI float wave_sum(float v, int x32) {
  v += dppf<0xB1>(v); v += dppf<0x4E>(v); v += dppf<0x141>(v); v += dppf<0x140>(v);
  v += __builtin_bit_cast(float, __builtin_amdgcn_ds_swizzle(__builtin_bit_cast(int, v), 0x401f));
  v += xch32(v, x32);
  return v;
}

struct Params {
  const float *x, *norm1_g, *w_in, *lam_q1, *lam_k1, *lam_q2, *lam_k2, *subln_g, *conv_dw_w, *conv_dw_b, *conv_ln_g, *conv_ln_b,
      *conv_pw_w, *conv_pw_b, *fnet_w, *fnet_b, *sgu_ln_g, *sgu_ln_b, *sgu_w, *sgu_b, *w_out, *norm2_g, *w_up, *w_down, *final_g;
  float* out;
  bf16_t *WallT, *WoutT, *WupT, *WdownT, *pwT, *sguW, *Dmat, *xn, *h, *Vt, *PQt, *y, *hid;
  float* lam;
};

constexpr int SMEM_BYTES = 73728;
__shared__ __attribute__((aligned(16))) unsigned char smem_raw[SMEM_BYTES];
#define SMEM ((bf16_t*)smem_raw)
#define NI __device__ __forceinline__
DI int otid() { int t = threadIdx.x; asm volatile("" : "+v"(t)); return t; }
#define KPARAMS const Params& p = *(const Params*)__builtin_amdgcn_kernarg_segment_ptr()

constexpr int LRS = 72;
constexpr int TILE_E = 128 * LRS;
template <class Epi>
DI void gemm_tile(const bf16_t* __restrict__ X, long ldx, const bf16_t* __restrict__ Y, long ldy, int K, bf16_t* smem, const Epi& epi) {
  const int tid = otid(), lane = tid & 63, wid = tid >> 6, wm = wid >> 1, wn = wid & 1;
  const int sr = tid >> 3, sc = (tid & 7) * 8;
  const int fr = lane & 15, fq = lane >> 4;
  const bf16_t* gx = X + (long)sr * ldx + sc;
  const bf16_t* gy = Y + (long)sr * ldy + sc;
  u32x4 ra[4], rb[4];
  f32x4 acc[4][4];
#pragma unroll
  for (int m = 0; m < 4; ++m)
#pragma unroll
    for (int n = 0; n < 4; ++n) acc[m][n] = (f32x4){0.f, 0.f, 0.f, 0.f};
  const int nk = K >> 6;
#pragma unroll
  for (int i = 0; i < 4; ++i) { ra[i] = *(const u32x4*)(gx + (long)(32 * i) * ldx); rb[i] = *(const u32x4*)(gy + (long)(32 * i) * ldy); }
#pragma unroll
  for (int i = 0; i < 4; ++i) { *(u32x4*)(smem + (sr + 32 * i) * LRS + sc) = ra[i]; *(u32x4*)(smem + TILE_E + (sr + 32 * i) * LRS + sc) = rb[i]; }
  __syncthreads();
  for (int kt = 0; kt < nk; ++kt) {
    const bool more = (kt + 1) < nk;
    if (more) {
#pragma unroll
      for (int i = 0; i < 4; ++i) { ra[i] = *(const u32x4*)(gx + (long)(32 * i) * ldx + (kt + 1) * 64); rb[i] = *(const u32x4*)(gy + (long)(32 * i) * ldy + (kt + 1) * 64); }
    }
    const bf16_t* a = smem + (kt & 1) * 2 * TILE_E;
    const bf16_t* b = a + TILE_E;
#pragma unroll
    for (int ks = 0; ks < 2; ++ks) {
      bf16x8 af[4], bfr[4];
#pragma unroll
      for (int m = 0; m < 4; ++m) af[m] = *(const bf16x8*)(a + (wm * 64 + m * 16 + fr) * LRS + ks * 32 + fq * 8);
#pragma unroll
      for (int n = 0; n < 4; ++n) bfr[n] = *(const bf16x8*)(b + (wn * 64 + n * 16 + fr) * LRS + ks * 32 + fq * 8);
#pragma unroll
      for (int m = 0; m < 4; ++m)
#pragma unroll
        for (int n = 0; n < 4; ++n) acc[m][n] = __builtin_amdgcn_mfma_f32_16x16x32_bf16(bfr[n], af[m], acc[m][n], 0, 0, 0);
    }
    if (more) {
      bf16_t* wa = smem + ((kt + 1) & 1) * 2 * TILE_E;
#pragma unroll
      for (int i = 0; i < 4; ++i) { *(u32x4*)(wa + (sr + 32 * i) * LRS + sc) = ra[i]; *(u32x4*)(wa + TILE_E + (sr + 32 * i) * LRS + sc) = rb[i]; }
    }
    __syncthreads();
  }
#pragma unroll
  for (int m = 0; m < 4; ++m)
#pragma unroll
    for (int n = 0; n < 4; ++n) epi(wm * 64 + m * 16 + fr, wn * 64 + n * 16 + fq * 4, acc[m][n]);
}

DI void tr_tile(const float* __restrict__ src, int lds_, int k0, int n0, bf16_t* __restrict__ dst, int ldd, int nd0, float scale, float* sm) {
  const int t = otid();
#pragma unroll
  for (int i = 0; i < 4; ++i) {
    const int kr = (t >> 4) + 16 * i, nc = (t & 15) * 4;
    const f32x4 v = *(const f32x4*)(src + (long)(k0 + kr) * lds_ + n0 + nc);
    sm[kr * 65 + nc + 0] = v[0]; sm[kr * 65 + nc + 1] = v[1]; sm[kr * 65 + nc + 2] = v[2]; sm[kr * 65 + nc + 3] = v[3];
  }
  __syncthreads();
  const int n = t >> 2, ks = (t & 3) * 16;
  u32x4 w0, w1;
#pragma unroll
  for (int j = 0; j < 4; ++j) {
    w0[j] = pk2(sm[(ks + 2 * j) * 65 + n] * scale, sm[(ks + 2 * j + 1) * 65 + n] * scale);
    w1[j] = pk2(sm[(ks + 8 + 2 * j) * 65 + n] * scale, sm[(ks + 8 + 2 * j + 1) * 65 + n] * scale);
  }
  bf16_t* d = dst + (long)(nd0 + n) * ldd + k0 + ks;
  *(u32x4*)d = w0; *(u32x4*)(d + 8) = w1;
  __syncthreads();
}

constexpr int NT_ALL = DEPTH * 28 * 16, NT_OUT = DEPTH * 16 * 16, NT_UP = DEPTH * 64 * 16, NT_DOWN = DEPTH * 16 * 64, NT_PW = DEPTH * 4 * 4;
constexpr int N_FOLD = DEPTH * 2 * 4 * 4, N_SGU = 128, N_DM = 4096 * 4, N_LAM = 1;
constexpr int PREP_ITEMS = NT_ALL + NT_OUT + NT_UP + NT_DOWN + NT_PW + N_FOLD + N_SGU + N_DM + N_LAM;

DI void prep_item(const Params& p, int it, float* sm) {
  const int t = otid();
  if (it < NT_ALL) {
    const int l = it / (28 * 16), rem = it % (28 * 16), nt = rem / 16, kt = rem % 16;
    const int nd = nt * 64;
    int nsrc; float scale = 1.f;
    if (nd < 512) { nsrc = nd; if (nd < 256) scale = 0.17677669529663687f * LOG2E; }
    else if (nd < 1024) nsrc = 768 + (nd - 512);
    else if (nd < 1536) nsrc = 1536 + (nd - 1024);
    else nsrc = 512 + (nd - 1536);
    tr_tile(p.w_in + (long)l * DM * 2048, 2048, kt * 64, nsrc, p.WallT + (long)l * WALL_N * DM, DM, nd, scale, sm);
    return;
  }
  it -= NT_ALL;
  if (it < NT_OUT) {
    const int l = it / 256, rem = it % 256, nt = rem / 16, kt = rem % 16;
    tr_tile(p.w_out + (long)l * DM * DM, DM, kt * 64, nt * 64, p.WoutT + (long)l * DM * DM, DM, nt * 64, 1.f, sm);
    return;
  }
  it -= NT_OUT;
  if (it < NT_UP) {
    const int l = it / 1024, rem = it % 1024, nt = rem / 16, kt = rem % 16;
    tr_tile(p.w_up + (long)l * DM * DFF, DFF, kt * 64, nt * 64, p.WupT + (long)l * DFF * DM, DM, nt * 64, 1.f, sm);
    return;
  }
  it -= NT_UP;
  if (it < NT_DOWN) {
    const int l = it / 1024, rem = it % 1024, nt = rem / 64, kt = rem % 64;
    tr_tile(p.w_down + (long)l * DFF * DM, DM, kt * 64, nt * 64, p.WdownT + (long)l * DM * DFF, DFF, nt * 64, 1.f, sm);
    return;
  }
  it -= NT_DOWN;
  if (it < NT_PW) {
    const int l = it / 16, rem = it % 16, nt = rem / 4, kt = rem % 4;
    tr_tile(p.conv_pw_w + (long)l * 65536, 256, kt * 64, nt * 64, p.pwT + (long)l * 65536, 256, nt * 64, 1.f, sm);
    return;
  }
  it -= NT_PW;
  if (it < N_FOLD) {
    const int l = it >> 5, pq = (it >> 4) & 1, g = (it >> 2) & 3, kcn = it & 3;
    const float* fw = p.fnet_w + ((long)l * 4 + g) * 4096;
    for (int idx = t; idx < 4096; idx += 256) {
      const int c = idx >> 6, e = idx & 63;
      float s = 0.f;
      for (int kc = 0; kc < 64; ++kc) {
        const int m = (c * kc) & 63;
        const float tr = pq ? sinpif((float)m * (1.f / 32.f)) : cospif((float)m * (1.f / 32.f));
        s += tr * fw[kc * 64 + e];
      }
      sm[idx] = s * (1.f / 512.f);
    }
    __syncthreads();
    const int k = kcn * 256 + t;
    const float* wr = p.w_in + (long)l * DM * 2048 + (long)k * 2048 + 1280 + g * 64;
    f32x4 wv[16];
#pragma unroll
    for (int i = 0; i < 16; ++i) wv[i] = *(const f32x4*)(wr + 4 * i);
    bf16_t* dst = p.WallT + (long)l * WALL_N * DM + (long)(1792 + pq * 256 + g * 64) * DM + k;
#pragma unroll 1
    for (int e = 0; e < 64; ++e) {
      float s = 0.f;
#pragma unroll
      for (int i = 0; i < 16; ++i) {
        s += wv[i][0] * sm[(4 * i + 0) * 64 + e]; s += wv[i][1] * sm[(4 * i + 1) * 64 + e];
        s += wv[i][2] * sm[(4 * i + 2) * 64 + e]; s += wv[i][3] * sm[(4 * i + 3) * 64 + e];
      }
      dst[(long)e * DM] = (bf16_t)(pk2(s, 0.f) & 0xffffu);
    }
    __syncthreads();
    return;
  }
  it -= N_FOLD;
  if (it < N_SGU) {
    const long o = (long)it * 2048 + t * 8;
    const f32x4 a = *(const f32x4*)(p.sgu_w + o), b = *(const f32x4*)(p.sgu_w + o + 4);
    u32x4 w; w[0] = pk2(a[0], a[1]); w[1] = pk2(a[2], a[3]); w[2] = pk2(b[0], b[1]); w[3] = pk2(b[2], b[3]);
    *(u32x4*)(p.sguW + o) = w;
    return;
  }
  it -= N_SGU;
  if (it < N_DM) {
    const int k = it >> 2, n0 = (it & 3) * 2048 + t * 8;
    float v[8];
#pragma unroll
    for (int j = 0; j < 8; ++j) {
      const int n = n0 + j;
      const int m = (k * (n & 4095)) & 4095;
      const float ang = (float)m * (1.f / 2048.f);
      v[j] = (n < 4096) ? cospif(ang) : -sinpif(ang);
    }
    u32x4 w; w[0] = pk2(v[0], v[1]); w[1] = pk2(v[2], v[3]); w[2] = pk2(v[4], v[5]); w[3] = pk2(v[6], v[7]);
    *(u32x4*)(p.Dmat + (long)k * 8192 + n0) = w;
    return;
  }
  it -= N_DM;
  if (t < DEPTH) {
    const int l = t;
    float s1 = 0.f, s2 = 0.f;
    for (int i = 0; i < 32; ++i) { s1 += p.lam_q1[l * 32 + i] * p.lam_k1[l * 32 + i]; s2 += p.lam_q2[l * 32 + i] * p.lam_k2[l * 32 + i]; }
    const float lam_init = 0.8f - 0.6f * expf(-0.3f * (float)l);
    p.lam[l] = expf(s1) - expf(s2) + lam_init;
  }
}

NI void prep_phase() {
  KPARAMS;
  float* sm = (float*)smem_raw;
  for (int it0 = blockIdx.x; it0 < PREP_ITEMS; it0 += gridDim.x) prep_item(p, it0, sm);
}

template <bool FINAL>
NI void rms_phase(const float* __restrict__ src, const float* __restrict__ g, bf16_t* __restrict__ dstb, float* __restrict__ dstf) {
  const int tid_ = otid(); const int lane = tid_ & 63, wid = tid_ >> 6, x32 = ((lane ^ 32) << 2);
  f32x4 gv[4];
#pragma unroll
  for (int i = 0; i < 4; ++i) gv[i] = *(const f32x4*)(g + lane * 4 + 256 * i);
  for (int row = blockIdx.x * 4 + wid; row < NTOK; row += gridDim.x * 4) {
    const float* s = src + (long)row * DM;
    f32x4 v[4];
#pragma unroll
    for (int i = 0; i < 4; ++i) v[i] = *(const f32x4*)(s + lane * 4 + 256 * i);
    float ss = 0.f;
#pragma unroll
    for (int i = 0; i < 4; ++i) ss += v[i][0] * v[i][0] + v[i][1] * v[i][1] + v[i][2] * v[i][2] + v[i][3] * v[i][3];
    ss = wave_sum(ss, x32);
    const float rs = rsqrtf(ss * (1.f / 1024.f) + EPS);
#pragma unroll
    for (int i = 0; i < 4; ++i) {
      const f32x4 o = v[i] * rs * gv[i];
      if (FINAL) *(f32x4*)(dstf + (long)row * DM + lane * 4 + 256 * i) = o;
      else { u32x2 w; w[0] = pk2(o[0], o[1]); w[1] = pk2(o[2], o[3]); *(u32x2*)(dstb + (long)row * DM + lane * 4 + 256 * i) = w; }
    }
  }
}

struct EpiH { bf16_t* h; long tok0; int col0;
  DI void operator()(int r, int c, f32x4 v) const { u32x2 w; w[0] = pk2(v[0], v[1]); w[1] = pk2(v[2], v[3]); *(u32x2*)(h + (tok0 + r) * HC + col0 + c) = w; } };
struct EpiT { bf16_t* Vt; bf16_t* PQt; int n0; int tok0;
  DI void operator()(int r, int c, f32x4 v) const {
    const int n = n0 + r, tok = tok0 + c, b = tok >> 12, s = tok & 4095;
    u32x2 w; w[0] = pk2(v[0], v[1]); w[1] = pk2(v[2], v[3]);
    if (n < 256) *(u32x2*)(Vt + ((long)(b * 256 + n)) * 4096 + s) = w;
    else { const int np = n - 256, pq = np >> 8, ch = np & 255; *(u32x2*)(PQt + ((long)(b * 256 + ch)) * 8192 + pq * 4096 + s) = w; }
  } };
struct EpiRes { const float* xin; float* out; long tok0; int col0;
  DI void operator()(int r, int c, f32x4 v) const { const long o = (tok0 + r) * DM + col0 + c; const f32x4 x = *(const f32x4*)(xin + o); *(f32x4*)(out + o) = x + v; } };
struct EpiUp { bf16_t* hid; long tok0; int col0;
  DI void operator()(int r, int c, f32x4 v) const {
    f32x4 a; a[0] = fmaxf(v[0], 0.f); a[1] = fmaxf(v[1], 0.f); a[2] = fmaxf(v[2], 0.f); a[3] = fmaxf(v[3], 0.f); a = a * a;
    u32x2 w; w[0] = pk2(a[0], a[1]); w[1] = pk2(a[2], a[3]); *(u32x2*)(hid + (tok0 + r) * DFF + col0 + c) = w; } };
struct EpiFnet { bf16_t* y; const float* bias; long tok0; int col0;
  DI void operator()(int r, int c, f32x4 v) const {
    const f32x4 bv = *(const f32x4*)(bias + col0 + c); v = v + bv;
    u32x2 w; w[0] = pk2(v[0], v[1]); w[1] = pk2(v[2], v[3]); *(u32x2*)(y + (tok0 + r) * DM + 512 + col0 + c) = w; } };

NI void gemm_in_phase(int l) {
  KPARAMS;
  bf16_t* smem = SMEM;
  const bf16_t* W = p.WallT + (long)l * WALL_N * DM;
  for (int id = blockIdx.x; id < 256 * 18; id += gridDim.x) {
    const int mt = id / 18, j = id % 18;
    if (j < 12) { EpiH e{p.h, (long)mt * 128, j * 128}; gemm_tile(p.xn + (long)mt * 128 * DM, DM, W + (long)j * 128 * DM, DM, DM, smem, e); }
    else { EpiT e{p.Vt, p.PQt, (j - 12) * 128, mt * 128}; gemm_tile(W + (long)(1536 + (j - 12) * 128) * DM, DM, p.xn + (long)mt * 128 * DM, DM, DM, smem, e); }
  }
}
NI void gemm_out_phase(int l) {
  KPARAMS;
  bf16_t* smem = SMEM;
  const bf16_t* W = p.WoutT + (long)l * DM * DM;
  const float* xin = (l == 0) ? p.x : p.out;
  for (int id = blockIdx.x; id < 256 * 8; id += gridDim.x) {
    const int mt = id >> 3, nt = id & 7;
    EpiRes e{xin, p.out, (long)mt * 128, nt * 128};
    gemm_tile(p.y + (long)mt * 128 * DM, DM, W + (long)nt * 128 * DM, DM, DM, smem, e);
  }
}
NI void gemm_up_phase(int l) {
  KPARAMS;
  bf16_t* smem = SMEM;
  const bf16_t* W = p.WupT + (long)l * DFF * DM;
  for (int id = blockIdx.x; id < 256 * 32; id += gridDim.x) {
    const int mt = id >> 5, nt = id & 31;
    EpiUp e{p.hid, (long)mt * 128, nt * 128};
    gemm_tile(p.xn + (long)mt * 128 * DM, DM, W + (long)nt * 128 * DM, DM, DM, smem, e);
  }
}
NI void gemm_down_phase(int l) {
  KPARAMS;
  bf16_t* smem = SMEM;
  const bf16_t* W = p.WdownT + (long)l * DM * DFF;
  for (int id = blockIdx.x; id < 256 * 8; id += gridDim.x) {
    const int mt = id >> 3, nt = id & 7;
    EpiRes e{p.out, p.out, (long)mt * 128, nt * 128};
    gemm_tile(p.hid + (long)mt * 128 * DFF, DFF, W + (long)nt * 128 * DFF, DFF, DFF, smem, e);
  }
}

constexpr int ARS = 72;
constexpr int ATILE = 64 * ARS;
NI void attn_tile(int l, int id) {
  KPARAMS;
  bf16_t* smem = SMEM;
  const int b = id >> 7, head = (id >> 5) & 3, qb = id & 31;
  const int tid = otid(), lane = tid & 63, wid = tid >> 6, r = lane & 31, hh = lane >> 5, x32 = ((lane ^ 32) << 2);
  const float slope = (head == 0) ? 0.25f : (head == 1) ? 0.0625f : (head == 2) ? 0.015625f : 0.00390625f;
  const float ncs = -slope * LOG2E;
  const int qi = qb * 128 + wid * 32 + r;
  const bf16_t* qrow = p.h + ((long)(b * SEQ + qi)) * HC + head * 64;
  bf16x8 qf[2][2];
#pragma unroll
  for (int m = 0; m < 2; ++m)
#pragma unroll
    for (int s = 0; s < 2; ++s) qf[m][s] = *(const bf16x8*)(qrow + m * 32 + s * 16 + hh * 8);
  const bf16_t* kbase = p.h + ((long)(b * SEQ)) * HC + 256 + head * 64;
  const bf16_t* vbase = p.Vt + ((long)((b * 4 + head) * 64)) * SEQ;
  const int srow = tid >> 3, scol = (tid & 7) * 8;
  u32x4 rk[2], rv[2];
  f32x16 O[2][2];
#pragma unroll
  for (int m = 0; m < 2; ++m)
#pragma unroll
    for (int vb = 0; vb < 2; ++vb)
#pragma unroll
      for (int i = 0; i < 16; ++i) O[m][vb][i] = 0.f;
  float mrun[2] = {-1e30f, -1e30f}, lrun[2] = {0.f, 0.f};
  const int kperm = (r & 19) | ((r & 4) << 1) | ((r & 8) >> 1);

#pragma unroll
  for (int i = 0; i < 2; ++i) {
    rk[i] = *(const u32x4*)(kbase + (long)(srow + 32 * i) * HC + scol);
    rv[i] = *(const u32x4*)(vbase + (long)(srow + 32 * i) * SEQ + scol);
  }
#pragma unroll
  for (int i = 0; i < 2; ++i) { *(u32x4*)(smem + (srow + 32 * i) * ARS + scol) = rk[i]; *(u32x4*)(smem + ATILE + (srow + 32 * i) * ARS + scol) = rv[i]; }
  __syncthreads();
  constexpr int NKT = SEQ / 64;
  for (int kt = 0; kt < NKT; ++kt) {
    const bool more = (kt + 1) < NKT;
    if (more) {
#pragma unroll
      for (int i = 0; i < 2; ++i) {
        rk[i] = *(const u32x4*)(kbase + (long)((kt + 1) * 64 + srow + 32 * i) * HC + scol);
        rv[i] = *(const u32x4*)(vbase + (long)(srow + 32 * i) * SEQ + (kt + 1) * 64 + scol);
      }
    }
    const bf16_t* Ks = smem + (kt & 1) * 2 * ATILE;
    const bf16_t* Vs = Ks + ATILE;
    const float dbase = (float)(qi - kt * 64 - 8 * hh);
#pragma unroll
    for (int m = 0; m < 2; ++m) {
      f32x16 x[2];
#pragma unroll
      for (int kb = 0; kb < 2; ++kb) {
#pragma unroll
        for (int i = 0; i < 16; ++i) x[kb][i] = 0.f;
#pragma unroll
        for (int s = 0; s < 2; ++s) {
          const bf16x8 kf = *(const bf16x8*)(Ks + (kb * 32 + kperm) * ARS + m * 32 + s * 16 + hh * 8);
          x[kb] = __builtin_amdgcn_mfma_f32_32x32x16_bf16(kf, qf[m][s], x[kb], 0, 0, 0);
        }
      }
      float mx = -1e30f;
#pragma unroll
      for (int kb = 0; kb < 2; ++kb)
#pragma unroll
        for (int i = 0; i < 16; ++i) {
          const float off = (float)(kb * 32 + 16 * (i >> 3) + (i & 7));
          x[kb][i] = fmaf(ncs, fabsf(dbase - off), x[kb][i]);
          mx = fmaxf(mx, x[kb][i]);
        }
      mx = fmaxf(mx, xch32(mx, x32));
      const float mnew = fmaxf(mrun[m], mx);
      const float alpha = __builtin_amdgcn_exp2f(mrun[m] - mnew);
      mrun[m] = mnew;
      float ps = 0.f;
#pragma unroll
      for (int kb = 0; kb < 2; ++kb)
#pragma unroll
        for (int i = 0; i < 16; ++i) { x[kb][i] = __builtin_amdgcn_exp2f(x[kb][i] - mnew); ps += x[kb][i]; }
      lrun[m] = lrun[m] * alpha + ps;
#pragma unroll
      for (int vb = 0; vb < 2; ++vb)
#pragma unroll
        for (int i = 0; i < 16; ++i) O[m][vb][i] *= alpha;
#pragma unroll
      for (int kb = 0; kb < 2; ++kb)
#pragma unroll
        for (int s = 0; s < 2; ++s) {
          u32x4 pw;
#pragma unroll
          for (int j = 0; j < 4; ++j) pw[j] = pk2(x[kb][8 * s + 2 * j], x[kb][8 * s + 2 * j + 1]);
          const bf16x8 pf = __builtin_bit_cast(bf16x8, pw);
#pragma unroll
          for (int vb = 0; vb < 2; ++vb) {
            const bf16x8 vf = *(const bf16x8*)(Vs + (vb * 32 + r) * ARS + kb * 32 + s * 16 + hh * 8);
            O[m][vb] = __builtin_amdgcn_mfma_f32_32x32x16_bf16(vf, pf, O[m][vb], 0, 0, 0);
          }
        }
    }
    if (more) {
      bf16_t* wk = smem + ((kt + 1) & 1) * 2 * ATILE;
#pragma unroll
      for (int i = 0; i < 2; ++i) { *(u32x4*)(wk + (srow + 32 * i) * ARS + scol) = rk[i]; *(u32x4*)(wk + ATILE + (srow + 32 * i) * ARS + scol) = rv[i]; }
    }
    __syncthreads();
  }
  asm volatile("" ::: "memory");
  const int tid2 = otid(), lane2 = tid2 & 63, hh2 = lane2 >> 5, qi2 = qb * 128 + (tid2 >> 6) * 32 + (lane2 & 31);
  const float lam = p.lam[l];
  const float lam_init = 0.8f - 0.6f * expf(-0.3f * (float)l);
  const float l1 = lrun[0] + xch32(lrun[0], x32), l2 = lrun[1] + xch32(lrun[1], x32);
  const float i1 = 1.f / l1, i2 = lam / l2;
  float ss = 0.f;
#pragma unroll
  for (int vb = 0; vb < 2; ++vb)
#pragma unroll
    for (int i = 0; i < 16; ++i) { const float o = O[0][vb][i] * i1 - O[1][vb][i] * i2; O[0][vb][i] = o; ss += o * o; }
  ss += xch32(ss, x32);
  const float rs = rsqrtf(ss * (1.f / 64.f) + EPS) * (1.f - lam_init);
  const float* sg = p.subln_g + l * 64;
  bf16_t* yrow = p.y + ((long)(b * SEQ + qi2)) * DM + head * 64;
#pragma unroll
  for (int vb = 0; vb < 2; ++vb)
#pragma unroll
    for (int g4 = 0; g4 < 4; ++g4) {
      const int vc = vb * 32 + 8 * g4 + 4 * hh2;
      const f32x4 gg = *(const f32x4*)(sg + vc);
      u32x2 w;
      w[0] = pk2(O[0][vb][4 * g4 + 0] * rs * gg[0], O[0][vb][4 * g4 + 1] * rs * gg[1]);
      w[1] = pk2(O[0][vb][4 * g4 + 2] * rs * gg[2], O[0][vb][4 * g4 + 3] * rs * gg[3]);
      *(u32x2*)(yrow + vc) = w;
    }
}

constexpr int ZRS = 264;
NI void conv_tile(int l, int id) {
  KPARAMS;
  bf16_t* smem = SMEM;
  const int b = id >> 6, t0 = (id & 63) * 64;
  const int tid = otid(), lane = tid & 63, wid = tid >> 6, x32 = ((lane ^ 32) << 2);
  for (int idx = tid; idx < 94 * 32; idx += 256) {
    const int row = idx >> 5, c8 = (idx & 31) * 8;
    const int tok = t0 - 15 + row;
    u32x4 w = (u32x4){0u, 0u, 0u, 0u};
    if (tok >= 0 && tok < SEQ) {
      const bf16_t* hp = p.h + ((long)(b * SEQ + tok)) * HC + 512 + c8;
      const u32x4 a = *(const u32x4*)hp, g = *(const u32x4*)(hp + 256);
#pragma unroll
      for (int j = 0; j < 4; ++j) {
        const float a0 = bflo(a[j]), a1 = bfhi(a[j]), g0 = bflo(g[j]), g1 = bfhi(g[j]);
        w[j] = pk2(a0 / (1.f + __expf(-g0)), a1 / (1.f + __expf(-g1)));
      }
    }
    *(u32x4*)(smem + row * ZRS + c8) = w;
  }
  __syncthreads();
  {
    const int c = tid;
    float wv[31];
#pragma unroll
    for (int j = 0; j < 31; ++j) wv[j] = p.conv_dw_w[((long)l * 31 + j) * 256 + c];
    const float cb = p.conv_dw_b[l * 256 + c], lg = p.conv_ln_g[l * 256 + c], lb = p.conv_ln_b[l * 256 + c];
#pragma unroll 1
    for (int ch = 0; ch < 8; ++ch) {
      float zw[38];
#pragma unroll
      for (int j = 0; j < 38; ++j) zw[j] = bf2f(smem[(ch * 8 + j) * ZRS + c]);
      float o[8];
#pragma unroll
      for (int tt = 0; tt < 8; ++tt) {
        float s = cb;
#pragma unroll
        for (int j = 0; j < 31; ++j) s = fmaf(wv[j], zw[tt + j], s);
        o[tt] = s;
      }
#pragma unroll
      for (int tt = 0; tt < 8; ++tt) {
        const float s1 = wave_sum(o[tt], x32), s2 = wave_sum(o[tt] * o[tt], x32);
        const float mu = s1 * (1.f / 64.f);
        const float var = fmaxf(s2 * (1.f / 64.f) - mu * mu, 0.f);
        const float yv = (o[tt] - mu) * rsqrtf(var + EPS) * lg + lb;
        const float sv = yv / (1.f + __expf(-yv));
        smem[(ch * 8 + tt) * ZRS + c] = (bf16_t)(pk2(sv, 0.f) & 0xffffu);
      }
    }
  }
  __syncthreads();
  {
    const int fr = lane & 15, fq = lane >> 4;
    const bf16_t* W = p.pwT + (long)l * 65536 + (long)(wid * 64) * 256;
    f32x4 acc[4][4];
#pragma unroll
    for (int m = 0; m < 4; ++m)
#pragma unroll
      for (int n = 0; n < 4; ++n) acc[m][n] = (f32x4){0.f, 0.f, 0.f, 0.f};
#pragma unroll 2
    for (int ks = 0; ks < 8; ++ks) {
      bf16x8 af[4], bfr[4];
#pragma unroll
      for (int m = 0; m < 4; ++m) af[m] = *(const bf16x8*)(smem + (m * 16 + fr) * ZRS + ks * 32 + fq * 8);
#pragma unroll
      for (int n = 0; n < 4; ++n) bfr[n] = *(const bf16x8*)(W + (long)(n * 16 + fr) * 256 + ks * 32 + fq * 8);
#pragma unroll
      for (int m = 0; m < 4; ++m)
#pragma unroll
        for (int n = 0; n < 4; ++n) acc[m][n] = __builtin_amdgcn_mfma_f32_16x16x32_bf16(bfr[n], af[m], acc[m][n], 0, 0, 0);
    }
    const float* pb = p.conv_pw_b + l * 256;
#pragma unroll
    for (int m = 0; m < 4; ++m)
#pragma unroll
      for (int n = 0; n < 4; ++n) {
        const int tok = t0 + m * 16 + fr, col = wid * 64 + n * 16 + fq * 4;
        const f32x4 bv = *(const f32x4*)(pb + col);
        const f32x4 v = acc[m][n] + bv;
        u32x2 w; w[0] = pk2(v[0], v[1]); w[1] = pk2(v[2], v[3]);
        *(u32x2*)(p.y + ((long)(b * SEQ + tok)) * DM + 256 + col) = w;
      }
  }
  __syncthreads();
}

constexpr int VRS = 258;
NI void sgu_tile(int l, int id) {
  KPARAMS;
  bf16_t* smem = SMEM;
  const int tid = otid(), lane = tid & 63, wid = tid >> 6, x32 = ((lane ^ 32) << 2);
  const long T0 = (long)id * 128;
  {
    const f32x4 lg = *(const f32x4*)(p.sgu_ln_g + l * 256 + lane * 4), lb = *(const f32x4*)(p.sgu_ln_b + l * 256 + lane * 4);
#pragma unroll 4
    for (int i = 0; i < 32; ++i) {
      const int s = wid * 32 + i;
      const u32x2 raw = *(const u32x2*)(p.h + (T0 + s) * HC + 1280 + lane * 4);
      const float v0 = bflo(raw[0]), v1 = bfhi(raw[0]), v2 = bflo(raw[1]), v3 = bfhi(raw[1]);
      const float s1 = wave_sum(v0 + v1 + v2 + v3, x32);
      const float mu = s1 * (1.f / 256.f);
      const float d0 = v0 - mu, d1 = v1 - mu, d2 = v2 - mu, d3 = v3 - mu;
      const float s2 = wave_sum(d0 * d0 + d1 * d1 + d2 * d2 + d3 * d3, x32);
      const float rs = rsqrtf(s2 * (1.f / 256.f) + EPS);
      unsigned* dst = (unsigned*)(smem + s * VRS + lane * 4);
      dst[0] = pk2(d0 * rs * lg[0] + lb[0], d1 * rs * lg[1] + lb[1]);
      dst[1] = pk2(d2 * rs * lg[2] + lb[2], d3 * rs * lg[3] + lb[3]);
    }
  }
  __syncthreads();
  {
    const int fr = lane & 15, fq = lane >> 4, g = wid;
    const bf16_t* W = p.sguW + ((long)(l * 4 + g)) * 16384;
    const float* bs = p.sgu_b + ((long)(l * 4 + g)) * 128;
#pragma unroll 1
    for (int th = 0; th < 2; ++th) {
      f32x4 acc[4][4];
#pragma unroll
      for (int m = 0; m < 4; ++m)
#pragma unroll
        for (int n = 0; n < 4; ++n) acc[m][n] = (f32x4){0.f, 0.f, 0.f, 0.f};
#pragma unroll 1
      for (int ks = 0; ks < 4; ++ks) {
        bf16x8 vf[4], wf[4];
#pragma unroll
        for (int n = 0; n < 4; ++n) {
#pragma unroll
          for (int j = 0; j < 8; ++j) vf[n][j] = (short)smem[(ks * 32 + fq * 8 + j) * VRS + g * 64 + n * 16 + fr];
        }
#pragma unroll
        for (int m = 0; m < 4; ++m) wf[m] = *(const bf16x8*)(W + (long)(th * 64 + m * 16 + fr) * 128 + ks * 32 + fq * 8);
#pragma unroll
        for (int m = 0; m < 4; ++m)
#pragma unroll
          for (int n = 0; n < 4; ++n) acc[m][n] = __builtin_amdgcn_mfma_f32_16x16x32_bf16(vf[n], wf[m], acc[m][n], 0, 0, 0);
      }
#pragma unroll
      for (int m = 0; m < 4; ++m) {
        const int t = th * 64 + m * 16 + fr;
        const float bt = bs[t];
#pragma unroll
        for (int n = 0; n < 4; ++n) {
          const int c = g * 64 + n * 16 + fq * 4;
          const u32x2 ur = *(const u32x2*)(p.h + (T0 + t) * HC + 1024 + c);
          const f32x4 sv = acc[m][n] + bt;
          u32x2 w; w[0] = pk2(bflo(ur[0]) * sv[0], bfhi(ur[0]) * sv[1]); w[1] = pk2(bflo(ur[1]) * sv[2], bfhi(ur[1]) * sv[3]);
          *(u32x2*)(p.y + (T0 + t) * DM + 768 + c) = w;
        }
      }
    }
  }
  __syncthreads();
}

NI void mixer_phase(int l) {
  KPARAMS;
  bf16_t* smem = SMEM;
  constexpr int NA = 1024, NF = 512, NC = 512, ND = 256;
  for (int id = blockIdx.x; id < NA + NF + NC + ND; id += gridDim.x) {
    if (id < NA) attn_tile(l, id);
    else if (id < NA + NF) {
      const int f = id - NA, b = f >> 6, mt = (f >> 1) & 31, nt = f & 1;
      EpiFnet e{p.y, p.fnet_b + l * 256, (long)b * SEQ + mt * 128, nt * 128};
      gemm_tile(p.Dmat + (long)mt * 128 * 8192, 8192, p.PQt + ((long)(b * 256 + nt * 128)) * 8192, 8192, 8192, smem, e);
    } else if (id < NA + NF + NC) conv_tile(l, id - NA - NF);
    else sgu_tile(l, id - NA - NF - NC);
  }
}

constexpr int NPHASE = 2 + 7 * DEPTH;
__global__ void __launch_bounds__(256, 2) mk_fwd(Params p, int ph_lo, int ph_hi, int coop) {
  for (int ph = ph_lo; ph < ph_hi; ++ph) {
    if (ph == 0) {
      prep_phase();
    } else if (ph == NPHASE - 1) {
      rms_phase<true>(p.out, p.final_g, nullptr, p.out);
    } else {
      const int l = (ph - 1) / 7, s = (ph - 1) % 7;
      if (s == 0) rms_phase<false>(l == 0 ? p.x : p.out, p.norm1_g + l * DM, p.xn, nullptr);
      else if (s == 1) gemm_in_phase(l);
      else if (s == 2) mixer_phase(l);
      else if (s == 3) gemm_out_phase(l);
      else if (s == 4) rms_phase<false>(p.out, p.norm2_g + l * DM, p.xn, nullptr);
      else if (s == 5) gemm_up_phase(l);
      else gemm_down_phase(l);
    }
    if (coop && ph + 1 < ph_hi) cg::this_grid().sync();
  }
}

extern "C" void kernel_launch(void* const* d_in, const int* in_sizes, int n_in, void* d_out, int out_size, void* d_ws, size_t ws_size, hipStream_t stream) {
  Params p{};
  const float** pf = (const float**)&p;
  for (int i = 0; i < 25; ++i) pf[i] = (const float*)d_in[i];
  p.out = (float*)d_out;
  unsigned char* w = (unsigned char*)d_ws;
  size_t off = 0;
  auto take = [&](size_t bytes) { unsigned char* r = w + off; off += (bytes + 255) & ~(size_t)255; return r; };
  p.WallT = (bf16_t*)take((size_t)DEPTH * WALL_N * DM * 2);
  p.WoutT = (bf16_t*)take((size_t)DEPTH * DM * DM * 2);
  p.WupT = (bf16_t*)take((size_t)DEPTH * DFF * DM * 2);
  p.WdownT = (bf16_t*)take((size_t)DEPTH * DFF * DM * 2);
  p.pwT = (bf16_t*)take((size_t)DEPTH * 65536 * 2);
  p.sguW = (bf16_t*)take((size_t)DEPTH * 4 * 16384 * 2);
  p.lam = (float*)take(256);
  p.Dmat = (bf16_t*)take((size_t)4096 * 8192 * 2);
  p.xn = (bf16_t*)take((size_t)NTOK * DM * 2);
  unsigned char* region = take((size_t)NTOK * DFF * 2);
  p.hid = (bf16_t*)region;
  p.h = (bf16_t*)region;
  p.Vt = (bf16_t*)(region + (size_t)NTOK * HC * 2);
  p.PQt = (bf16_t*)(region + (size_t)NTOK * HC * 2 + (size_t)NTOK * 256 * 2);
  p.y = (bf16_t*)(region + (size_t)NTOK * HC * 2 + (size_t)NTOK * 256 * 2 + (size_t)BATCH * 256 * 8192 * 2);
  if (off > ws_size) { fprintf(stderr, "workspace too small: need %zu have %zu\n", off, ws_size); return; }

  static int grid_blocks = 0;
  if (!grid_blocks) {
    int dev = 0, cus = 0, per_cu = 0;
    hipGetDevice(&dev);
    hipDeviceGetAttribute(&cus, hipDeviceAttributeMultiprocessorCount, dev);
    hipOccupancyMaxActiveBlocksPerMultiprocessor(&per_cu, mk_fwd, 256, 0);
    if (per_cu < 1) per_cu = 1;
    grid_blocks = cus * per_cu;
  }
#if MK_ONE_LAUNCH
  int lo = 0, hi = NPHASE, coop = 1;
  void* args[] = {&p, &lo, &hi, &coop};
  hipError_t e = hipLaunchCooperativeKernel((void*)mk_fwd, dim3(grid_blocks), dim3(256), args, 0, stream);
  if (e != hipSuccess) fprintf(stderr, "cooperative launch failed: %s (grid %d)\n", hipGetErrorString(e), grid_blocks);
#else
  for (int ph = 0; ph < NPHASE; ++ph) mk_fwd<<<grid_blocks, 256, 0, stream>>>(p, ph, ph + 1, 0);
#endif
}
```

```cpp
#include <hip/hip_runtime.h>
#include <hip/hip_cooperative_groups.h>
#include <cstdint>
#include <cstdio>
#include <cmath>
namespace cg = cooperative_groups;

#ifndef EXTRA_SYNCS
#define EXTRA_SYNCS 0
#endif
#ifndef REP_PREP
#define REP_PREP 0
#endif
#ifndef REP_S
#define REP_S -1
#endif
#ifndef MK_ONE_LAUNCH
#define MK_ONE_LAUNCH 1
#endif

#define DI __device__ __forceinline__
typedef unsigned short bf16_t;
typedef short bf16x8 __attribute__((ext_vector_type(8)));
typedef float f32x4 __attribute__((ext_vector_type(4)));
typedef float f32x16 __attribute__((ext_vector_type(16)));
typedef float f32x2 __attribute__((ext_vector_type(2)));
typedef __bf16 bf16x2v __attribute__((ext_vector_type(2)));
typedef unsigned u32x4 __attribute__((ext_vector_type(4)));
typedef unsigned u32x2 __attribute__((ext_vector_type(2)));

constexpr int BATCH = 8, SEQ = 4096, DM = 1024, DEPTH = 4, NTOK = BATCH * SEQ;
constexpr int HC = 1536;
constexpr int WALL_N = 2304;
constexpr int DFF = 4096;
constexpr float EPS = 1e-6f;
constexpr float LOG2E = 1.4426950408889634f;

DI unsigned pk2(float lo, float hi) { f32x2 v = {lo, hi}; bf16x2v b = __builtin_convertvector(v, bf16x2v); return __builtin_bit_cast(unsigned, b); }
DI float bflo(unsigned u) { return __uint_as_float(u << 16); }
DI float bfhi(unsigned u) { return __uint_as_float(u & 0xffff0000u); }
DI float bf2f(bf16_t u) { return __uint_as_float(((unsigned)u) << 16); }
template <int CTRL> DI float dppf(float v) { return __builtin_bit_cast(float, __builtin_amdgcn_update_dpp(0, __builtin_bit_cast(int, v), CTRL, 0xf, 0xf, true)); }
DI float xch32(float v, int x32) { return __builtin_bit_cast(float, __builtin_amdgcn_ds_bpermute(x32, __builtin_bit_cast(int, v))); }
template <int CTRL, int RM> DI float dppz(float v) { return __builtin_bit_cast(float, __builtin_amdgcn_update_dpp(0, __builtin_bit_cast(int, v), CTRL, RM, 0xf, false)); }
DI float wave_sum(float v, int) {
  v += dppf<0xB1>(v); v += dppf<0x4E>(v); v += dppf<0x141>(v); v += dppf<0x140>(v);
  v += dppz<0x142, 0xa>(v);
  v += dppz<0x143, 0xc>(v);
  return __builtin_bit_cast(float, __builtin_amdgcn_readlane(__builtin_bit_cast(int, v), 63));
}

#define LAS3 __attribute__((address_space(3)))
DI void half_bar(LAS3 unsigned* cnt, unsigned& target, int lane) {
  asm volatile("s_waitcnt lgkmcnt(0)" ::: "memory");
  target += 4u;
  if (lane == 0) __hip_atomic_fetch_add(cnt, 1u, __ATOMIC_RELAXED, __HIP_MEMORY_SCOPE_WORKGROUP);
  while (__hip_atomic_load(cnt, __ATOMIC_RELAXED, __HIP_MEMORY_SCOPE_WORKGROUP) < target) __builtin_amdgcn_s_sleep(1);
  asm volatile("" ::: "memory");
}
#define HBAR() half_bar(cnt, target, lane)

struct Params {
  const float *x, *norm1_g, *w_in, *lam_q1, *lam_k1, *lam_q2, *lam_k2, *subln_g, *conv_dw_w, *conv_dw_b, *conv_ln_g, *conv_ln_b,
      *conv_pw_w, *conv_pw_b, *fnet_w, *fnet_b, *sgu_ln_g, *sgu_ln_b, *sgu_w, *sgu_b, *w_out, *norm2_g, *w_up, *w_down, *final_g;
  float* out;
  bf16_t *WallT, *WoutT, *WupT, *WdownT, *pwT, *sguW, *M1, *M3, *xn, *h, *Vt, *PQt, *y, *hid;
  float* lam;
  float* TW;
  float* part;
  int* ctr;
  unsigned* barw;
};

constexpr int HALF_B = 72960;
constexpr int SMEM_BYTES = 2 * HALF_B + 256;
constexpr int HALF_E = HALF_B / 2;
__shared__ __attribute__((aligned(16))) unsigned char smem_raw[SMEM_BYTES];
#define SMEM ((bf16_t*)smem_raw)
#define NI __device__ __forceinline__
DI int otid() { int t = threadIdx.x; asm volatile("" : "+v"(t)); return t; }
#define KPARAMS const Params& p = *(const Params*)__builtin_amdgcn_kernarg_segment_ptr()

namespace pg8 {
#define PG8_LAS __attribute__((address_space(3)))
typedef unsigned short bf16_t;
typedef short bf16x8 __attribute__((ext_vector_type(8)));
typedef float f32x4 __attribute__((ext_vector_type(4)));
typedef unsigned u32x4 __attribute__((ext_vector_type(4)));
constexpr int BM = 256, BK = 64, HALF = 128, HTB = HALF * BK * 2  , STAGE_BYTES = 8 * HTB, NXCD = 8, WGM = 8;

__host__ __device__ __forceinline__ int lds_byte(int r, int c) { const int st = (r >> 4) * 2 + (c >> 5), rr = r & 15, cc = c & 31, ob = rr * 64 + cc * 2; return st * 1024 + (ob ^ (((ob >> 9) & 1) << 5)); }
__host__ __device__ __forceinline__ void stage_rc(int b, int& R, int& C) { const int st = b / 1024, sb = b % 1024, swz = sb ^ (((sb >> 9) & 1) << 5); R = (st >> 1) * 16 + swz / 64; C = (st & 1) * 32 + (swz % 64) / 2; }
__host__ __device__ __forceinline__ int perm32(int rho) { const int n = rho >> 4, i = rho & 15; return 8 * (i >> 2) + 4 * n + (i & 3); }

struct Unit { int pm, pn; };
struct Gemm { const bf16_t* A; const bf16_t* Bt; int M, N, K; };

struct StaticOrder {
    int nM, nN, nwg, G, c;
    __host__ __device__ void init(int M, int N, int G_, int c_) { nM = M / BM; nN = N / BM; nwg = nM * nN; G = G_; c = c_; }
    __host__ __device__ bool next(int i, Unit& u) const {
        const long L = (long)i * G + c; if (L >= nwg) return false;
        int wgid = (int)L; { const int q = nwg / NXCD, r = nwg % NXCD, xcd = wgid % NXCD, off = wgid / NXCD; wgid = (xcd < r ? xcd * (q + 1) : r * (q + 1) + (xcd - r) * q) + off; }
        const int nig = WGM * nN, gid = wgid / nig, fm = gid * WGM, gsz = (nM - fm) < WGM ? (nM - fm) : WGM;
        u.pm = fm + ((wgid % nig) % gsz); u.pn = (wgid % nig) / gsz; return true;
    }
    __device__ __forceinline__ void a_ready(const Unit&) const {}
    __device__ __forceinline__ void done(const Unit&) const {}
};
template <class Epi, class Sched, bool ALIGN_EPI = false, bool SP2 = false>
__device__ __forceinline__ void gemm_phase(PG8_LAS unsigned char* lds, const Gemm g, const Sched& S, const Epi& E) {
    const int tid = otid(), wid = __builtin_amdgcn_readfirstlane(tid >> 6), lane = tid & 63, wr = wid >> 2, wc = wid & 3, fr = lane & 15, fq = lane >> 4;
    const int K = g.K, nt = K / BK;
    unsigned voffA[2], voffB[2];
#pragma unroll
    for (int i = 0; i < 2; ++i) { int R, C; stage_rc(tid * 16 + i * 8192, R, C); const int Rb = Epi::PERM ? ((R & ~31) + perm32(R & 31)) : R;
        voffA[i] = (unsigned)(R * K + C) * 2u; voffB[i] = (unsigned)(Rb * K + C) * 2u; }
    const size_t kstep = (size_t)(BK * 2);
    const size_t hstep = (size_t)HALF * K * 2;
    const size_t tstep = 2 * hstep;
    const unsigned ldsw = (unsigned)wid * 1024u;
    const int aoff = lds_byte(wr * 64 + fr, fq * 8), boff = lds_byte(wc * 32 + fr, fq * 8);
#define PG8_SA(b, h) (((b) * 2 + (h)) * HTB)
#define PG8_SB(b, h) ((4 + (b) * 2 + (h)) * HTB)
#define PG8_STAGE(bufoff, gbase, voff) do { _Pragma("unroll") for (int _i = 0; _i < 2; ++_i) \
        __builtin_amdgcn_global_load_lds((const unsigned*)((const char*)(gbase) + (voff)[_i]), (PG8_LAS unsigned*)(lds + (bufoff) + ldsw + _i * 8192), 16, 0, 0); } while (0)
#define PG8_LDA(dst, b, h) do { _Pragma("unroll") for (int m = 0; m < 4; ++m) _Pragma("unroll") for (int k = 0; k < 2; ++k) dst[m][k] = *(const PG8_LAS bf16x8*)(lds + PG8_SA(b, h) + aoff + m * 2048 + k * 1024); } while (0)
#define PG8_LDB(dst, b, h) do { _Pragma("unroll") for (int n = 0; n < 2; ++n) _Pragma("unroll") for (int k = 0; k < 2; ++k) dst[n][k] = *(const PG8_LAS bf16x8*)(lds + PG8_SB(b, h) + boff + n * 2048 + k * 1024); } while (0)
#define PG8_MMA(ai, bj, At, Bt) do { __builtin_amdgcn_s_setprio(1); _Pragma("unroll") for (int m = 0; m < 4; ++m) _Pragma("unroll") for (int n = 0; n < 2; ++n) _Pragma("unroll") for (int k = 0; k < 2; ++k) \
        acc[ai][bj][m][n] = __builtin_amdgcn_mfma_f32_16x16x32_bf16(Bt[n][k], At[m][k], acc[ai][bj][m][n], 0, 0, 0); __builtin_amdgcn_s_setprio(0); } while (0)
#define PG8_WAIT_V(n) asm volatile("s_waitcnt vmcnt(" #n ")" ::: "memory")
#define PG8_WAIT_L(n) asm volatile("s_waitcnt lgkmcnt(" #n ")" ::: "memory")
#define PG8_BAR __builtin_amdgcn_s_barrier()
#define PG8_SCHED __builtin_amdgcn_sched_barrier(0)
    Unit cur, nxt; int ui = 0;
    if (!S.next(0, cur)) return;
    f32x4 acc[2][2][4][2];
#pragma unroll
    for (int a = 0; a < 2; ++a)
#pragma unroll
        for (int b = 0; b < 2; ++b)
#pragma unroll
            for (int m = 0; m < 4; ++m)
#pragma unroll
                for (int n = 0; n < 2; ++n) acc[a][b][m][n] = (f32x4){0.f, 0.f, 0.f, 0.f};
    bf16x8 At[4][2], B0[2][2], B1[2][2];
    const char* cA = (const char*)g.A + (size_t)cur.pm * tstep; const char* cB = (const char*)g.Bt + (size_t)cur.pn * tstep;
    S.a_ready(cur);
    if constexpr (SP2) {
        PG8_STAGE(PG8_SB(0, 0), cB, voffB); PG8_STAGE(PG8_SB(0, 1), cB + hstep, voffB); PG8_STAGE(PG8_SA(0, 0), cA, voffA); PG8_STAGE(PG8_SA(0, 1), cA + hstep, voffA);
        if (wr == 1) PG8_BAR;
        PG8_WAIT_V(2); PG8_BAR;
        PG8_STAGE(PG8_SB(1, 0), cB + kstep, voffB); PG8_STAGE(PG8_SA(1, 0), cA + kstep, voffA); PG8_STAGE(PG8_SB(1, 1), cB + hstep + kstep, voffB);
        PG8_WAIT_V(6); PG8_BAR;
    } else {
        PG8_STAGE(PG8_SB(0, 0), cB, voffB); PG8_STAGE(PG8_SA(0, 0), cA, voffA); PG8_STAGE(PG8_SB(0, 1), cB + hstep, voffB); PG8_STAGE(PG8_SA(0, 1), cA + hstep, voffA);
        if (wr == 1) PG8_BAR;
        PG8_WAIT_V(4); PG8_BAR;
        PG8_STAGE(PG8_SB(1, 0), cB + kstep, voffB); PG8_STAGE(PG8_SA(1, 0), cA + kstep, voffA); PG8_STAGE(PG8_SB(1, 1), cB + hstep + kstep, voffB);
        PG8_WAIT_V(6); PG8_BAR;
    }
    for (;;) {
        const bool has_next = S.next(ui + 1, nxt);
        const char* nA = has_next ? (const char*)g.A + (size_t)nxt.pm * tstep : cA; const char* nB = has_next ? (const char*)g.Bt + (size_t)nxt.pn * tstep : cB;
        for (int t = 0; t < nt; t += 2) {
            const bool last = (t == nt - 2);
            const char* a1 = cA + (size_t)(t + 1) * kstep;
            const char* a2 = last ? nA : cA + (size_t)(t + 2) * kstep; const char* b2 = last ? nB : cB + (size_t)(t + 2) * kstep;
            const char* a3 = a2 + kstep; const char* b3 = b2 + kstep;
            if (last && has_next) S.a_ready(nxt);
            if constexpr (SP2) {
            PG8_LDB(B0, 0, 0); PG8_LDB(B1, 0, 1); PG8_SCHED; PG8_LDA(At, 0, 0); PG8_STAGE(PG8_SA(1, 1), a1 + hstep, voffA);
            PG8_WAIT_V(8); PG8_WAIT_L(0); PG8_BAR; PG8_MMA(0, 0, At, B0); PG8_MMA(0, 1, At, B1); PG8_BAR; PG8_SCHED;
            PG8_LDA(At, 0, 1); PG8_STAGE(PG8_SB(0, 0), b2, voffB); PG8_STAGE(PG8_SB(0, 1), b2 + hstep, voffB); PG8_STAGE(PG8_SA(0, 0), a2, voffA);
            PG8_WAIT_V(8); PG8_WAIT_L(0); PG8_BAR; PG8_MMA(1, 0, At, B0); PG8_MMA(1, 1, At, B1); PG8_BAR; PG8_SCHED;
            PG8_LDB(B0, 1, 0); PG8_LDB(B1, 1, 1); PG8_SCHED; PG8_LDA(At, 1, 0); PG8_STAGE(PG8_SA(0, 1), a2 + hstep, voffA);
            PG8_WAIT_V(8); PG8_WAIT_L(0); PG8_BAR; PG8_MMA(0, 0, At, B0); PG8_MMA(0, 1, At, B1); PG8_BAR; PG8_SCHED;
            PG8_LDA(At, 1, 1); PG8_STAGE(PG8_SB(1, 0), b3, voffB); PG8_STAGE(PG8_SB(1, 1), b3 + hstep, voffB); PG8_STAGE(PG8_SA(1, 0), a3, voffA);
            PG8_WAIT_V(8); PG8_WAIT_L(0); PG8_BAR; PG8_MMA(1, 0, At, B0); PG8_MMA(1, 1, At, B1); PG8_BAR; PG8_SCHED;
            } else {
            PG8_LDB(B0, 0, 0); PG8_SCHED; PG8_LDA(At, 0, 0); PG8_STAGE(PG8_SA(1, 1), a1 + hstep, voffA);
            PG8_WAIT_L(8); PG8_BAR; PG8_WAIT_L(0); PG8_MMA(0, 0, At, B0); PG8_BAR; PG8_SCHED;
            PG8_LDB(B1, 0, 1); PG8_STAGE(PG8_SB(0, 0), b2, voffB);
            PG8_BAR; PG8_WAIT_L(0); PG8_MMA(0, 1, At, B1); PG8_BAR;
            PG8_LDA(At, 0, 1); PG8_STAGE(PG8_SA(0, 0), a2, voffA);
            PG8_BAR; PG8_WAIT_L(0); PG8_MMA(1, 0, At, B0); PG8_BAR; PG8_SCHED;
            PG8_STAGE(PG8_SB(0, 1), b2 + hstep, voffB);
            PG8_WAIT_V(6); PG8_BAR; PG8_MMA(1, 1, At, B1); PG8_BAR;
            PG8_LDB(B0, 1, 0); PG8_SCHED; PG8_LDA(At, 1, 0); PG8_STAGE(PG8_SA(0, 1), a2 + hstep, voffA);
            PG8_WAIT_L(8); PG8_BAR; PG8_WAIT_L(0); PG8_MMA(0, 0, At, B0); PG8_BAR; PG8_SCHED;
            PG8_LDB(B1, 1, 1); PG8_STAGE(PG8_SB(1, 0), b3, voffB);
            PG8_BAR; PG8_WAIT_L(0); PG8_MMA(0, 1, At, B1); PG8_BAR;
            PG8_LDA(At, 1, 1); PG8_STAGE(PG8_SA(1, 0), a3, voffA);
            PG8_BAR; PG8_WAIT_L(0); PG8_MMA(1, 0, At, B0); PG8_BAR; PG8_SCHED;
            PG8_STAGE(PG8_SB(1, 1), b3 + hstep, voffB);
            PG8_WAIT_V(6); PG8_BAR; PG8_MMA(1, 1, At, B1); PG8_BAR;
            }
        }
        if constexpr (ALIGN_EPI) { if (wr == 0) PG8_BAR; }
        if constexpr (!Epi::AFTER_DRAIN) { E(acc, cur, wr, wc, fr, fq); S.done(cur); }
        if (!has_next) break;
#pragma unroll
        for (int a = 0; a < 2; ++a)
#pragma unroll
            for (int b = 0; b < 2; ++b)
#pragma unroll
                for (int m = 0; m < 4; ++m)
#pragma unroll
                    for (int n = 0; n < 2; ++n) acc[a][b][m][n] = (f32x4){0.f, 0.f, 0.f, 0.f};
        cur = nxt; cA = nA; cB = nB; ++ui;
        if constexpr (ALIGN_EPI) { if (wr == 1) PG8_BAR; }
    }
    PG8_WAIT_V(0);
    if constexpr (!ALIGN_EPI) { if (wr == 0) PG8_BAR; }
    PG8_BAR;
    if constexpr (Epi::AFTER_DRAIN) { E.fused(acc, cur, wr, wc, fr, fq, lds, wid, lane); S.done(cur); }
#undef PG8_SA
#undef PG8_SB
#undef PG8_STAGE
#undef PG8_LDA
#undef PG8_LDB
#undef PG8_MMA
#undef PG8_WAIT_V
#undef PG8_WAIT_L
#undef PG8_BAR
#undef PG8_SCHED
}
}

template <class F> struct Epi8 {
  static constexpr bool PERM = true, AFTER_DRAIN = false;
  F f;
  DI void operator()(const pg8::f32x4 (&acc)[2][2][4][2], const pg8::Unit& u, int wr, int wc, int fr, int fq) const {
#pragma unroll
    for (int ai = 0; ai < 2; ++ai)
#pragma unroll
      for (int m = 0; m < 4; ++m) {
        const int row = u.pm * 256 + ai * 128 + wr * 64 + m * 16 + fr;
#pragma unroll
        for (int bj = 0; bj < 2; ++bj) f.st(row, u.pn * 256 + bj * 128 + wc * 32 + 8 * fq, acc[ai][bj][m][0], acc[ai][bj][m][1]);
      }
  }
};
#define LDSP ((__attribute__((address_space(3))) unsigned char*)smem_raw)
DI float row_rs(const float* __restrict__ part, int row) {
  const f32x4 a = *(const f32x4*)(part + (long)row * 16), b = *(const f32x4*)(part + (long)row * 16 + 4), c = *(const f32x4*)(part + (long)row * 16 + 8), d = *(const f32x4*)(part + (long)row * 16 + 12);
  const f32x4 s = (a + b) + (c + d);
  return rsqrtf(((s[0] + s[1]) + (s[2] + s[3])) * (1.f / 1024.f) + EPS);
}
template <class F> struct Epi8Rows {
  static constexpr bool PERM = true, AFTER_DRAIN = false;
  F f; const float* part;
  DI void operator()(const pg8::f32x4 (&acc)[2][2][4][2], const pg8::Unit& u, int wr, int wc, int fr, int fq) const {
    const int x32 = (((fq * 16 + fr) ^ 32) << 2);
#pragma unroll
    for (int ai = 0; ai < 2; ++ai)
#pragma unroll
      for (int m = 0; m < 4; ++m) {
        const int row = u.pm * 256 + ai * 128 + wr * 64 + m * 16 + fr;
        const f32x4 pp = *(const f32x4*)(part + (long)row * 16 + fq * 4);
        float sq = (pp[0] + pp[1]) + (pp[2] + pp[3]);
        sq += __builtin_bit_cast(float, __builtin_amdgcn_ds_swizzle(__builtin_bit_cast(int, sq), 0x401f));
        sq += xch32(sq, x32);
        const float rs = rsqrtf(sq * (1.f / 1024.f) + EPS);
#pragma unroll
        for (int bj = 0; bj < 2; ++bj) f.st(row, u.pn * 256 + bj * 128 + wc * 32 + 8 * fq, acc[ai][bj][m][0] * rs, acc[ai][bj][m][1] * rs);
      }
  }
};
template <class F> struct Epi8Cols {
  static constexpr bool PERM = true, AFTER_DRAIN = false;
  F f; const float* part;
  DI void operator()(const pg8::f32x4 (&acc)[2][2][4][2], const pg8::Unit& u, int wr, int wc, int fr, int fq) const {
    f32x4 r0[2], r1[2];
    const float rsl = row_rs(part, u.pn * 256 + (fr >> 3) * 128 + wc * 32 + 8 * fq + (fr & 7));
#pragma unroll
    for (int bj = 0; bj < 2; ++bj)
#pragma unroll
      for (int j = 0; j < 4; ++j) {
        r0[bj][j] = __builtin_bit_cast(float, __builtin_amdgcn_ds_bpermute(4 * (fq * 16 + bj * 8 + j), __builtin_bit_cast(int, rsl)));
        r1[bj][j] = __builtin_bit_cast(float, __builtin_amdgcn_ds_bpermute(4 * (fq * 16 + bj * 8 + 4 + j), __builtin_bit_cast(int, rsl)));
      }
#pragma unroll
    for (int ai = 0; ai < 2; ++ai)
#pragma unroll
      for (int m = 0; m < 4; ++m) {
        const int row = u.pm * 256 + ai * 128 + wr * 64 + m * 16 + fr;
#pragma unroll
        for (int bj = 0; bj < 2; ++bj) f.st(row, u.pn * 256 + bj * 128 + wc * 32 + 8 * fq, acc[ai][bj][m][0] * r0[bj], acc[ai][bj][m][1] * r1[bj]);
      }
  }
};
struct Epi8Res {
  static constexpr bool PERM = true, AFTER_DRAIN = false;
  bf16_t* xb; float* part; float accscale;
  DI void operator()(const pg8::f32x4 (&acc)[2][2][4][2], const pg8::Unit& u, int wr, int wc, int fr, int fq) const {
    const int x32 = (((fq * 16 + fr) ^ 32) << 2);
#pragma unroll
    for (int ai = 0; ai < 2; ++ai)
#pragma unroll
      for (int m = 0; m < 4; ++m) {
        const int row = u.pm * 256 + ai * 128 + wr * 64 + m * 16 + fr;
        float ss = 0.f;
#pragma unroll
        for (int bj = 0; bj < 2; ++bj) {
          const long o = (long)row * DM + u.pn * 256 + bj * 128 + wc * 32 + 8 * fq;
          const u32x4 xr = *(const u32x4*)(xb + o);
          f32x4 v0, v1;
          v0[0] = bflo(xr[0]); v0[1] = bfhi(xr[0]); v0[2] = bflo(xr[1]); v0[3] = bfhi(xr[1]);
          v1[0] = bflo(xr[2]); v1[1] = bfhi(xr[2]); v1[2] = bflo(xr[3]); v1[3] = bfhi(xr[3]);
          v0 = v0 + acc[ai][bj][m][0] * accscale; v1 = v1 + acc[ai][bj][m][1] * accscale;
          u32x4 w; w[0] = pk2(v0[0], v0[1]); w[1] = pk2(v0[2], v0[3]); w[2] = pk2(v1[0], v1[1]); w[3] = pk2(v1[2], v1[3]);
          *(u32x4*)(xb + o) = w;
          ss += (v0[0] * v0[0] + v0[1] * v0[1]) + (v0[2] * v0[2] + v0[3] * v0[3]) + (v1[0] * v1[0] + v1[1] * v1[1]) + (v1[2] * v1[2] + v1[3] * v1[3]);
        }
        ss += __builtin_bit_cast(float, __builtin_amdgcn_ds_swizzle(__builtin_bit_cast(int, ss), 0x401f));
        ss += xch32(ss, x32);
        if (fq == 0) part[(long)row * 16 + u.pn * 4 + wc] = ss;
      }
  }
};
template <class E> DI void run_gemm_e(const bf16_t* A, const bf16_t* Bt, int M, int N, int K, const E& e) {
  pg8::Gemm g{A, Bt, M, N, K};
  pg8::StaticOrder so; so.init(M, N, (int)gridDim.x, (int)blockIdx.x);
  pg8::gemm_phase<E, pg8::StaticOrder, true, true>(LDSP, g, so, e);
}
template <class F> DI void run_gemm(const bf16_t* A, const bf16_t* Bt, int M, int N, int K, const F& f) {
  pg8::Gemm g{A, Bt, M, N, K};
  pg8::StaticOrder so; so.init(M, N, (int)gridDim.x, (int)blockIdx.x);
  Epi8<F> e{f};
  pg8::gemm_phase<Epi8<F>, pg8::StaticOrder, true, true>(LDSP, g, so, e);
}
struct OneUnit { int pm, pn;
  DI bool next(int i, pg8::Unit& u) const { if (i) return false; u.pm = pm; u.pn = pn; return true; }
  DI void a_ready(const pg8::Unit&) const {}
  DI void done(const pg8::Unit&) const {} };

DI void tr_tile(const float* __restrict__ src, int lds_, int k0, int n0, bf16_t* __restrict__ dst, int ldd, int nd0, float scale, float* sm, const float* __restrict__ gk = nullptr) {
  const int t = otid() & 255;
#pragma unroll
  for (int i = 0; i < 4; ++i) {
    const int kr = (t >> 4) + 16 * i, nc = (t & 15) * 4;
    f32x4 v = *(const f32x4*)(src + (long)(k0 + kr) * lds_ + n0 + nc);
    if (gk) v = v * gk[k0 + kr];
    sm[kr * 65 + nc + 0] = v[0]; sm[kr * 65 + nc + 1] = v[1]; sm[kr * 65 + nc + 2] = v[2]; sm[kr * 65 + nc + 3] = v[3];
  }
  __syncthreads();
  const int n = t >> 2, ks = (t & 3) * 16;
  u32x4 w0, w1;
#pragma unroll
  for (int j = 0; j < 4; ++j) {
    w0[j] = pk2(sm[(ks + 2 * j) * 65 + n] * scale, sm[(ks + 2 * j + 1) * 65 + n] * scale);
    w1[j] = pk2(sm[(ks + 8 + 2 * j) * 65 + n] * scale, sm[(ks + 8 + 2 * j + 1) * 65 + n] * scale);
  }
  bf16_t* d = dst + (long)(nd0 + n) * ldd + k0 + ks;
  *(u32x4*)d = w0; *(u32x4*)(d + 8) = w1;
  __syncthreads();
}

constexpr int NT_ALL = DEPTH * 28 * 16, NT_OUT = DEPTH * 16 * 16, NT_UP = DEPTH * 64 * 16, NT_DOWN = DEPTH * 16 * 64, NT_PW = DEPTH * 4 * 4;
constexpr int N_FOLD = DEPTH * 2 * 4 * 4, N_SGU = 128, N_DM = 112, N_LAM = 1;
constexpr int PREP_ITEMS = NT_ALL + NT_OUT + NT_UP + NT_DOWN + NT_PW + N_FOLD + N_SGU + N_DM + N_LAM;

DI void prep_item(const Params& p, int it, float* sm) {
  const int t = otid() & 255;
  if (it < NT_ALL) {
    const int l = it / (28 * 16), rem = it % (28 * 16), nt = rem / 16, kt = rem % 16;
    const int nd = nt * 64;
    int nsrc; float scale = 1.f;
    if (nd < 512) { nsrc = nd; if (nd < 256) scale = 0.17677669529663687f * LOG2E; }
    else if (nd < 1024) nsrc = 768 + (nd - 512);
    else if (nd < 1536) nsrc = 1536 + (nd - 1024);
    else nsrc = 512 + (nd - 1536);
    tr_tile(p.w_in + (long)l * DM * 2048, 2048, kt * 64, nsrc, p.WallT + (long)l * WALL_N * DM, DM, nd, scale, sm, p.norm1_g + l * DM);
    return;
  }
  it -= NT_ALL;
  if (it < NT_OUT) {
    const int l = it / 256, rem = it % 256, nt = rem / 16, kt = rem % 16;
    tr_tile(p.w_out + (long)l * DM * DM, DM, kt * 64, nt * 64, p.WoutT + (long)l * DM * DM, DM, nt * 64, 1.f, sm);
    return;
  }
  it -= NT_OUT;
  if (it < NT_UP) {
    const int l = it / 1024, rem = it % 1024, nt = rem / 16, kt = rem % 16;
    tr_tile(p.w_up + (long)l * DM * DFF, DFF, kt * 64, nt * 64, p.WupT + (long)l * DFF * DM, DM, nt * 64, 1.f, sm, p.norm2_g + l * DM);
    return;
  }
  it -= NT_UP;
  if (it < NT_DOWN) {
    const int l = it / 1024, rem = it % 1024, nt = rem / 64, kt = rem % 64;
    tr_tile(p.w_down + (long)l * DFF * DM, DM, kt * 64, nt * 64, p.WdownT + (long)l * DM * DFF, DFF, nt * 64, 1.f, sm);
    return;
  }
  it -= NT_DOWN;
  if (it < NT_PW) {
    const int l = it / 16, rem = it % 16, nt = rem / 4, kt = rem % 4;
    tr_tile(p.conv_pw_w + (long)l * 65536, 256, kt * 64, nt * 64, p.pwT + (long)l * 65536, 256, nt * 64, 1.f, sm);
    return;
  }
  it -= NT_PW;
  if (it < N_FOLD) {
    const int l = it >> 5, pq = (it >> 4) & 1, g = (it >> 2) & 3, kcn = it & 3;
    const float* fw = p.fnet_w + ((long)l * 4 + g) * 4096;
    for (int idx = t; idx < 4096; idx += 256) {
      const int c = idx >> 6, e = idx & 63;
      float s = 0.f;
      for (int kc = 0; kc < 64; ++kc) {
        const int m = (c * kc) & 63;
        const float tr = pq ? sinpif((float)m * (1.f / 32.f)) : cospif((float)m * (1.f / 32.f));
        s += tr * fw[kc * 64 + e];
      }
      sm[idx] = s * (1.f / 512.f);
    }
    __syncthreads();
    const int k = kcn * 256 + t;
    const float gk1 = p.norm1_g[l * DM + k];
    const float* wr = p.w_in + (long)l * DM * 2048 + (long)k * 2048 + 1280 + g * 64;
    f32x4 wv[16];
#pragma unroll
    for (int i = 0; i < 16; ++i) wv[i] = *(const f32x4*)(wr + 4 * i);
    bf16_t* dst = p.WallT + (long)l * WALL_N * DM + (long)(1792 + pq * 256 + g * 64) * DM + k;
#pragma unroll 1
    for (int e = 0; e < 64; ++e) {
      float s = 0.f;
#pragma unroll
      for (int i = 0; i < 16; ++i) {
        s += wv[i][0] * sm[(4 * i + 0) * 64 + e]; s += wv[i][1] * sm[(4 * i + 1) * 64 + e];
        s += wv[i][2] * sm[(4 * i + 2) * 64 + e]; s += wv[i][3] * sm[(4 * i + 3) * 64 + e];
      }
      dst[(long)e * DM] = (bf16_t)(pk2(s * gk1, 0.f) & 0xffffu);
    }
    __syncthreads();
    return;
  }
  it -= N_FOLD;
  if (it < N_SGU) {
    const long o = (long)it * 2048 + t * 8;
    const f32x4 a = *(const f32x4*)(p.sgu_w + o), b = *(const f32x4*)(p.sgu_w + o + 4);
    u32x4 w; w[0] = pk2(a[0], a[1]); w[1] = pk2(a[2], a[3]); w[2] = pk2(b[0], b[1]); w[3] = pk2(b[2], b[3]);
    *(u32x4*)(p.sguW + o) = w;
    return;
  }
  it -= N_SGU;
  if (it < N_DM) {
    const int e = it * 256 + t;
    if (e < 16384) {
      const int m = e >> 7, k = e & 127, ro = m >> 6, k1 = m & 63, ri = k >> 6, s1 = k & 63;
      const float ang = (float)((s1 * k1) & 63) * (1.f / 32.f);
      const float c = cospif(ang), sn = sinpif(ang);
      const float v = (ro == 0) ? (ri == 0 ? c : -sn) : (ri == 0 ? sn : c);
      p.M1[e] = (bf16_t)(pk2(v, 0.f) & 0xffffu);
    } else if (e < 16384 + 8192) {
      const int e2 = e - 16384, k2 = e2 >> 7, k = e2 & 127, ri = k >> 6, s2 = k & 63;
      const float ang = (float)((s2 * k2) & 63) * (1.f / 32.f);
      const float v = (ri == 0) ? cospif(ang) : -sinpif(ang);
      p.M3[e2] = (bf16_t)(pk2(v, 0.f) & 0xffffu);
    } else {
      const int e3 = e - 16384 - 8192, k1 = e3 >> 6, s2 = e3 & 63;
      const float ang = (float)(s2 * k1) * (1.f / 2048.f);
      ((unsigned*)p.TW)[e3] = pk2(cospif(ang), sinpif(ang));
    }
    return;
  }
  it -= N_DM;
  if (t < DEPTH) {
    const int l = t;
    float s1 = 0.f, s2 = 0.f;
    for (int i = 0; i < 32; ++i) { s1 += p.lam_q1[l * 32 + i] * p.lam_k1[l * 32 + i]; s2 += p.lam_q2[l * 32 + i] * p.lam_k2[l * 32 + i]; }
    const float lam_init = 0.8f - 0.6f * expf(-0.3f * (float)l);
    p.lam[l] = expf(s1) - expf(s2) + lam_init;
  }
}

NI void prep_phase() {
  KPARAMS;
  const int half = otid() >> 8;
  float* sm = (float*)smem_raw + half * (HALF_E / 2);
  for (int it0 = blockIdx.x * 2 + half; it0 < PREP_ITEMS; it0 += gridDim.x * 2) prep_item(p, it0, sm);
  const int tid_ = otid(); const int lane = tid_ & 63, wid = tid_ >> 6, x32 = ((lane ^ 32) << 2);
  for (int row = blockIdx.x * 8 + wid; row < NTOK; row += gridDim.x * 8) {
    const float* sp = p.x + (long)row * DM;
    float ss = 0.f;
#pragma unroll
    for (int i = 0; i < 4; ++i) {
      const f32x4 v = *(const f32x4*)(sp + lane * 4 + 256 * i);
      ss += v[0] * v[0] + v[1] * v[1] + v[2] * v[2] + v[3] * v[3];
      u32x2 w; w[0] = pk2(v[0], v[1]); w[1] = pk2(v[2], v[3]); *(u32x2*)(p.xn + (long)row * DM + lane * 4 + 256 * i) = w;
    }
    ss = wave_sum(ss, x32);
    if (lane < 16) p.part[(long)row * 16 + lane] = (lane == 0) ? ss : 0.f;
  }
}

NI void final_rms_phase(const bf16_t* __restrict__ src, const float* __restrict__ g, float* __restrict__ dstf) {
  const int tid_ = otid(); const int lane = tid_ & 63, wid = tid_ >> 6, x32 = ((lane ^ 32) << 2);
  f32x4 gv[4];
#pragma unroll
  for (int i = 0; i < 4; ++i) gv[i] = *(const f32x4*)(g + lane * 4 + 256 * i);
  for (int row = blockIdx.x * 8 + wid; row < NTOK; row += gridDim.x * 8) {
    f32x4 v[4];
    float ss = 0.f;
#pragma unroll
    for (int i = 0; i < 4; ++i) {
      const u32x2 r = *(const u32x2*)(src + (long)row * DM + lane * 4 + 256 * i);
      v[i][0] = bflo(r[0]); v[i][1] = bfhi(r[0]); v[i][2] = bflo(r[1]); v[i][3] = bfhi(r[1]);
      ss += v[i][0] * v[i][0] + v[i][1] * v[i][1] + v[i][2] * v[i][2] + v[i][3] * v[i][3];
    }
    ss = wave_sum(ss, x32);
    const float rs = rsqrtf(ss * (1.f / 1024.f) + EPS);
#pragma unroll
    for (int i = 0; i < 4; ++i) *(f32x4*)(dstf + (long)row * DM + lane * 4 + 256 * i) = v[i] * rs * gv[i];
  }
}

DI u32x4 pk8(f32x4 a, f32x4 b) { u32x4 w; w[0] = pk2(a[0], a[1]); w[1] = pk2(a[2], a[3]); w[2] = pk2(b[0], b[1]); w[3] = pk2(b[2], b[3]); return w; }
struct StH { bf16_t* h; DI void st(int r, int c, f32x4 a, f32x4 b) const { *(u32x4*)(h + (long)r * HC + c) = pk8(a, b); } };
struct StT { bf16_t* Vt; bf16_t* PQt;
  DI void st(int n, int tok, f32x4 a, f32x4 b) const {
    const int bb = tok >> 12, s = tok & 4095; const u32x4 w = pk8(a, b);
    if (n < 256) *(u32x4*)(Vt + ((long)(bb * 256 + n)) * 4096 + s) = w;
    else { const int np = n - 256, pq = np >> 8, ch = np & 255; *(u32x4*)(PQt + ((long)(bb * 256 + ch)) * 8192 + pq * 4096 + s) = w; }
  } };
struct StRes { const float* xin; float* out;
  DI void st(int r, int c, f32x4 a, f32x4 b) const { const long o = (long)r * DM + c; const f32x4 x0 = *(const f32x4*)(xin + o), x1 = *(const f32x4*)(xin + o + 4); *(f32x4*)(out + o) = x0 + a; *(f32x4*)(out + o + 4) = x1 + b; } };
struct StUp { bf16_t* hid;
  DI void st(int r, int c, f32x4 a, f32x4 b) const {
#pragma unroll
    for (int j = 0; j < 4; ++j) { a[j] = fmaxf(a[j], 0.f); b[j] = fmaxf(b[j], 0.f); }
    *(u32x4*)(hid + (long)r * DFF + c) = pk8(a * a, b * b); } };

NI void gemm_in_phase(int l) {
  KPARAMS;
  const bf16_t* W = p.WallT + (long)l * WALL_N * DM;
  run_gemm_e(p.xn, W, NTOK, HC, DM, Epi8Rows<StH>{StH{p.h}, p.part});
  run_gemm_e(W + (long)HC * DM, p.xn, 768, NTOK, DM, Epi8Cols<StT>{StT{p.Vt, p.PQt}, p.part});
}
NI void gemm_out_phase(int l, float accscale) {
  KPARAMS;
  run_gemm_e(p.y, p.WoutT + (long)l * DM * DM, NTOK, DM, DM, Epi8Res{p.xn, p.part, accscale});
}
NI void gemm_up_phase(int l) {
  KPARAMS;
  run_gemm_e(p.xn, p.WupT + (long)l * DFF * DM, NTOK, DFF, DM, Epi8Rows<StUp>{StUp{p.hid}, p.part});
}
NI void gemm_down_phase(int l, float accscale) {
  KPARAMS;
  run_gemm_e(p.hid, p.WdownT + (long)l * DM * DFF, NTOK, DM, DFF, Epi8Res{p.xn, p.part, accscale});
}

constexpr int ARS = 72;
constexpr int ATILE = 64 * ARS;
NI void attn_tile(int l, int id, LAS3 unsigned* cnt, unsigned& target) {
  KPARAMS;
  const int tidf = otid(), half = __builtin_amdgcn_readfirstlane(tidf >> 8), tid = tidf & 255, lane = tid & 63, wid = __builtin_amdgcn_readfirstlane(tid >> 6), r = lane & 31, hh = lane >> 5, x32 = ((lane ^ 32) << 2);
  bf16_t* smem = SMEM + half * HALF_E;
  const int head = 3 - (id >> 8), b = (id >> 5) & 7, qb = id & 31;
  const float slope = (head == 0) ? 0.25f : (head == 1) ? 0.0625f : (head == 2) ? 0.015625f : 0.00390625f;
  const float ncs = -slope * LOG2E, cs = slope * LOG2E;
  const int qi = qb * 128 + wid * 32 + r;
  const bf16_t* qrow = p.h + ((long)(b * SEQ + qi)) * HC + head * 64;
  bf16x8 qf[2][2];
#pragma unroll
  for (int m = 0; m < 2; ++m)
#pragma unroll
    for (int s = 0; s < 2; ++s) qf[m][s] = *(const bf16x8*)(qrow + m * 32 + s * 16 + hh * 8);
  const bf16_t* kbase = p.h + ((long)(b * SEQ)) * HC + 256 + head * 64;
  const bf16_t* vbase = p.Vt + ((long)((b * 4 + head) * 64)) * SEQ;
  const int srow = tid >> 3, scol = (tid & 7) * 8;
  u32x4 rk[2], rv[2];
  f32x16 O[2][2];
#pragma unroll
  for (int m = 0; m < 2; ++m)
#pragma unroll
    for (int vb = 0; vb < 2; ++vb)
#pragma unroll
      for (int i = 0; i < 16; ++i) O[m][vb][i] = 0.f;
  float mrun[2] = {0.f, 0.f}, lrun[2] = {0.f, 0.f};
  const int kperm = (r & 19) | ((r & 4) << 1) | ((r & 8) >> 1);
  const int ktd = (qb * 128 + wid * 32) >> 6;
  unsigned csw, jrelw[2];
  { const unsigned h_ = pk2(cs, 0.f) & 0xffffu; csw = h_ | (pk2(cs - bflo(h_), 0.f) << 16); }
#pragma unroll
  for (int kb = 0; kb < 2; ++kb) { const float j_ = (float)(kb * 32 + kperm); jrelw[kb] = pk2(j_, j_); }

  const int wkeys = (head == 0) ? 305 : (head == 1) ? 1220 : SEQ;
  const int kt_lo = max(0, qb * 128 - wkeys) >> 6, kt_hi = min(SEQ, qb * 128 + 128 + wkeys + 63) >> 6;
#pragma unroll
  for (int i = 0; i < 2; ++i) {
    rk[i] = *(const u32x4*)(kbase + (long)(kt_lo * 64 + srow + 32 * i) * HC + scol);
    rv[i] = *(const u32x4*)(vbase + (long)(srow + 32 * i) * SEQ + kt_lo * 64 + scol);
  }
#pragma unroll
  for (int i = 0; i < 2; ++i) { *(u32x4*)(smem + (srow + 32 * i) * ARS + scol) = rk[i]; *(u32x4*)(smem + ATILE + (srow + 32 * i) * ARS + scol) = rv[i]; }
  asm volatile("" :: "v"(qf[0][0]), "v"(qf[0][1]), "v"(qf[1][0]), "v"(qf[1][1]));
  HBAR();
  for (int kt = kt_lo; kt < kt_hi; ++kt) {
    const bool more = (kt + 1) < kt_hi;
    if (more) {
#pragma unroll
      for (int i = 0; i < 2; ++i) {
        rk[i] = *(const u32x4*)(kbase + (long)((kt + 1) * 64 + srow + 32 * i) * HC + scol);
        rv[i] = *(const u32x4*)(vbase + (long)(srow + 32 * i) * SEQ + (kt + 1) * 64 + scol);
      }
    }
    const bf16_t* Ks = smem + ((kt - kt_lo) & 1) * 2 * ATILE;
    const bf16_t* Vs = Ks + ATILE;
    const float dbase = (float)(qi - kt * 64 - 8 * hh);
    const bool diag = (kt == ktd);
#pragma unroll
    for (int m = 0; m < 2; ++m) {
      __builtin_amdgcn_sched_barrier(0);
      f32x16 x[2];
      if (!diag) {
        const bool left = kt < ktd;
        const float C = fmaf(left ? cs : -cs, (float)(kt * 64 - qi), -mrun[m]);
        const unsigned wC = pk2(C, 0.f), wL = pk2(C - bflo(wC), 0.f);
        u32x4 qa; qa[0] = hh ? 0u : (left ? csw : (csw ^ 0x80008000u)); qa[1] = hh ? 0u : ((wC & 0xffffu) | (wL << 16)); qa[2] = 0u; qa[3] = 0u;
#pragma unroll
        for (int kb = 0; kb < 2; ++kb) {
          u32x4 ka; ka[0] = hh ? 0u : jrelw[kb]; ka[1] = hh ? 0u : 0x3f803f80u; ka[2] = 0u; ka[3] = 0u;
#pragma unroll
          for (int i = 0; i < 16; ++i) x[kb][i] = 0.f;
          x[kb] = __builtin_amdgcn_mfma_f32_32x32x16_bf16(__builtin_bit_cast(bf16x8, ka), __builtin_bit_cast(bf16x8, qa), x[kb], 0, 0, 0);
#pragma unroll
          for (int s = 0; s < 2; ++s) {
            const bf16x8 kf = *(const bf16x8*)(Ks + (kb * 32 + kperm) * ARS + m * 32 + s * 16 + hh * 8);
            x[kb] = __builtin_amdgcn_mfma_f32_32x32x16_bf16(kf, qf[m][s], x[kb], 0, 0, 0);
          }
        }
      } else {
#pragma unroll
        for (int kb = 0; kb < 2; ++kb) {
#pragma unroll
          for (int i = 0; i < 16; ++i) x[kb][i] = 0.f;
#pragma unroll
          for (int s = 0; s < 2; ++s) {
            const bf16x8 kf = *(const bf16x8*)(Ks + (kb * 32 + kperm) * ARS + m * 32 + s * 16 + hh * 8);
            x[kb] = __builtin_amdgcn_mfma_f32_32x32x16_bf16(kf, qf[m][s], x[kb], 0, 0, 0);
          }
        }
        const float nm = -mrun[m];
#pragma unroll
        for (int kb = 0; kb < 2; ++kb)
#pragma unroll
          for (int i = 0; i < 16; ++i) {
            const float off = (float)(kb * 32 + 16 * (i >> 3) + (i & 7));
            x[kb][i] = fmaf(ncs, fabsf(dbase - off), x[kb][i]) + nm;
          }
      }
      float mx = -1e30f;
#pragma unroll
      for (int kb = 0; kb < 2; ++kb)
#pragma unroll
        for (int i = 0; i < 16; ++i) mx = fmaxf(mx, x[kb][i]);
      mx = fmaxf(mx, xch32(mx, x32));
      if (__builtin_amdgcn_ballot_w64(mx > 8.f) != 0ull) {
        const float delta = fmaxf(mx, 0.f);
        const float alpha = __builtin_amdgcn_exp2f(-delta);
        mrun[m] += delta;
        lrun[m] *= alpha;
#pragma unroll
        for (int vb = 0; vb < 2; ++vb)
#pragma unroll
          for (int i = 0; i < 16; ++i) O[m][vb][i] *= alpha;
#pragma unroll
        for (int kb = 0; kb < 2; ++kb)
#pragma unroll
          for (int i = 0; i < 16; ++i) x[kb][i] -= delta;
      }
      float ps = 0.f;
#pragma unroll
      for (int kb = 0; kb < 2; ++kb)
#pragma unroll
        for (int i = 0; i < 16; ++i) { x[kb][i] = __builtin_amdgcn_exp2f(x[kb][i]); ps += x[kb][i]; }
      lrun[m] += ps;
#pragma unroll
      for (int kb = 0; kb < 2; ++kb)
#pragma unroll
        for (int s = 0; s < 2; ++s) {
          u32x4 pw;
#pragma unroll
          for (int j = 0; j < 4; ++j) pw[j] = pk2(x[kb][8 * s + 2 * j], x[kb][8 * s + 2 * j + 1]);
          const bf16x8 pf = __builtin_bit_cast(bf16x8, pw);
#pragma unroll
          for (int vb = 0; vb < 2; ++vb) {
            const bf16x8 vf = *(const bf16x8*)(Vs + (vb * 32 + r) * ARS + kb * 32 + s * 16 + hh * 8);
            O[m][vb] = __builtin_amdgcn_mfma_f32_32x32x16_bf16(vf, pf, O[m][vb], 0, 0, 0);
          }
        }
    }
    if (more) {
      bf16_t* wk = smem + ((kt + 1 - kt_lo) & 1) * 2 * ATILE;
#pragma unroll
      for (int i = 0; i < 2; ++i) { *(u32x4*)(wk + (srow + 32 * i) * ARS + scol) = rk[i]; *(u32x4*)(wk + ATILE + (srow + 32 * i) * ARS + scol) = rv[i]; }
    }
    HBAR();
  }
  asm volatile("" ::: "memory");
  const int tid2 = otid() & 255, lane2 = tid2 & 63, hh2 = lane2 >> 5, qi2 = qb * 128 + __builtin_amdgcn_readfirstlane(tid2 >> 6) * 32 + (lane2 & 31);
  const float lam = p.lam[l];
  int lx = l; asm volatile("" : "+s"(lx));
  const float lam_init = (lx == 0) ? 0.2f : (lx == 1) ? 0.35550907f : (lx == 2) ? 0.47071302f : 0.55605820f;
  const float l1 = lrun[0] + xch32(lrun[0], x32), l2 = lrun[1] + xch32(lrun[1], x32);
  const float i1 = 1.f / l1, i2 = lam / l2;
  float ss = 0.f;
#pragma unroll
  for (int vb = 0; vb < 2; ++vb)
#pragma unroll
    for (int i = 0; i < 16; ++i) { const float o = O[0][vb][i] * i1 - O[1][vb][i] * i2; O[0][vb][i] = o; ss += o * o; }
  ss += xch32(ss, x32);
  const float rs = rsqrtf(ss * (1.f / 64.f) + EPS) * (1.f - lam_init);
  const float* sg = p.subln_g + l * 64;
  bf16_t* yrow = p.y + ((long)(b * SEQ + qi2)) * DM + head * 64;
#pragma unroll
  for (int vb = 0; vb < 2; ++vb)
#pragma unroll
    for (int g4 = 0; g4 < 4; ++g4) {
      const int vc = vb * 32 + 8 * g4 + 4 * hh2;
      const f32x4 gg = *(const f32x4*)(sg + vc);
      u32x2 w;
      w[0] = pk2(O[0][vb][4 * g4 + 0] * rs * gg[0], O[0][vb][4 * g4 + 1] * rs * gg[1]);
      w[1] = pk2(O[0][vb][4 * g4 + 2] * rs * gg[2], O[0][vb][4 * g4 + 3] * rs * gg[3]);
      *(u32x2*)(yrow + vc) = w;
    }
}

constexpr int ZRS = 264;
NI void conv_tile(int l, int id, LAS3 unsigned* cnt, unsigned& target) {
  KPARAMS;
  const int tidf = otid(), half = __builtin_amdgcn_readfirstlane(tidf >> 8), tid = tidf & 255, lane = tid & 63, wid = __builtin_amdgcn_readfirstlane(tid >> 6), x32 = ((lane ^ 32) << 2);
  bf16_t* smem = SMEM + half * HALF_E;
  const int b = id >> 6, t0 = (id & 63) * 64;
  for (int idx = tid; idx < 94 * 32; idx += 256) {
    const int row = idx >> 5, c8 = (idx & 31) * 8;
    const int tok = t0 - 15 + row;
    u32x4 w = (u32x4){0u, 0u, 0u, 0u};
    if (tok >= 0 && tok < SEQ) {
      const bf16_t* hp = p.h + ((long)(b * SEQ + tok)) * HC + 512 + c8;
      const u32x4 a = *(const u32x4*)hp, g = *(const u32x4*)(hp + 256);
#pragma unroll
      for (int j = 0; j < 4; ++j) {
        const float a0 = bflo(a[j]), a1 = bfhi(a[j]), g0 = bflo(g[j]), g1 = bfhi(g[j]);
        w[j] = pk2(a0 * __builtin_amdgcn_rcpf(1.f + __builtin_amdgcn_exp2f(-LOG2E * g0)), a1 * __builtin_amdgcn_rcpf(1.f + __builtin_amdgcn_exp2f(-LOG2E * g1)));
      }
    }
    *(u32x4*)(smem + row * ZRS + c8) = w;
  }
  HBAR();
  {
    const int c = tid;
    float wv[31];
#pragma unroll
    for (int j = 0; j < 31; ++j) wv[j] = p.conv_dw_w[((long)l * 31 + j) * 256 + c];
    const float cb = p.conv_dw_b[l * 256 + c], lg = p.conv_ln_g[l * 256 + c], lb = p.conv_ln_b[l * 256 + c];
#pragma unroll 1
    for (int ch = 0; ch < 8; ++ch) {
      float zw[38];
#pragma unroll
      for (int j = 0; j < 38; ++j) zw[j] = bf2f(smem[(ch * 8 + j) * ZRS + c]);
      float o[8];
#pragma unroll
      for (int tt = 0; tt < 8; ++tt) {
        float s = cb;
#pragma unroll
        for (int j = 0; j < 31; ++j) s = fmaf(wv[j], zw[tt + j], s);
        o[tt] = s;
      }
#pragma unroll
      for (int tt = 0; tt < 8; ++tt) {
        const float s1 = wave_sum(o[tt], x32), s2 = wave_sum(o[tt] * o[tt], x32);
        const float mu = s1 * (1.f / 64.f);
        const float var = fmaxf(s2 * (1.f / 64.f) - mu * mu, 0.f);
        const float yv = (o[tt] - mu) * rsqrtf(var + EPS) * lg + lb;
        const float sv = yv * __builtin_amdgcn_rcpf(1.f + __builtin_amdgcn_exp2f(-LOG2E * yv));
        smem[(ch * 8 + tt) * ZRS + c] = (bf16_t)(pk2(sv, 0.f) & 0xffffu);
      }
    }
  }
  HBAR();
  {
    const int fr = lane & 15, fq = lane >> 4;
    const bf16_t* W = p.pwT + (long)l * 65536 + (long)(wid * 64) * 256;
    f32x4 acc[4][4];
#pragma unroll
    for (int m = 0; m < 4; ++m)
#pragma unroll
      for (int n = 0; n < 4; ++n) acc[m][n] = (f32x4){0.f, 0.f, 0.f, 0.f};
#pragma unroll 2
    for (int ks = 0; ks < 8; ++ks) {
      bf16x8 af[4], bfr[4];
#pragma unroll
      for (int m = 0; m < 4; ++m) af[m] = *(const bf16x8*)(smem + (m * 16 + fr) * ZRS + ks * 32 + fq * 8);
#pragma unroll
      for (int n = 0; n < 4; ++n) bfr[n] = *(const bf16x8*)(W + (long)(n * 16 + fr) * 256 + ks * 32 + fq * 8);
#pragma unroll
      for (int m = 0; m < 4; ++m)
#pragma unroll
        for (int n = 0; n < 4; ++n) acc[m][n] = __builtin_amdgcn_mfma_f32_16x16x32_bf16(bfr[n], af[m], acc[m][n], 0, 0, 0);
    }
    const float* pb = p.conv_pw_b + l * 256;
#pragma unroll
    for (int m = 0; m < 4; ++m)
#pragma unroll
      for (int n = 0; n < 4; ++n) {
        const int tok = t0 + m * 16 + fr, col = wid * 64 + n * 16 + fq * 4;
        const f32x4 bv = *(const f32x4*)(pb + col);
        const f32x4 v = acc[m][n] + bv;
        u32x2 w; w[0] = pk2(v[0], v[1]); w[1] = pk2(v[2], v[3]);
        *(u32x2*)(p.y + ((long)(b * SEQ + tok)) * DM + 256 + col) = w;
      }
  }
  HBAR();
}

constexpr int VRS = 258;
NI void sgu_tile(int l, int id, LAS3 unsigned* cnt, unsigned& target) {
  KPARAMS;
  const int tidf = otid(), half = __builtin_amdgcn_readfirstlane(tidf >> 8), tid = tidf & 255, lane = tid & 63, wid = __builtin_amdgcn_readfirstlane(tid >> 6), x32 = ((lane ^ 32) << 2);
  bf16_t* smem = SMEM + half * HALF_E;
  const long T0 = (long)id * 128;
  {
    const f32x4 lg = *(const f32x4*)(p.sgu_ln_g + l * 256 + lane * 4), lb = *(const f32x4*)(p.sgu_ln_b + l * 256 + lane * 4);
#pragma unroll 4
    for (int i = 0; i < 32; ++i) {
      const int s = wid * 32 + i;
      const u32x2 raw = *(const u32x2*)(p.h + (T0 + s) * HC + 1280 + lane * 4);
      const float v0 = bflo(raw[0]), v1 = bfhi(raw[0]), v2 = bflo(raw[1]), v3 = bfhi(raw[1]);
      const float s1 = wave_sum(v0 + v1 + v2 + v3, x32);
      const float mu = s1 * (1.f / 256.f);
      const float d0 = v0 - mu, d1 = v1 - mu, d2 = v2 - mu, d3 = v3 - mu;
      const float s2 = wave_sum(d0 * d0 + d1 * d1 + d2 * d2 + d3 * d3, x32);
      const float rs = rsqrtf(s2 * (1.f / 256.f) + EPS);
      unsigned* dst = (unsigned*)(smem + s * VRS + lane * 4);
      dst[0] = pk2(d0 * rs * lg[0] + lb[0], d1 * rs * lg[1] + lb[1]);
      dst[1] = pk2(d2 * rs * lg[2] + lb[2], d3 * rs * lg[3] + lb[3]);
    }
  }
  HBAR();
  {
    const int fr = lane & 15, fq = lane >> 4, g = wid;
    const bf16_t* W = p.sguW + ((long)(l * 4 + g)) * 16384;
    const float* bs = p.sgu_b + ((long)(l * 4 + g)) * 128;
#pragma unroll 1
    for (int th = 0; th < 2; ++th) {
      f32x4 acc[4][4];
#pragma unroll
      for (int m = 0; m < 4; ++m)
#pragma unroll
        for (int n = 0; n < 4; ++n) acc[m][n] = (f32x4){0.f, 0.f, 0.f, 0.f};
#pragma unroll 1
      for (int ks = 0; ks < 4; ++ks) {
        bf16x8 vf[4], wf[4];
#pragma unroll
        for (int n = 0; n < 4; ++n) {
#pragma unroll
          for (int j = 0; j < 8; ++j) vf[n][j] = (short)smem[(ks * 32 + fq * 8 + j) * VRS + g * 64 + n * 16 + fr];
        }
#pragma unroll
        for (int m = 0; m < 4; ++m) wf[m] = *(const bf16x8*)(W + (long)(th * 64 + m * 16 + fr) * 128 + ks * 32 + fq * 8);
#pragma unroll
        for (int m = 0; m < 4; ++m)
#pragma unroll
          for (int n = 0; n < 4; ++n) acc[m][n] = __builtin_amdgcn_mfma_f32_16x16x32_bf16(vf[n], wf[m], acc[m][n], 0, 0, 0);
      }
#pragma unroll
      for (int m = 0; m < 4; ++m) {
        const int t = th * 64 + m * 16 + fr;
        const float bt = bs[t];
#pragma unroll
        for (int n = 0; n < 4; ++n) {
          const int c = g * 64 + n * 16 + fq * 4;
          const u32x2 ur = *(const u32x2*)(p.h + (T0 + t) * HC + 1024 + c);
          const f32x4 sv = acc[m][n] + bt;
          u32x2 w; w[0] = pk2(bflo(ur[0]) * sv[0], bfhi(ur[0]) * sv[1]); w[1] = pk2(bflo(ur[1]) * sv[2], bfhi(ur[1]) * sv[3]);
          *(u32x2*)(p.y + (T0 + t) * DM + 768 + c) = w;
        }
      }
    }
  }
  HBAR();
}

constexpr int FRS = 72, FPL = 64 * FRS, FCH = 2 * FPL + 64;
NI void fft_item(int l, int id, LAS3 unsigned* cnt, unsigned& target) {
  KPARAMS;
  const int tidf = otid(), half = __builtin_amdgcn_readfirstlane(tidf >> 8), tid = tidf & 255, lane = tid & 63, wid = __builtin_amdgcn_readfirstlane(tid >> 6);
  const int fr = lane & 15, fq = lane >> 4;
  bf16_t* smem = SMEM + half * HALF_E;
  const int b = id >> 7, ch0 = (id & 127) * 2;
  bf16_t* Ct = smem + 2 * FCH;
  unsigned* TWl = (unsigned*)(Ct + 2 * FPL);
  {
    u32x4 zv[8], cv[4], tv[4];
#pragma unroll
    for (int i = 0; i < 8; ++i) {
      const int chunk = tid + 256 * i, c = chunk >> 10, rem = chunk & 1023, ri = rem >> 9, s8 = rem & 511;
      zv[i] = *(const u32x4*)(p.PQt + ((long)(b * 256 + ch0 + c)) * 8192 + ri * 4096 + s8 * 8);
    }
#pragma unroll
    for (int i = 0; i < 4; ++i) {
      const int chunk = tid + 256 * i, tb = chunk >> 9, row = (chunk >> 3) & 63, c8 = chunk & 7;
      cv[i] = *(const u32x4*)(p.M1 + (tb * 64 + row) * 128 + c8 * 8);
      tv[i] = *(const u32x4*)((const unsigned*)p.TW + chunk * 4);
    }
#pragma unroll
    for (int i = 0; i < 8; ++i) {
      const int chunk = tid + 256 * i, c = chunk >> 10, rem = chunk & 1023, ri = rem >> 9, s8 = rem & 511;
      *(u32x4*)(smem + c * FCH + ri * FPL + (s8 >> 3) * FRS + (s8 & 7) * 8) = zv[i];
    }
#pragma unroll
    for (int i = 0; i < 4; ++i) {
      const int chunk = tid + 256 * i, tb = chunk >> 9, row = (chunk >> 3) & 63, c8 = chunk & 7;
      *(u32x4*)(Ct + tb * FPL + row * FRS + c8 * 8) = cv[i];
      *(u32x4*)(TWl + (chunk >> 4) * 68 + (chunk & 15) * 4) = tv[i];
    }
  }
  HBAR();
  {
    const int c = wid >> 1;
    bf16x8 zf[2][4];
#pragma unroll
    for (int nt = 0; nt < 2; ++nt)
#pragma unroll
      for (int ks = 0; ks < 4; ++ks) {
        const bf16_t* src = smem + c * FCH + (ks >> 1) * FPL + ((ks & 1) * 32 + fq * 8) * FRS + (wid & 1) * 32 + nt * 16 + fr;
#pragma unroll
        for (int j = 0; j < 8; ++j) zf[nt][ks][j] = (short)src[j * FRS];
      }
    f32x4 acc[2][8];
#pragma unroll
    for (int nt = 0; nt < 2; ++nt)
#pragma unroll
      for (int mt = 0; mt < 8; ++mt) acc[nt][mt] = (f32x4){0.f, 0.f, 0.f, 0.f};
#pragma unroll
    for (int mt = 0; mt < 8; ++mt)
#pragma unroll
      for (int ks = 0; ks < 4; ++ks) {
        u32x4 mw = *(const u32x4*)(Ct + (((mt >> 2) == (ks >> 1)) ? 0 : FPL) + ((mt & 3) * 16 + fr) * FRS + (ks & 1) * 32 + fq * 8);
        if ((mt >> 2) == 0 && (ks >> 1) == 1) mw = mw ^ 0x80008000u;
        const bf16x8 mf = __builtin_bit_cast(bf16x8, mw);
#pragma unroll
        for (int nt = 0; nt < 2; ++nt) acc[nt][mt] = __builtin_amdgcn_mfma_f32_16x16x32_bf16(zf[nt][ks], mf, acc[nt][mt], 0, 0, 0);
      }
#pragma unroll
    for (int nt = 0; nt < 2; ++nt)
#pragma unroll
      for (int m4 = 0; m4 < 4; ++m4) {
        const int k1 = m4 * 16 + fr, s2 = (wid & 1) * 32 + nt * 16 + fq * 4;
        const u32x4 tw = *(const u32x4*)(TWl + k1 * 68 + s2);
        const f32x4 yr = acc[nt][m4], yi = acc[nt][m4 + 4];
        const float cs[4] = {bflo(tw[0]), bflo(tw[1]), bflo(tw[2]), bflo(tw[3])}, sn[4] = {bfhi(tw[0]), bfhi(tw[1]), bfhi(tw[2]), bfhi(tw[3])};
        float tr[4], ti[4];
#pragma unroll
        for (int j = 0; j < 4; ++j) { tr[j] = yr[j] * cs[j] - yi[j] * sn[j]; ti[j] = yr[j] * sn[j] + yi[j] * cs[j]; }
        u32x2 wr_, wi_; wr_[0] = pk2(tr[0], tr[1]); wr_[1] = pk2(tr[2], tr[3]); wi_[0] = pk2(ti[0], ti[1]); wi_[1] = pk2(ti[2], ti[3]);
        *(u32x2*)(smem + c * FCH + k1 * FRS + s2) = wr_;
        *(u32x2*)(smem + c * FCH + FPL + k1 * FRS + s2) = wi_;
      }
  }
  HBAR();
  {
    f32x4 acc[2][4];
#pragma unroll
    for (int t = 0; t < 2; ++t)
#pragma unroll
      for (int mt = 0; mt < 4; ++mt) acc[t][mt] = (f32x4){0.f, 0.f, 0.f, 0.f};
#pragma unroll
    for (int ks = 0; ks < 4; ++ks) {
      bf16x8 tf[2];
#pragma unroll
      for (int t = 0; t < 2; ++t) {
        const int k1 = (wid * 2 + t) * 8 + (fr >> 1), c = fr & 1;
        tf[t] = *(const bf16x8*)(smem + c * FCH + (ks >> 1) * FPL + k1 * FRS + (ks & 1) * 32 + fq * 8);
      }
#pragma unroll
      for (int mt = 0; mt < 4; ++mt) {
        u32x4 mw = *(const u32x4*)(Ct + ((ks >> 1) ? FPL : 0) + (mt * 16 + fr) * FRS + (ks & 1) * 32 + fq * 8);
        if (ks >> 1) mw = mw ^ 0x80008000u;
        const bf16x8 mf = __builtin_bit_cast(bf16x8, mw);
#pragma unroll
        for (int t = 0; t < 2; ++t) acc[t][mt] = __builtin_amdgcn_mfma_f32_16x16x32_bf16(tf[t], mf, acc[t][mt], 0, 0, 0);
      }
    }
    const float b0 = p.fnet_b[l * 256 + ch0], b1 = p.fnet_b[l * 256 + ch0 + 1];
#pragma unroll
    for (int t = 0; t < 2; ++t)
#pragma unroll
      for (int mt = 0; mt < 4; ++mt)
#pragma unroll
        for (int jj = 0; jj < 2; ++jj) {
          const int k1 = (wid * 2 + t) * 8 + 2 * fq + jj, k2 = mt * 16 + fr;
          *(unsigned*)(p.y + ((long)(b * SEQ + k1 + 64 * k2)) * DM + 512 + ch0) = pk2(acc[t][mt][2 * jj] + b0, acc[t][mt][2 * jj + 1] + b1);
        }
  }
  HBAR();
}

NI void mixer_phase(int l, int rep) {
  KPARAMS;
  constexpr int NA = 1024, NF = 1024, NC = 512, ND = 256;
  const int tidf = otid(), half = __builtin_amdgcn_readfirstlane(tidf >> 8), tid = tidf & 255, lane = tid & 63;
  LAS3 unsigned* ctl = (LAS3 unsigned*)(LDSP + 2 * HALF_B);
  LAS3 unsigned* cnt = ctl + 8 + 4 * half;
  LAS3 unsigned* nx = ctl + 16 + 4 * half;
  if (tid == 0) *cnt = 0u;
  __syncthreads();
  unsigned target = 0u;
  for (int it = 0;; ++it) {
    if (tid == 0) nx[it & 1] = (unsigned)atomicAdd(p.ctr + l + 4 * rep, 1);
    HBAR();
    const int id = __builtin_amdgcn_readfirstlane((int)nx[it & 1]);
    if (id >= NA + NF + NC + ND) break;
    if (id < NA) attn_tile(l, id, cnt, target);
    else if (id < NA + NF) fft_item(l, id - NA, cnt, target);
    else if (id < NA + NF + NC) conv_tile(l, id - NA - NF, cnt, target);
    else sgu_tile(l, id - NA - NF - NC, cnt, target);
  }
}

#define LAS __attribute__((address_space(3)))
#define XB_TMO      128
#define XB_XCNT(j)  (256  + 64 * (j))
#define XB_XSUB(j)  (1280 + 64 * (j))
#define XB_XGEN(j)  (2304 + 64 * (j))
#define XB_TOP      3328
#define XB_TOPGEN   3392
#define XCD_BAR_WORDS 3456
#define XB_SPIN_CAP (1u << 18)

__device__ __forceinline__ unsigned xb_ld(unsigned* p)              { return __hip_atomic_load(p, __ATOMIC_RELAXED, __HIP_MEMORY_SCOPE_AGENT); }
__device__ __forceinline__ unsigned xb_add(unsigned* p, unsigned v) { return __hip_atomic_fetch_add(p, v, __ATOMIC_RELAXED, __HIP_MEMORY_SCOPE_AGENT); }
__device__ __forceinline__ unsigned xb_xcc_id() { return (unsigned)__builtin_amdgcn_s_getreg((3 << 11) | 20) & 0xFu; }
#define XB_SPIN(cond, bar) do { unsigned _sp = 0; while (cond) { __builtin_amdgcn_s_sleep(1); \
    if ((++_sp & 255u) == 0u) { if (xb_ld(&(bar)[XB_TMO])) break; if (_sp > XB_SPIN_CAP) { atomicAdd(&(bar)[XB_TMO], 1u); break; } } } } while (0)

struct XcdBarrier {
    unsigned* bar; unsigned x;
    volatile LAS unsigned* st;
};

__device__ __forceinline__ XcdBarrier xcd_barrier_post(unsigned* bar, volatile LAS unsigned* st) {
    XcdBarrier b; b.bar = bar; b.x = xb_xcc_id(); b.st = st;
    if (threadIdx.x == 0) (void)xb_add(&bar[XB_XCNT(b.x)], 1u);
    return b;
}
__device__ __forceinline__ void xcd_barrier_complete(unsigned* bar, unsigned x, unsigned& nloc, unsigned& nx) {
    const unsigned G = gridDim.x * gridDim.y * gridDim.z;
    unsigned sum, cnt, mine, sp = 0u;
    for (;;) {
        sum = 0u; cnt = 0u; mine = 0u;
#pragma unroll
        for (unsigned j = 0; j < 16; ++j) { const unsigned c = xb_ld(&bar[XB_XCNT(j)]); sum += c; cnt += (c > 0u) ? 1u : 0u; mine = (j == x) ? c : mine; }
        if (sum == G) break;
        __builtin_amdgcn_s_sleep(1);
        if ((++sp & 255u) == 0u) { if (xb_ld(&bar[XB_TMO])) break; if (sp > XB_SPIN_CAP) { atomicAdd(&bar[XB_TMO], 1u); break; } }
    }
    nloc = mine > 0u ? mine : 1u; nx = cnt > 0u ? cnt : 1u;
}

__device__ __forceinline__ void xcd_barrier(const XcdBarrier& b) {
    asm volatile("s_waitcnt vmcnt(0)" ::: "memory");
    __syncthreads();
    if (threadIdx.x == 0) {
        unsigned* bar = b.bar;
        __builtin_amdgcn_s_waitcnt(0);
        unsigned nloc = b.st[0], nx = b.st[1];
        if (nloc == 0u) { xcd_barrier_complete(bar, b.x, nloc, nx); b.st[0] = nloc; b.st[1] = nx; }
        const unsigned old = xb_add(&bar[XB_XSUB(b.x)], 1u);
        const unsigned gen = old / nloc;
        if (old + 1u == (gen + 1u) * nloc) {
            __builtin_amdgcn_fence(__ATOMIC_RELEASE, "agent");
            asm volatile("s_waitcnt vmcnt(0)" ::: "memory");
            const unsigned og = xb_add(&bar[XB_TOP], 1u);
            const unsigned tg = og / nx;
            if (og + 1u == (tg + 1u) * nx) xb_add(&bar[XB_TOPGEN], 1u);
            else XB_SPIN(xb_ld(&bar[XB_TOPGEN]) == tg, bar);
            __builtin_amdgcn_fence(__ATOMIC_ACQUIRE, "agent");
            xb_add(&bar[XB_XGEN(b.x)], 1u);
            asm volatile("s_waitcnt vmcnt(0)" ::: "memory");
        } else {
            XB_SPIN(xb_ld(&bar[XB_XGEN(b.x)]) == gen, bar);
            __builtin_amdgcn_fence(__ATOMIC_ACQUIRE, "agent");
            asm volatile("s_waitcnt vmcnt(0)" ::: "memory");
        }
    }
    __syncthreads();
}

constexpr int NPHASE = 2 + 5 * DEPTH;
__global__ void __launch_bounds__(512, 2) mk_fwd(Params p, int ph_lo, int ph_hi, int coop) {
  int rep = 0;
  volatile LAS unsigned* bst = (volatile LAS unsigned*)(LDSP + 2 * HALF_B + 16);
  if (otid() < 2) bst[otid()] = 0u;
  __syncthreads();
  XcdBarrier xbar = xcd_barrier_post(p.barw, bst);
  for (int ph = ph_lo; ph < ph_hi; ++ph) {
    if (ph == 0) {
      prep_phase();
      if (REP_PREP) { __syncthreads(); prep_phase(); }
    } else if (ph == NPHASE - 1) {
      final_rms_phase(p.xn, p.final_g, p.out);
    } else {
      const int l = (ph - 1) / 5, s = (ph - 1) % 5;
      if (s == 0) gemm_in_phase(l);
      else if (s == 1) mixer_phase(l, rep);
      else if (s == 2) gemm_out_phase(l, (REP_S == 2 && rep == 0) ? 0.f : 1.f);
      else if (s == 3) gemm_up_phase(l);
      else gemm_down_phase(l, (REP_S == 4 && rep == 0) ? 0.f : 1.f);
    }
    if (coop && ph + 1 < ph_hi) { if (ph == 0) cg::this_grid().sync(); else xcd_barrier(xbar); }
    if (coop && ph == 1) for (int i = 0; i < EXTRA_SYNCS; ++i) xcd_barrier(xbar);
    if (REP_S >= 0 && rep == 0 && ph >= 1 && ph < NPHASE - 1 && ((ph - 1) % 5) == REP_S) { rep = 1; --ph; } else rep = 0;
  }
}

extern "C" void kernel_launch(void* const* d_in, const int* in_sizes, int n_in, void* d_out, int out_size, void* d_ws, size_t ws_size, hipStream_t stream) {
  Params p{};
  const float** pf = (const float**)&p;
  for (int i = 0; i < 25; ++i) pf[i] = (const float*)d_in[i];
  p.out = (float*)d_out;
  unsigned char* w = (unsigned char*)d_ws;
  size_t off = 0;
  auto take = [&](size_t bytes) { unsigned char* r = w + off; off += (bytes + 255) & ~(size_t)255; return r; };
  p.WallT = (bf16_t*)take((size_t)DEPTH * WALL_N * DM * 2);
  p.WoutT = (bf16_t*)take((size_t)DEPTH * DM * DM * 2);
  p.WupT = (bf16_t*)take((size_t)DEPTH * DFF * DM * 2);
  p.WdownT = (bf16_t*)take((size_t)DEPTH * DFF * DM * 2);
  p.pwT = (bf16_t*)take((size_t)DEPTH * 65536 * 2);
  p.sguW = (bf16_t*)take((size_t)DEPTH * 4 * 16384 * 2);
  p.lam = (float*)take(256);
  unsigned char* ctl = take(16384);
  p.ctr = (int*)ctl;
  p.barw = (unsigned*)(ctl + 256);
  p.M1 = (bf16_t*)take(128 * 128 * 2);
  p.M3 = (bf16_t*)take(64 * 128 * 2);
  p.TW = (float*)take(4096 * 2 * 4);
  p.part = (float*)take((size_t)NTOK * 16 * 4);
  p.xn = (bf16_t*)take((size_t)NTOK * DM * 2);
  unsigned char* region = take((size_t)NTOK * DFF * 2);
  p.hid = (bf16_t*)region;
  p.h = (bf16_t*)region;
  p.Vt = (bf16_t*)(region + (size_t)NTOK * HC * 2);
  p.PQt = (bf16_t*)(region + (size_t)NTOK * HC * 2 + (size_t)NTOK * 256 * 2);
  p.y = (bf16_t*)(region + (size_t)NTOK * HC * 2 + (size_t)NTOK * 256 * 2 + (size_t)BATCH * 256 * 8192 * 2);
  if (off > ws_size) { fprintf(stderr, "workspace too small: need %zu have %zu\n", off, ws_size); return; }

  static int grid_blocks = 0;
  if (!grid_blocks) {
    int dev = 0, cus = 0, per_cu = 0;
    hipGetDevice(&dev);
    hipDeviceGetAttribute(&cus, hipDeviceAttributeMultiprocessorCount, dev);
    hipOccupancyMaxActiveBlocksPerMultiprocessor(&per_cu, mk_fwd, 512, 0);
    if (per_cu < 1) per_cu = 1;
    grid_blocks = cus * per_cu;
  }
  hipMemsetAsync(ctl, 0, 16384, stream);
#if MK_ONE_LAUNCH
  int lo = 0, hi = NPHASE, coop = 1;
  void* args[] = {&p, &lo, &hi, &coop};
  hipError_t e = hipLaunchCooperativeKernel((void*)mk_fwd, dim3(grid_blocks), dim3(512), args, 0, stream);
  if (e != hipSuccess) fprintf(stderr, "cooperative launch failed: %s (grid %d)\n", hipGetErrorString(e), grid_blocks);
#else
  for (int ph = 0; ph < NPHASE; ++ph) mk_fwd<<<grid_blocks, 512, 0, stream>>>(p, ph, ph + 1, 0);
#endif
}
```

```cpp
#include <hip/hip_runtime.h>
#include <hip/hip_cooperative_groups.h>
#include <cstdint>
#include <cstdio>
#include <cmath>
namespace cg = cooperative_groups;

#ifndef EXTRA_SYNCS
#define EXTRA_SYNCS 0
#endif
#ifndef REP_PREP
#define REP_PREP 0
#endif
#ifndef REP_S
#define REP_S -1
#endif
#ifndef MK_ONE_LAUNCH
#define MK_ONE_LAUNCH 1
#endif

#define DI __device__ __forceinline__
typedef unsigned short bf16_t;
typedef short bf16x8 __attribute__((ext_vector_type(8)));
typedef float f32x4 __attribute__((ext_vector_type(4)));
typedef float f32x16 __attribute__((ext_vector_type(16)));
typedef float f32x2 __attribute__((ext_vector_type(2)));
typedef __bf16 bf16x2v __attribute__((ext_vector_type(2)));
typedef unsigned u32x4 __attribute__((ext_vector_type(4)));
typedef unsigned u32x2 __attribute__((ext_vector_type(2)));

constexpr int BATCH = 8, SEQ = 4096, DM = 1024, DEPTH = 4, NTOK = BATCH * SEQ;
constexpr int HC = 1536;
constexpr int WALL_N = 2304;
constexpr int DFF = 4096;
constexpr float EPS = 1e-6f;
constexpr float LOG2E = 1.4426950408889634f;

DI unsigned pk2(float lo, float hi) { f32x2 v = {lo, hi}; bf16x2v b = __builtin_convertvector(v, bf16x2v); return __builtin_bit_cast(unsigned, b); }
DI float bflo(unsigned u) { return __uint_as_float(u << 16); }
DI float bfhi(unsigned u) { return __uint_as_float(u & 0xffff0000u); }
DI float bf2f(bf16_t u) { return __uint_as_float(((unsigned)u) << 16); }
template <int CTRL> DI float dppf(float v) { return __builtin_bit_cast(float, __builtin_amdgcn_update_dpp(0, __builtin_bit_cast(int, v), CTRL, 0xf, 0xf, true)); }
DI float xch32(float v, int x32) { return __builtin_bit_cast(float, __builtin_amdgcn_ds_bpermute(x32, __builtin_bit_cast(int, v))); }
DI float wave_sum(float v, int x32) {
  v += dppf<0xB1>(v); v += dppf<0x4E>(v); v += dppf<0x141>(v); v += dppf<0x140>(v);
  v += __builtin_bit_cast(float, __builtin_amdgcn_ds_swizzle(__builtin_bit_cast(int, v), 0x401f));
  v += xch32(v, x32);
  return v;
}

#define LAS3 __attribute__((address_space(3)))
DI void half_bar(LAS3 unsigned* cnt, unsigned& target, int lane) {
  asm volatile("s_waitcnt lgkmcnt(0)" ::: "memory");
  target += 4u;
  if (lane == 0) __hip_atomic_fetch_add(cnt, 1u, __ATOMIC_RELAXED, __HIP_MEMORY_SCOPE_WORKGROUP);
  while (__hip_atomic_load(cnt, __ATOMIC_RELAXED, __HIP_MEMORY_SCOPE_WORKGROUP) < target) __builtin_amdgcn_s_sleep(1);
  asm volatile("" ::: "memory");
}
#define HBAR() half_bar(cnt, target, lane)

struct Params {
  const float *x, *norm1_g, *w_in, *lam_q1, *lam_k1, *lam_q2, *lam_k2, *subln_g, *conv_dw_w, *conv_dw_b, *conv_ln_g, *conv_ln_b,
      *conv_pw_w, *conv_pw_b, *fnet_w, *fnet_b, *sgu_ln_g, *sgu_ln_b, *sgu_w, *sgu_b, *w_out, *norm2_g, *w_up, *w_down, *final_g;
  float* out;
  bf16_t *WallT, *WoutT, *WupT, *WdownT, *pwT, *sguW, *M1, *M3, *xn, *h, *Vt, *PQt, *y, *hid;
  float* lam;
  float* TW;
  float* part;
  int* ctr;
  unsigned* barw;
};

constexpr int HALF_B = 72960;
constexpr int SMEM_BYTES = 2 * HALF_B + 256;
constexpr int HALF_E = HALF_B / 2;
__shared__ __attribute__((aligned(16))) unsigned char smem_raw[SMEM_BYTES];
#define SMEM ((bf16_t*)smem_raw)
#define NI __device__ __forceinline__
DI int otid() { int t = threadIdx.x; asm volatile("" : "+v"(t)); return t; }
#define KPARAMS const Params& p = *(const Params*)__builtin_amdgcn_kernarg_segment_ptr()

namespace pg8 {
#define PG8_LAS __attribute__((address_space(3)))
typedef unsigned short bf16_t;
typedef short bf16x8 __attribute__((ext_vector_type(8)));
typedef float f32x4 __attribute__((ext_vector_type(4)));
typedef unsigned u32x4 __attribute__((ext_vector_type(4)));
constexpr int BM = 256, BK = 64, HALF = 128, HTB = HALF * BK * 2  , STAGE_BYTES = 8 * HTB, NXCD = 8, WGM = 8;

__host__ __device__ __forceinline__ int lds_byte(int r, int c) { const int st = (r >> 4) * 2 + (c >> 5), rr = r & 15, cc = c & 31, ob = rr * 64 + cc * 2; return st * 1024 + (ob ^ (((ob >> 9) & 1) << 5)); }
__host__ __device__ __forceinline__ void stage_rc(int b, int& R, int& C) { const int st = b / 1024, sb = b % 1024, swz = sb ^ (((sb >> 9) & 1) << 5); R = (st >> 1) * 16 + swz / 64; C = (st & 1) * 32 + (swz % 64) / 2; }
__host__ __device__ __forceinline__ int perm32(int rho) { const int n = rho >> 4, i = rho & 15; return 8 * (i >> 2) + 4 * n + (i & 3); }

struct Unit { int pm, pn; };
struct Gemm { const bf16_t* A; const bf16_t* Bt; int M, N, K; };

struct StaticOrder {
    int nM, nN, nwg, G, c;
    __host__ __device__ void init(int M, int N, int G_, int c_) { nM = M / BM; nN = N / BM; nwg = nM * nN; G = G_; c = c_; }
    __host__ __device__ bool next(int i, Unit& u) const {
        const long L = (long)i * G + c; if (L >= nwg) return false;
        int wgid = (int)L; { const int q = nwg / NXCD, r = nwg % NXCD, xcd = wgid % NXCD, off = wgid / NXCD; wgid = (xcd < r ? xcd * (q + 1) : r * (q + 1) + (xcd - r) * q) + off; }
        const int nig = WGM * nN, gid = wgid / nig, fm = gid * WGM, gsz = (nM - fm) < WGM ? (nM - fm) : WGM;
        u.pm = fm + ((wgid % nig) % gsz); u.pn = (wgid % nig) / gsz; return true;
    }
    __device__ __forceinline__ void a_ready(const Unit&) const {}
    __device__ __forceinline__ void done(const Unit&) const {}
};
template <class Epi, class Sched, bool ALIGN_EPI = false, bool SP2 = false>
__device__ __forceinline__ void gemm_phase(PG8_LAS unsigned char* lds, const Gemm g, const Sched& S, const Epi& E) {
    const int tid = otid(), wid = __builtin_amdgcn_readfirstlane(tid >> 6), lane = tid & 63, wr = wid >> 2, wc = wid & 3, fr = lane & 15, fq = lane >> 4;
    const int K = g.K, nt = K / BK;
    unsigned voffA[2], voffB[2];
#pragma unroll
    for (int i = 0; i < 2; ++i) { int R, C; stage_rc(tid * 16 + i * 8192, R, C); const int Rb = Epi::PERM ? ((R & ~31) + perm32(R & 31)) : R;
        voffA[i] = (unsigned)(R * K + C) * 2u; voffB[i] = (unsigned)(Rb * K + C) * 2u; }
    const size_t kstep = (size_t)(BK * 2);
    const size_t hstep = (size_t)HALF * K * 2;
    const size_t tstep = 2 * hstep;
    const unsigned ldsw = (unsigned)wid * 1024u;
    const int aoff = lds_byte(wr * 64 + fr, fq * 8), boff = lds_byte(wc * 32 + fr, fq * 8);
#define PG8_SA(b, h) (((b) * 2 + (h)) * HTB)
#define PG8_SB(b, h) ((4 + (b) * 2 + (h)) * HTB)
#define PG8_STAGE(bufoff, gbase, voff) do { _Pragma("unroll") for (int _i = 0; _i < 2; ++_i) \
        __builtin_amdgcn_global_load_lds((const unsigned*)((const char*)(gbase) + (voff)[_i]), (PG8_LAS unsigned*)(lds + (bufoff) + ldsw + _i * 8192), 16, 0, 0); } while (0)
#define PG8_LDA(dst, b, h) do { _Pragma("unroll") for (int m = 0; m < 4; ++m) _Pragma("unroll") for (int k = 0; k < 2; ++k) dst[m][k] = *(const PG8_LAS bf16x8*)(lds + PG8_SA(b, h) + aoff + m * 2048 + k * 1024); } while (0)
#define PG8_LDB(dst, b, h) do { _Pragma("unroll") for (int n = 0; n < 2; ++n) _Pragma("unroll") for (int k = 0; k < 2; ++k) dst[n][k] = *(const PG8_LAS bf16x8*)(lds + PG8_SB(b, h) + boff + n * 2048 + k * 1024); } while (0)
#define PG8_MMA(ai, bj, At, Bt) do { __builtin_amdgcn_s_setprio(1); _Pragma("unroll") for (int m = 0; m < 4; ++m) _Pragma("unroll") for (int n = 0; n < 2; ++n) _Pragma("unroll") for (int k = 0; k < 2; ++k) \
        acc[ai][bj][m][n] = __builtin_amdgcn_mfma_f32_16x16x32_bf16(Bt[n][k], At[m][k], acc[ai][bj][m][n], 0, 0, 0); __builtin_amdgcn_s_setprio(0); } while (0)
#define PG8_WAIT_V(n) asm volatile("s_waitcnt vmcnt(" #n ")" ::: "memory")
#define PG8_WAIT_L(n) asm volatile("s_waitcnt lgkmcnt(" #n ")" ::: "memory")
#define PG8_BAR __builtin_amdgcn_s_barrier()
#define PG8_SCHED __builtin_amdgcn_sched_barrier(0)
    Unit cur, nxt; int ui = 0;
    if (!S.next(0, cur)) return;
    f32x4 acc[2][2][4][2];
#pragma unroll
    for (int a = 0; a < 2; ++a)
#pragma unroll
        for (int b = 0; b < 2; ++b)
#pragma unroll
            for (int m = 0; m < 4; ++m)
#pragma unroll
                for (int n = 0; n < 2; ++n) acc[a][b][m][n] = (f32x4){0.f, 0.f, 0.f, 0.f};
    bf16x8 At[4][2], B0[2][2], B1[2][2];
    const char* cA = (const char*)g.A + (size_t)cur.pm * tstep; const char* cB = (const char*)g.Bt + (size_t)cur.pn * tstep;
    S.a_ready(cur);
    if constexpr (SP2) {
        PG8_STAGE(PG8_SB(0, 0), cB, voffB); PG8_STAGE(PG8_SB(0, 1), cB + hstep, voffB); PG8_STAGE(PG8_SA(0, 0), cA, voffA); PG8_STAGE(PG8_SA(0, 1), cA + hstep, voffA);
        if (wr == 1) PG8_BAR;
        PG8_WAIT_V(2); PG8_BAR;
        PG8_STAGE(PG8_SB(1, 0), cB + kstep, voffB); PG8_STAGE(PG8_SA(1, 0), cA + kstep, voffA); PG8_STAGE(PG8_SB(1, 1), cB + hstep + kstep, voffB);
        PG8_WAIT_V(6); PG8_BAR;
    } else {
        PG8_STAGE(PG8_SB(0, 0), cB, voffB); PG8_STAGE(PG8_SA(0, 0), cA, voffA); PG8_STAGE(PG8_SB(0, 1), cB + hstep, voffB); PG8_STAGE(PG8_SA(0, 1), cA + hstep, voffA);
        if (wr == 1) PG8_BAR;
        PG8_WAIT_V(4); PG8_BAR;
        PG8_STAGE(PG8_SB(1, 0), cB + kstep, voffB); PG8_STAGE(PG8_SA(1, 0), cA + kstep, voffA); PG8_STAGE(PG8_SB(1, 1), cB + hstep + kstep, voffB);
        PG8_WAIT_V(6); PG8_BAR;
    }
    for (;;) {
        const bool has_next = S.next(ui + 1, nxt);
        const char* nA = has_next ? (const char*)g.A + (size_t)nxt.pm * tstep : cA; const char* nB = has_next ? (const char*)g.Bt + (size_t)nxt.pn * tstep : cB;
        for (int t = 0; t < nt; t += 2) {
            const bool last = (t == nt - 2);
            const char* a1 = cA + (size_t)(t + 1) * kstep;
            const char* a2 = last ? nA : cA + (size_t)(t + 2) * kstep; const char* b2 = last ? nB : cB + (size_t)(t + 2) * kstep;
            const char* a3 = a2 + kstep; const char* b3 = b2 + kstep;
            if (last && has_next) S.a_ready(nxt);
            if constexpr (SP2) {
            PG8_LDB(B0, 0, 0); PG8_LDB(B1, 0, 1); PG8_SCHED; PG8_LDA(At, 0, 0); PG8_STAGE(PG8_SA(1, 1), a1 + hstep, voffA);
            PG8_WAIT_V(8); PG8_WAIT_L(0); PG8_BAR; PG8_MMA(0, 0, At, B0); PG8_MMA(0, 1, At, B1); PG8_BAR; PG8_SCHED;
            PG8_LDA(At, 0, 1); PG8_STAGE(PG8_SB(0, 0), b2, voffB); PG8_STAGE(PG8_SB(0, 1), b2 + hstep, voffB); PG8_STAGE(PG8_SA(0, 0), a2, voffA);
            PG8_WAIT_V(8); PG8_WAIT_L(0); PG8_BAR; PG8_MMA(1, 0, At, B0); PG8_MMA(1, 1, At, B1); PG8_BAR; PG8_SCHED;
            PG8_LDB(B0, 1, 0); PG8_LDB(B1, 1, 1); PG8_SCHED; PG8_LDA(At, 1, 0); PG8_STAGE(PG8_SA(0, 1), a2 + hstep, voffA);
            PG8_WAIT_V(8); PG8_WAIT_L(0); PG8_BAR; PG8_MMA(0, 0, At, B0); PG8_MMA(0, 1, At, B1); PG8_BAR; PG8_SCHED;
            PG8_LDA(At, 1, 1); PG8_STAGE(PG8_SB(1, 0), b3, voffB); PG8_STAGE(PG8_SB(1, 1), b3 + hstep, voffB); PG8_STAGE(PG8_SA(1, 0), a3, voffA);
            PG8_WAIT_V(8); PG8_WAIT_L(0); PG8_BAR; PG8_MMA(1, 0, At, B0); PG8_MMA(1, 1, At, B1); PG8_BAR; PG8_SCHED;
            } else {
            PG8_LDB(B0, 0, 0); PG8_SCHED; PG8_LDA(At, 0, 0); PG8_STAGE(PG8_SA(1, 1), a1 + hstep, voffA);
            PG8_WAIT_L(8); PG8_BAR; PG8_WAIT_L(0); PG8_MMA(0, 0, At, B0); PG8_BAR; PG8_SCHED;
            PG8_LDB(B1, 0, 1); PG8_STAGE(PG8_SB(0, 0), b2, voffB);
            PG8_BAR; PG8_WAIT_L(0); PG8_MMA(0, 1, At, B1); PG8_BAR;
            PG8_LDA(At, 0, 1); PG8_STAGE(PG8_SA(0, 0), a2, voffA);
            PG8_BAR; PG8_WAIT_L(0); PG8_MMA(1, 0, At, B0); PG8_BAR; PG8_SCHED;
            PG8_STAGE(PG8_SB(0, 1), b2 + hstep, voffB);
            PG8_WAIT_V(6); PG8_BAR; PG8_MMA(1, 1, At, B1); PG8_BAR;
            PG8_LDB(B0, 1, 0); PG8_SCHED; PG8_LDA(At, 1, 0); PG8_STAGE(PG8_SA(0, 1), a2 + hstep, voffA);
            PG8_WAIT_L(8); PG8_BAR; PG8_WAIT_L(0); PG8_MMA(0, 0, At, B0); PG8_BAR; PG8_SCHED;
            PG8_LDB(B1, 1, 1); PG8_STAGE(PG8_SB(1, 0), b3, voffB);
            PG8_BAR; PG8_WAIT_L(0); PG8_MMA(0, 1, At, B1); PG8_BAR;
            PG8_LDA(At, 1, 1); PG8_STAGE(PG8_SA(1, 0), a3, voffA);
            PG8_BAR; PG8_WAIT_L(0); PG8_MMA(1, 0, At, B0); PG8_BAR; PG8_SCHED;
            PG8_STAGE(PG8_SB(1, 1), b3 + hstep, voffB);
            PG8_WAIT_V(6); PG8_BAR; PG8_MMA(1, 1, At, B1); PG8_BAR;
            }
        }
        if constexpr (ALIGN_EPI) { if (wr == 0) PG8_BAR; }
        if constexpr (!Epi::AFTER_DRAIN) { E(acc, cur, wr, wc, fr, fq); S.done(cur); }
        if (!has_next) break;
#pragma unroll
        for (int a = 0; a < 2; ++a)
#pragma unroll
            for (int b = 0; b < 2; ++b)
#pragma unroll
                for (int m = 0; m < 4; ++m)
#pragma unroll
                    for (int n = 0; n < 2; ++n) acc[a][b][m][n] = (f32x4){0.f, 0.f, 0.f, 0.f};
        cur = nxt; cA = nA; cB = nB; ++ui;
        if constexpr (ALIGN_EPI) { if (wr == 1) PG8_BAR; }
    }
    PG8_WAIT_V(0);
    if constexpr (!ALIGN_EPI) { if (wr == 0) PG8_BAR; }
    PG8_BAR;
    if constexpr (Epi::AFTER_DRAIN) { E.fused(acc, cur, wr, wc, fr, fq, lds, wid, lane); S.done(cur); }
#undef PG8_SA
#undef PG8_SB
#undef PG8_STAGE
#undef PG8_LDA
#undef PG8_LDB
#undef PG8_MMA
#undef PG8_WAIT_V
#undef PG8_WAIT_L
#undef PG8_BAR
#undef PG8_SCHED
}
}

template <class F> struct Epi8 {
  static constexpr bool PERM = true, AFTER_DRAIN = false;
  F f;
  DI void operator()(const pg8::f32x4 (&acc)[2][2][4][2], const pg8::Unit& u, int wr, int wc, int fr, int fq) const {
#pragma unroll
    for (int ai = 0; ai < 2; ++ai)
#pragma unroll
      for (int m = 0; m < 4; ++m) {
        const int row = u.pm * 256 + ai * 128 + wr * 64 + m * 16 + fr;
#pragma unroll
        for (int bj = 0; bj < 2; ++bj) f.st(row, u.pn * 256 + bj * 128 + wc * 32 + 8 * fq, acc[ai][bj][m][0], acc[ai][bj][m][1]);
      }
  }
};
#define LDSP ((__attribute__((address_space(3))) unsigned char*)smem_raw)
DI float row_rs(const float* __restrict__ part, int row) {
  const f32x4 a = *(const f32x4*)(part + (long)row * 16), b = *(const f32x4*)(part + (long)row * 16 + 4), c = *(const f32x4*)(part + (long)row * 16 + 8), d = *(const f32x4*)(part + (long)row * 16 + 12);
  const f32x4 s = (a + b) + (c + d);
  return rsqrtf(((s[0] + s[1]) + (s[2] + s[3])) * (1.f / 1024.f) + EPS);
}
template <class F> struct Epi8Rows {
  static constexpr bool PERM = true, AFTER_DRAIN = false;
  F f; const float* part;
  DI void operator()(const pg8::f32x4 (&acc)[2][2][4][2], const pg8::Unit& u, int wr, int wc, int fr, int fq) const {
    const int x32 = (((fq * 16 + fr) ^ 32) << 2);
#pragma unroll
    for (int ai = 0; ai < 2; ++ai)
#pragma unroll
      for (int m = 0; m < 4; ++m) {
        const int row = u.pm * 256 + ai * 128 + wr * 64 + m * 16 + fr;
        const f32x4 pp = *(const f32x4*)(part + (long)row * 16 + fq * 4);
        float sq = (pp[0] + pp[1]) + (pp[2] + pp[3]);
        sq += __builtin_bit_cast(float, __builtin_amdgcn_ds_swizzle(__builtin_bit_cast(int, sq), 0x401f));
        sq += xch32(sq, x32);
        const float rs = rsqrtf(sq * (1.f / 1024.f) + EPS);
#pragma unroll
        for (int bj = 0; bj < 2; ++bj) f.st(row, u.pn * 256 + bj * 128 + wc * 32 + 8 * fq, acc[ai][bj][m][0] * rs, acc[ai][bj][m][1] * rs);
      }
  }
};
template <class F> struct Epi8Cols {
  static constexpr bool PERM = true, AFTER_DRAIN = false;
  F f; const float* part;
  DI void operator()(const pg8::f32x4 (&acc)[2][2][4][2], const pg8::Unit& u, int wr, int wc, int fr, int fq) const {
    f32x4 r0[2], r1[2];
    const float rsl = row_rs(part, u.pn * 256 + (fr >> 3) * 128 + wc * 32 + 8 * fq + (fr & 7));
#pragma unroll
    for (int bj = 0; bj < 2; ++bj)
#pragma unroll
      for (int j = 0; j < 4; ++j) {
        r0[bj][j] = __builtin_bit_cast(float, __builtin_amdgcn_ds_bpermute(4 * (fq * 16 + bj * 8 + j), __builtin_bit_cast(int, rsl)));
        r1[bj][j] = __builtin_bit_cast(float, __builtin_amdgcn_ds_bpermute(4 * (fq * 16 + bj * 8 + 4 + j), __builtin_bit_cast(int, rsl)));
      }
#pragma unroll
    for (int ai = 0; ai < 2; ++ai)
#pragma unroll
      for (int m = 0; m < 4; ++m) {
        const int row = u.pm * 256 + ai * 128 + wr * 64 + m * 16 + fr;
#pragma unroll
        for (int bj = 0; bj < 2; ++bj) f.st(row, u.pn * 256 + bj * 128 + wc * 32 + 8 * fq, acc[ai][bj][m][0] * r0[bj], acc[ai][bj][m][1] * r1[bj]);
      }
  }
};
struct Epi8Res {
  static constexpr bool PERM = true, AFTER_DRAIN = false;
  bf16_t* xb; float* part; float accscale;
  DI void operator()(const pg8::f32x4 (&acc)[2][2][4][2], const pg8::Unit& u, int wr, int wc, int fr, int fq) const {
    const int x32 = (((fq * 16 + fr) ^ 32) << 2);
#pragma unroll
    for (int ai = 0; ai < 2; ++ai)
#pragma unroll
      for (int m = 0; m < 4; ++m) {
        const int row = u.pm * 256 + ai * 128 + wr * 64 + m * 16 + fr;
        float ss = 0.f;
#pragma unroll
        for (int bj = 0; bj < 2; ++bj) {
          const long o = (long)row * DM + u.pn * 256 + bj * 128 + wc * 32 + 8 * fq;
          const u32x4 xr = *(const u32x4*)(xb + o);
          f32x4 v0, v1;
          v0[0] = bflo(xr[0]); v0[1] = bfhi(xr[0]); v0[2] = bflo(xr[1]); v0[3] = bfhi(xr[1]);
          v1[0] = bflo(xr[2]); v1[1] = bfhi(xr[2]); v1[2] = bflo(xr[3]); v1[3] = bfhi(xr[3]);
          v0 = v0 + acc[ai][bj][m][0] * accscale; v1 = v1 + acc[ai][bj][m][1] * accscale;
          u32x4 w; w[0] = pk2(v0[0], v0[1]); w[1] = pk2(v0[2], v0[3]); w[2] = pk2(v1[0], v1[1]); w[3] = pk2(v1[2], v1[3]);
          *(u32x4*)(xb + o) = w;
          ss += (v0[0] * v0[0] + v0[1] * v0[1]) + (v0[2] * v0[2] + v0[3] * v0[3]) + (v1[0] * v1[0] + v1[1] * v1[1]) + (v1[2] * v1[2] + v1[3] * v1[3]);
        }
        ss += __builtin_bit_cast(float, __builtin_amdgcn_ds_swizzle(__builtin_bit_cast(int, ss), 0x401f));
        ss += xch32(ss, x32);
        if (fq == 0) part[(long)row * 16 + u.pn * 4 + wc] = ss;
      }
  }
};
template <class E> DI void run_gemm_e(const bf16_t* A, const bf16_t* Bt, int M, int N, int K, const E& e) {
  pg8::Gemm g{A, Bt, M, N, K};
  pg8::StaticOrder so; so.init(M, N, (int)gridDim.x, (int)blockIdx.x);
  pg8::gemm_phase<E, pg8::StaticOrder, true, true>(LDSP, g, so, e);
}
template <class F> DI void run_gemm(const bf16_t* A, const bf16_t* Bt, int M, int N, int K, const F& f) {
  pg8::Gemm g{A, Bt, M, N, K};
  pg8::StaticOrder so; so.init(M, N, (int)gridDim.x, (int)blockIdx.x);
  Epi8<F> e{f};
  pg8::gemm_phase<Epi8<F>, pg8::StaticOrder, true, true>(LDSP, g, so, e);
}
struct OneUnit { int pm, pn;
  DI bool next(int i, pg8::Unit& u) const { if (i) return false; u.pm = pm; u.pn = pn; return true; }
  DI void a_ready(const pg8::Unit&) const {}
  DI void done(const pg8::Unit&) const {} };

DI void tr_tile(const float* __restrict__ src, int lds_, int k0, int n0, bf16_t* __restrict__ dst, int ldd, int nd0, float scale, float* sm, const float* __restrict__ gk = nullptr) {
  const int t = otid() & 255;
#pragma unroll
  for (int i = 0; i < 4; ++i) {
    const int kr = (t >> 4) + 16 * i, nc = (t & 15) * 4;
    f32x4 v = *(const f32x4*)(src + (long)(k0 + kr) * lds_ + n0 + nc);
    if (gk) v = v * gk[k0 + kr];
    sm[kr * 65 + nc + 0] = v[0]; sm[kr * 65 + nc + 1] = v[1]; sm[kr * 65 + nc + 2] = v[2]; sm[kr * 65 + nc + 3] = v[3];
  }
  __syncthreads();
  const int n = t >> 2, ks = (t & 3) * 16;
  u32x4 w0, w1;
#pragma unroll
  for (int j = 0; j < 4; ++j) {
    w0[j] = pk2(sm[(ks + 2 * j) * 65 + n] * scale, sm[(ks + 2 * j + 1) * 65 + n] * scale);
    w1[j] = pk2(sm[(ks + 8 + 2 * j) * 65 + n] * scale, sm[(ks + 8 + 2 * j + 1) * 65 + n] * scale);
  }
  bf16_t* d = dst + (long)(nd0 + n) * ldd + k0 + ks;
  *(u32x4*)d = w0; *(u32x4*)(d + 8) = w1;
  __syncthreads();
}

constexpr int NT_ALL = DEPTH * 28 * 16, NT_OUT = DEPTH * 16 * 16, NT_UP = DEPTH * 64 * 16, NT_DOWN = DEPTH * 16 * 64, NT_PW = DEPTH * 4 * 4;
constexpr int N_FOLD = DEPTH * 2 * 4 * 4, N_SGU = 128, N_DM = 112, N_LAM = 1;
constexpr int PREP_ITEMS = NT_ALL + NT_OUT + NT_UP + NT_DOWN + NT_PW + N_FOLD + N_SGU + N_DM + N_LAM;

DI void prep_item(const Params& p, int it, float* sm) {
  const int t = otid() & 255;
  if (it < NT_ALL) {
    const int l = it / (28 * 16), rem = it % (28 * 16), nt = rem / 16, kt = rem % 16;
    const int nd = nt * 64;
    int nsrc; float scale = 1.f;
    if (nd < 512) { nsrc = nd; if (nd < 256) scale = 0.17677669529663687f * LOG2E; }
    else if (nd < 1024) nsrc = 768 + (nd - 512);
    else if (nd < 1536) nsrc = 1536 + (nd - 1024);
    else nsrc = 512 + (nd - 1536);
    tr_tile(p.w_in + (long)l * DM * 2048, 2048, kt * 64, nsrc, p.WallT + (long)l * WALL_N * DM, DM, nd, scale, sm, p.norm1_g + l * DM);
    return;
  }
  it -= NT_ALL;
  if (it < NT_OUT) {
    const int l = it / 256, rem = it % 256, nt = rem / 16, kt = rem % 16;
    tr_tile(p.w_out + (long)l * DM * DM, DM, kt * 64, nt * 64, p.WoutT + (long)l * DM * DM, DM, nt * 64, 1.f, sm);
    return;
  }
  it -= NT_OUT;
  if (it < NT_UP) {
    const int l = it / 1024, rem = it % 1024, nt = rem / 16, kt = rem % 16;
    tr_tile(p.w_up + (long)l * DM * DFF, DFF, kt * 64, nt * 64, p.WupT + (long)l * DFF * DM, DM, nt * 64, 1.f, sm, p.norm2_g + l * DM);
    return;
  }
  it -= NT_UP;
  if (it < NT_DOWN) {
    const int l = it / 1024, rem = it % 1024, nt = rem / 64, kt = rem % 64;
    tr_tile(p.w_down + (long)l * DFF * DM, DM, kt * 64, nt * 64, p.WdownT + (long)l * DM * DFF, DFF, nt * 64, 1.f, sm);
    return;
  }
  it -= NT_DOWN;
  if (it < NT_PW) {
    const int l = it / 16, rem = it % 16, nt = rem / 4, kt = rem % 4;
    tr_tile(p.conv_pw_w + (long)l * 65536, 256, kt * 64, nt * 64, p.pwT + (long)l * 65536, 256, nt * 64, 1.f, sm);
    return;
  }
  it -= NT_PW;
  if (it < N_FOLD) {
    const int l = it >> 5, pq = (it >> 4) & 1, g = (it >> 2) & 3, kcn = it & 3;
    const float* fw = p.fnet_w + ((long)l * 4 + g) * 4096;
    for (int idx = t; idx < 4096; idx += 256) {
      const int c = idx >> 6, e = idx & 63;
      float s = 0.f;
      for (int kc = 0; kc < 64; ++kc) {
        const int m = (c * kc) & 63;
        const float tr = pq ? sinpif((float)m * (1.f / 32.f)) : cospif((float)m * (1.f / 32.f));
        s += tr * fw[kc * 64 + e];
      }
      sm[idx] = s * (1.f / 512.f);
    }
    __syncthreads();
    const int k = kcn * 256 + t;
    const float gk1 = p.norm1_g[l * DM + k];
    const float* wr = p.w_in + (long)l * DM * 2048 + (long)k * 2048 + 1280 + g * 64;
    f32x4 wv[16];
#pragma unroll
    for (int i = 0; i < 16; ++i) wv[i] = *(const f32x4*)(wr + 4 * i);
    bf16_t* dst = p.WallT + (long)l * WALL_N * DM + (long)(1792 + pq * 256 + g * 64) * DM + k;
#pragma unroll 1
    for (int e = 0; e < 64; ++e) {
      float s = 0.f;
#pragma unroll
      for (int i = 0; i < 16; ++i) {
        s += wv[i][0] * sm[(4 * i + 0) * 64 + e]; s += wv[i][1] * sm[(4 * i + 1) * 64 + e];
        s += wv[i][2] * sm[(4 * i + 2) * 64 + e]; s += wv[i][3] * sm[(4 * i + 3) * 64 + e];
      }
      dst[(long)e * DM] = (bf16_t)(pk2(s * gk1, 0.f) & 0xffffu);
    }
    __syncthreads();
    return;
  }
  it -= N_FOLD;
  if (it < N_SGU) {
    const long o = (long)it * 2048 + t * 8;
    const f32x4 a = *(const f32x4*)(p.sgu_w + o), b = *(const f32x4*)(p.sgu_w + o + 4);
    u32x4 w; w[0] = pk2(a[0], a[1]); w[1] = pk2(a[2], a[3]); w[2] = pk2(b[0], b[1]); w[3] = pk2(b[2], b[3]);
    *(u32x4*)(p.sguW + o) = w;
    return;
  }
  it -= N_SGU;
  if (it < N_DM) {
    const int e = it * 256 + t;
    if (e < 16384) {
      const int m = e >> 7, k = e & 127, ro = m >> 6, k1 = m & 63, ri = k >> 6, s1 = k & 63;
      const float ang = (float)((s1 * k1) & 63) * (1.f / 32.f);
      const float c = cospif(ang), sn = sinpif(ang);
      const float v = (ro == 0) ? (ri == 0 ? c : -sn) : (ri == 0 ? sn : c);
      p.M1[e] = (bf16_t)(pk2(v, 0.f) & 0xffffu);
    } else if (e < 16384 + 8192) {
      const int e2 = e - 16384, k2 = e2 >> 7, k = e2 & 127, ri = k >> 6, s2 = k & 63;
      const float ang = (float)((s2 * k2) & 63) * (1.f / 32.f);
      const float v = (ri == 0) ? cospif(ang) : -sinpif(ang);
      p.M3[e2] = (bf16_t)(pk2(v, 0.f) & 0xffffu);
    } else {
      const int e3 = e - 16384 - 8192, k1 = e3 >> 6, s2 = e3 & 63;
      const float ang = (float)(s2 * k1) * (1.f / 2048.f);
      ((unsigned*)p.TW)[e3] = pk2(cospif(ang), sinpif(ang));
    }
    return;
  }
  it -= N_DM;
  if (t < DEPTH) {
    const int l = t;
    float s1 = 0.f, s2 = 0.f;
    for (int i = 0; i < 32; ++i) { s1 += p.lam_q1[l * 32 + i] * p.lam_k1[l * 32 + i]; s2 += p.lam_q2[l * 32 + i] * p.lam_k2[l * 32 + i]; }
    const float lam_init = 0.8f - 0.6f * expf(-0.3f * (float)l);
    p.lam[l] = expf(s1) - expf(s2) + lam_init;
  }
}

NI void prep_phase() {
  KPARAMS;
  const int half = otid() >> 8;
  float* sm = (float*)smem_raw + half * (HALF_E / 2);
  for (int it0 = blockIdx.x * 2 + half; it0 < PREP_ITEMS; it0 += gridDim.x * 2) prep_item(p, it0, sm);
  const int tid_ = otid(); const int lane = tid_ & 63, wid = tid_ >> 6, x32 = ((lane ^ 32) << 2);
  for (int row = blockIdx.x * 8 + wid; row < NTOK; row += gridDim.x * 8) {
    const float* sp = p.x + (long)row * DM;
    float ss = 0.f;
#pragma unroll
    for (int i = 0; i < 4; ++i) {
      const f32x4 v = *(const f32x4*)(sp + lane * 4 + 256 * i);
      ss += v[0] * v[0] + v[1] * v[1] + v[2] * v[2] + v[3] * v[3];
      u32x2 w; w[0] = pk2(v[0], v[1]); w[1] = pk2(v[2], v[3]); *(u32x2*)(p.xn + (long)row * DM + lane * 4 + 256 * i) = w;
    }
    ss = wave_sum(ss, x32);
    if (lane < 16) p.part[(long)row * 16 + lane] = (lane == 0) ? ss : 0.f;
  }
}

NI void final_rms_phase(const bf16_t* __restrict__ src, const float* __restrict__ g, float* __restrict__ dstf) {
  const int tid_ = otid(); const int lane = tid_ & 63, wid = tid_ >> 6, x32 = ((lane ^ 32) << 2);
  f32x4 gv[4];
#pragma unroll
  for (int i = 0; i < 4; ++i) gv[i] = *(const f32x4*)(g + lane * 4 + 256 * i);
  for (int row = blockIdx.x * 8 + wid; row < NTOK; row += gridDim.x * 8) {
    f32x4 v[4];
    float ss = 0.f;
#pragma unroll
    for (int i = 0; i < 4; ++i) {
      const u32x2 r = *(const u32x2*)(src + (long)row * DM + lane * 4 + 256 * i);
      v[i][0] = bflo(r[0]); v[i][1] = bfhi(r[0]); v[i][2] = bflo(r[1]); v[i][3] = bfhi(r[1]);
      ss += v[i][0] * v[i][0] + v[i][1] * v[i][1] + v[i][2] * v[i][2] + v[i][3] * v[i][3];
    }
    ss = wave_sum(ss, x32);
    const float rs = rsqrtf(ss * (1.f / 1024.f) + EPS);
#pragma unroll
    for (int i = 0; i < 4; ++i) *(f32x4*)(dstf + (long)row * DM + lane * 4 + 256 * i) = v[i] * rs * gv[i];
  }
}

DI u32x4 pk8(f32x4 a, f32x4 b) { u32x4 w; w[0] = pk2(a[0], a[1]); w[1] = pk2(a[2], a[3]); w[2] = pk2(b[0], b[1]); w[3] = pk2(b[2], b[3]); return w; }
struct StH { bf16_t* h; DI void st(int r, int c, f32x4 a, f32x4 b) const { *(u32x4*)(h + (long)r * HC + c) = pk8(a, b); } };
struct StT { bf16_t* Vt; bf16_t* PQt;
  DI void st(int n, int tok, f32x4 a, f32x4 b) const {
    const int bb = tok >> 12, s = tok & 4095; const u32x4 w = pk8(a, b);
    if (n < 256) *(u32x4*)(Vt + ((long)(bb * 256 + n)) * 4096 + s) = w;
    else { const int np = n - 256, pq = np >> 8, ch = np & 255; *(u32x4*)(PQt + ((long)(bb * 256 + ch)) * 8192 + pq * 4096 + s) = w; }
  } };
struct StRes { const float* xin; float* out;
  DI void st(int r, int c, f32x4 a, f32x4 b) const { const long o = (long)r * DM + c; const f32x4 x0 = *(const f32x4*)(xin + o), x1 = *(const f32x4*)(xin + o + 4); *(f32x4*)(out + o) = x0 + a; *(f32x4*)(out + o + 4) = x1 + b; } };
struct StUp { bf16_t* hid;
  DI void st(int r, int c, f32x4 a, f32x4 b) const {
#pragma unroll
    for (int j = 0; j < 4; ++j) { a[j] = fmaxf(a[j], 0.f); b[j] = fmaxf(b[j], 0.f); }
    *(u32x4*)(hid + (long)r * DFF + c) = pk8(a * a, b * b); } };

NI void gemm_in_phase(int l) {
  KPARAMS;
  const bf16_t* W = p.WallT + (long)l * WALL_N * DM;
  run_gemm_e(p.xn, W, NTOK, HC, DM, Epi8Rows<StH>{StH{p.h}, p.part});
  run_gemm_e(W + (long)HC * DM, p.xn, 768, NTOK, DM, Epi8Cols<StT>{StT{p.Vt, p.PQt}, p.part});
}
NI void gemm_out_phase(int l, float accscale) {
  KPARAMS;
  run_gemm_e(p.y, p.WoutT + (long)l * DM * DM, NTOK, DM, DM, Epi8Res{p.xn, p.part, accscale});
}
NI void gemm_up_phase(int l) {
  KPARAMS;
  run_gemm_e(p.xn, p.WupT + (long)l * DFF * DM, NTOK, DFF, DM, Epi8Rows<StUp>{StUp{p.hid}, p.part});
}
NI void gemm_down_phase(int l, float accscale) {
  KPARAMS;
  run_gemm_e(p.hid, p.WdownT + (long)l * DM * DFF, NTOK, DM, DFF, Epi8Res{p.xn, p.part, accscale});
}

constexpr int ARS = 72;
constexpr int ATILE = 64 * ARS;
NI void attn_tile(int l, int id, LAS3 unsigned* cnt, unsigned& target) {
  KPARAMS;
  const int tidf = otid(), half = __builtin_amdgcn_readfirstlane(tidf >> 8), tid = tidf & 255, lane = tid & 63, wid = __builtin_amdgcn_readfirstlane(tid >> 6), r = lane & 31, hh = lane >> 5, x32 = ((lane ^ 32) << 2);
  bf16_t* smem = SMEM + half * HALF_E;
  const int head = 3 - (id >> 8), b = (id >> 5) & 7, qb = id & 31;
  const float slope = (head == 0) ? 0.25f : (head == 1) ? 0.0625f : (head == 2) ? 0.015625f : 0.00390625f;
  const float ncs = -slope * LOG2E, cs = slope * LOG2E;
  const int qi = qb * 128 + wid * 32 + r;
  const bf16_t* qrow = p.h + ((long)(b * SEQ + qi)) * HC + head * 64;
  bf16x8 qf[2][2];
#pragma unroll
  for (int m = 0; m < 2; ++m)
#pragma unroll
    for (int s = 0; s < 2; ++s) qf[m][s] = *(const bf16x8*)(qrow + m * 32 + s * 16 + hh * 8);
  const bf16_t* kbase = p.h + ((long)(b * SEQ)) * HC + 256 + head * 64;
  const bf16_t* vbase = p.Vt + ((long)((b * 4 + head) * 64)) * SEQ;
  const int srow = tid >> 3, scol = (tid & 7) * 8;
  u32x4 rk[2], rv[2];
  f32x16 O[2][2];
#pragma unroll
  for (int m = 0; m < 2; ++m)
#pragma unroll
    for (int vb = 0; vb < 2; ++vb)
#pragma unroll
      for (int i = 0; i < 16; ++i) O[m][vb][i] = 0.f;
  float mrun[2] = {0.f, 0.f}, lrun[2] = {0.f, 0.f};
  const int kperm = (r & 19) | ((r & 4) << 1) | ((r & 8) >> 1);
  const int ktd = (qb * 128 + wid * 32) >> 6;
  unsigned csw, jrelw[2];
  { const unsigned h_ = pk2(cs, 0.f) & 0xffffu; csw = h_ | (pk2(cs - bflo(h_), 0.f) << 16); }
#pragma unroll
  for (int kb = 0; kb < 2; ++kb) { const float j_ = (float)(kb * 32 + kperm); jrelw[kb] = pk2(j_, j_); }

  const int wkeys = (head == 0) ? 305 : (head == 1) ? 1220 : SEQ;
  const int kt_lo = max(0, qb * 128 - wkeys) >> 6, kt_hi = min(SEQ, qb * 128 + 128 + wkeys + 63) >> 6;
#pragma unroll
  for (int i = 0; i < 2; ++i) {
    rk[i] = *(const u32x4*)(kbase + (long)(kt_lo * 64 + srow + 32 * i) * HC + scol);
    rv[i] = *(const u32x4*)(vbase + (long)(srow + 32 * i) * SEQ + kt_lo * 64 + scol);
  }
#pragma unroll
  for (int i = 0; i < 2; ++i) { *(u32x4*)(smem + (srow + 32 * i) * ARS + scol) = rk[i]; *(u32x4*)(smem + ATILE + (srow + 32 * i) * ARS + scol) = rv[i]; }
  asm volatile("" :: "v"(qf[0][0]), "v"(qf[0][1]), "v"(qf[1][0]), "v"(qf[1][1]));
  HBAR();
  for (int kt = kt_lo; kt < kt_hi; ++kt) {
    const bool more = (kt + 1) < kt_hi;
    if (more) {
#pragma unroll
      for (int i = 0; i < 2; ++i) {
        rk[i] = *(const u32x4*)(kbase + (long)((kt + 1) * 64 + srow + 32 * i) * HC + scol);
        rv[i] = *(const u32x4*)(vbase + (long)(srow + 32 * i) * SEQ + (kt + 1) * 64 + scol);
      }
    }
    const bf16_t* Ks = smem + ((kt - kt_lo) & 1) * 2 * ATILE;
    const bf16_t* Vs = Ks + ATILE;
    const float dbase = (float)(qi - kt * 64 - 8 * hh);
    const bool diag = (kt == ktd);
#pragma unroll
    for (int m = 0; m < 2; ++m) {
      __builtin_amdgcn_sched_barrier(0);
      f32x16 x[2];
      if (!diag) {
        const bool left = kt < ktd;
        const float C = fmaf(left ? cs : -cs, (float)(kt * 64 - qi), -mrun[m]);
        const unsigned wC = pk2(C, 0.f), wL = pk2(C - bflo(wC), 0.f);
        u32x4 qa; qa[0] = hh ? 0u : (left ? csw : (csw ^ 0x80008000u)); qa[1] = hh ? 0u : ((wC & 0xffffu) | (wL << 16)); qa[2] = 0u; qa[3] = 0u;
#pragma unroll
        for (int kb = 0; kb < 2; ++kb) {
          u32x4 ka; ka[0] = hh ? 0u : jrelw[kb]; ka[1] = hh ? 0u : 0x3f803f80u; ka[2] = 0u; ka[3] = 0u;
#pragma unroll
          for (int i = 0; i < 16; ++i) x[kb][i] = 0.f;
          x[kb] = __builtin_amdgcn_mfma_f32_32x32x16_bf16(__builtin_bit_cast(bf16x8, ka), __builtin_bit_cast(bf16x8, qa), x[kb], 0, 0, 0);
#pragma unroll
          for (int s = 0; s < 2; ++s) {
            const bf16x8 kf = *(const bf16x8*)(Ks + (kb * 32 + kperm) * ARS + m * 32 + s * 16 + hh * 8);
            x[kb] = __builtin_amdgcn_mfma_f32_32x32x16_bf16(kf, qf[m][s], x[kb], 0, 0, 0);
          }
        }
      } else {
#pragma unroll
        for (int kb = 0; kb < 2; ++kb) {
#pragma unroll
          for (int i = 0; i < 16; ++i) x[kb][i] = 0.f;
#pragma unroll
          for (int s = 0; s < 2; ++s) {
            const bf16x8 kf = *(const bf16x8*)(Ks + (kb * 32 + kperm) * ARS + m * 32 + s * 16 + hh * 8);
            x[kb] = __builtin_amdgcn_mfma_f32_32x32x16_bf16(kf, qf[m][s], x[kb], 0, 0, 0);
          }
        }
        const float nm = -mrun[m];
#pragma unroll
        for (int kb = 0; kb < 2; ++kb)
#pragma unroll
          for (int i = 0; i < 16; ++i) {
            const float off = (float)(kb * 32 + 16 * (i >> 3) + (i & 7));
            x[kb][i] = fmaf(ncs, fabsf(dbase - off), x[kb][i]) + nm;
          }
      }
      float mx = -1e30f;
#pragma unroll
      for (int kb = 0; kb < 2; ++kb)
#pragma unroll
        for (int i = 0; i < 16; ++i) mx = fmaxf(mx, x[kb][i]);
      mx = fmaxf(mx, xch32(mx, x32));
      if (__builtin_amdgcn_ballot_w64(mx > 8.f) != 0ull) {
        const float delta = fmaxf(mx, 0.f);
        const float alpha = __builtin_amdgcn_exp2f(-delta);
        mrun[m] += delta;
        lrun[m] *= alpha;
#pragma unroll
        for (int vb = 0; vb < 2; ++vb)
#pragma unroll
          for (int i = 0; i < 16; ++i) O[m][vb][i] *= alpha;
#pragma unroll
        for (int kb = 0; kb < 2; ++kb)
#pragma unroll
          for (int i = 0; i < 16; ++i) x[kb][i] -= delta;
      }
      float ps = 0.f;
#pragma unroll
      for (int kb = 0; kb < 2; ++kb)
#pragma unroll
        for (int i = 0; i < 16; ++i) { x[kb][i] = __builtin_amdgcn_exp2f(x[kb][i]); ps += x[kb][i]; }
      lrun[m] += ps;
#pragma unroll
      for (int kb = 0; kb < 2; ++kb)
#pragma unroll
        for (int s = 0; s < 2; ++s) {
          u32x4 pw;
#pragma unroll
          for (int j = 0; j < 4; ++j) pw[j] = pk2(x[kb][8 * s + 2 * j], x[kb][8 * s + 2 * j + 1]);
          const bf16x8 pf = __builtin_bit_cast(bf16x8, pw);
#pragma unroll
          for (int vb = 0; vb < 2; ++vb) {
            const bf16x8 vf = *(const bf16x8*)(Vs + (vb * 32 + r) * ARS + kb * 32 + s * 16 + hh * 8);
            O[m][vb] = __builtin_amdgcn_mfma_f32_32x32x16_bf16(vf, pf, O[m][vb], 0, 0, 0);
          }
        }
    }
    if (more) {
      bf16_t* wk = smem + ((kt + 1 - kt_lo) & 1) * 2 * ATILE;
#pragma unroll
      for (int i = 0; i < 2; ++i) { *(u32x4*)(wk + (srow + 32 * i) * ARS + scol) = rk[i]; *(u32x4*)(wk + ATILE + (srow + 32 * i) * ARS + scol) = rv[i]; }
    }
    HBAR();
  }
  asm volatile("" ::: "memory");
  const int tid2 = otid() & 255, lane2 = tid2 & 63, hh2 = lane2 >> 5, qi2 = qb * 128 + __builtin_amdgcn_readfirstlane(tid2 >> 6) * 32 + (lane2 & 31);
  const float lam = p.lam[l];
  int lx = l; asm volatile("" : "+s"(lx));
  const float lam_init = (lx == 0) ? 0.2f : (lx == 1) ? 0.35550907f : (lx == 2) ? 0.47071302f : 0.55605820f;
  const float l1 = lrun[0] + xch32(lrun[0], x32), l2 = lrun[1] + xch32(lrun[1], x32);
  const float i1 = 1.f / l1, i2 = lam / l2;
  float ss = 0.f;
#pragma unroll
  for (int vb = 0; vb < 2; ++vb)
#pragma unroll
    for (int i = 0; i < 16; ++i) { const float o = O[0][vb][i] * i1 - O[1][vb][i] * i2; O[0][vb][i] = o; ss += o * o; }
  ss += xch32(ss, x32);
  const float rs = rsqrtf(ss * (1.f / 64.f) + EPS) * (1.f - lam_init);
  const float* sg = p.subln_g + l * 64;
  bf16_t* yrow = p.y + ((long)(b * SEQ + qi2)) * DM + head * 64;
#pragma unroll
  for (int vb = 0; vb < 2; ++vb)
#pragma unroll
    for (int g4 = 0; g4 < 4; ++g4) {
      const int vc = vb * 32 + 8 * g4 + 4 * hh2;
      const f32x4 gg = *(const f32x4*)(sg + vc);
      u32x2 w;
      w[0] = pk2(O[0][vb][4 * g4 + 0] * rs * gg[0], O[0][vb][4 * g4 + 1] * rs * gg[1]);
      w[1] = pk2(O[0][vb][4 * g4 + 2] * rs * gg[2], O[0][vb][4 * g4 + 3] * rs * gg[3]);
      *(u32x2*)(yrow + vc) = w;
    }
}

constexpr int ZRS = 264;
NI void conv_tile(int l, int id, LAS3 unsigned* cnt, unsigned& target) {
  KPARAMS;
  const int tidf = otid(), half = __builtin_amdgcn_readfirstlane(tidf >> 8), tid = tidf & 255, lane = tid & 63, wid = __builtin_amdgcn_readfirstlane(tid >> 6), x32 = ((lane ^ 32) << 2);
  bf16_t* smem = SMEM + half * HALF_E;
  const int b = id >> 6, t0 = (id & 63) * 64;
  for (int idx = tid; idx < 94 * 32; idx += 256) {
    const int row = idx >> 5, c8 = (idx & 31) * 8;
    const int tok = t0 - 15 + row;
    u32x4 w = (u32x4){0u, 0u, 0u, 0u};
    if (tok >= 0 && tok < SEQ) {
      const bf16_t* hp = p.h + ((long)(b * SEQ + tok)) * HC + 512 + c8;
      const u32x4 a = *(const u32x4*)hp, g = *(const u32x4*)(hp + 256);
#pragma unroll
      for (int j = 0; j < 4; ++j) {
        const float a0 = bflo(a[j]), a1 = bfhi(a[j]), g0 = bflo(g[j]), g1 = bfhi(g[j]);
        w[j] = pk2(a0 * __builtin_amdgcn_rcpf(1.f + __builtin_amdgcn_exp2f(-LOG2E * g0)), a1 * __builtin_amdgcn_rcpf(1.f + __builtin_amdgcn_exp2f(-LOG2E * g1)));
      }
    }
    *(u32x4*)(smem + row * ZRS + c8) = w;
  }
  HBAR();
  {
    const int c = tid;
    float wv[31];
#pragma unroll
    for (int j = 0; j < 31; ++j) wv[j] = p.conv_dw_w[((long)l * 31 + j) * 256 + c];
    const float cb = p.conv_dw_b[l * 256 + c], lg = p.conv_ln_g[l * 256 + c], lb = p.conv_ln_b[l * 256 + c];
#pragma unroll 1
    for (int ch = 0; ch < 8; ++ch) {
      float zw[38];
#pragma unroll
      for (int j = 0; j < 38; ++j) zw[j] = bf2f(smem[(ch * 8 + j) * ZRS + c]);
      float o[8];
#pragma unroll
      for (int tt = 0; tt < 8; ++tt) {
        float s = cb;
#pragma unroll
        for (int j = 0; j < 31; ++j) s = fmaf(wv[j], zw[tt + j], s);
        o[tt] = s;
      }
#pragma unroll
      for (int tt = 0; tt < 8; ++tt) {
        const float s1 = wave_sum(o[tt], x32), s2 = wave_sum(o[tt] * o[tt], x32);
        const float mu = s1 * (1.f / 64.f);
        const float var = fmaxf(s2 * (1.f / 64.f) - mu * mu, 0.f);
        const float yv = (o[tt] - mu) * rsqrtf(var + EPS) * lg + lb;
        const float sv = yv * __builtin_amdgcn_rcpf(1.f + __builtin_amdgcn_exp2f(-LOG2E * yv));
        smem[(ch * 8 + tt) * ZRS + c] = (bf16_t)(pk2(sv, 0.f) & 0xffffu);
      }
    }
  }
  HBAR();
  {
    const int fr = lane & 15, fq = lane >> 4;
    const bf16_t* W = p.pwT + (long)l * 65536 + (long)(wid * 64) * 256;
    f32x4 acc[4][4];
#pragma unroll
    for (int m = 0; m < 4; ++m)
#pragma unroll
      for (int n = 0; n < 4; ++n) acc[m][n] = (f32x4){0.f, 0.f, 0.f, 0.f};
#pragma unroll 2
    for (int ks = 0; ks < 8; ++ks) {
      bf16x8 af[4], bfr[4];
#pragma unroll
      for (int m = 0; m < 4; ++m) af[m] = *(const bf16x8*)(smem + (m * 16 + fr) * ZRS + ks * 32 + fq * 8);
#pragma unroll
      for (int n = 0; n < 4; ++n) bfr[n] = *(const bf16x8*)(W + (long)(n * 16 + fr) * 256 + ks * 32 + fq * 8);
#pragma unroll
      for (int m = 0; m < 4; ++m)
#pragma unroll
        for (int n = 0; n < 4; ++n) acc[m][n] = __builtin_amdgcn_mfma_f32_16x16x32_bf16(bfr[n], af[m], acc[m][n], 0, 0, 0);
    }
    const float* pb = p.conv_pw_b + l * 256;
#pragma unroll
    for (int m = 0; m < 4; ++m)
#pragma unroll
      for (int n = 0; n < 4; ++n) {
        const int tok = t0 + m * 16 + fr, col = wid * 64 + n * 16 + fq * 4;
        const f32x4 bv = *(const f32x4*)(pb + col);
        const f32x4 v = acc[m][n] + bv;
        u32x2 w; w[0] = pk2(v[0], v[1]); w[1] = pk2(v[2], v[3]);
        *(u32x2*)(p.y + ((long)(b * SEQ + tok)) * DM + 256 + col) = w;
      }
  }
  HBAR();
}

constexpr int VRS = 258;
NI void sgu_tile(int l, int id, LAS3 unsigned* cnt, unsigned& target) {
  KPARAMS;
  const int tidf = otid(), half = __builtin_amdgcn_readfirstlane(tidf >> 8), tid = tidf & 255, lane = tid & 63, wid = __builtin_amdgcn_readfirstlane(tid >> 6), x32 = ((lane ^ 32) << 2);
  bf16_t* smem = SMEM + half * HALF_E;
  const long T0 = (long)id * 128;
  {
    const f32x4 lg = *(const f32x4*)(p.sgu_ln_g + l * 256 + lane * 4), lb = *(const f32x4*)(p.sgu_ln_b + l * 256 + lane * 4);
#pragma unroll 4
    for (int i = 0; i < 32; ++i) {
      const int s = wid * 32 + i;
      const u32x2 raw = *(const u32x2*)(p.h + (T0 + s) * HC + 1280 + lane * 4);
      const float v0 = bflo(raw[0]), v1 = bfhi(raw[0]), v2 = bflo(raw[1]), v3 = bfhi(raw[1]);
      const float s1 = wave_sum(v0 + v1 + v2 + v3, x32);
      const float mu = s1 * (1.f / 256.f);
      const float d0 = v0 - mu, d1 = v1 - mu, d2 = v2 - mu, d3 = v3 - mu;
      const float s2 = wave_sum(d0 * d0 + d1 * d1 + d2 * d2 + d3 * d3, x32);
      const float rs = rsqrtf(s2 * (1.f / 256.f) + EPS);
      unsigned* dst = (unsigned*)(smem + s * VRS + lane * 4);
      dst[0] = pk2(d0 * rs * lg[0] + lb[0], d1 * rs * lg[1] + lb[1]);
      dst[1] = pk2(d2 * rs * lg[2] + lb[2], d3 * rs * lg[3] + lb[3]);
    }
  }
  HBAR();
  {
    const int fr = lane & 15, fq = lane >> 4, g = wid;
    const bf16_t* W = p.sguW + ((long)(l * 4 + g)) * 16384;
    const float* bs = p.sgu_b + ((long)(l * 4 + g)) * 128;
#pragma unroll 1
    for (int th = 0; th < 2; ++th) {
      f32x4 acc[4][4];
#pragma unroll
      for (int m = 0; m < 4; ++m)
#pragma unroll
        for (int n = 0; n < 4; ++n) acc[m][n] = (f32x4){0.f, 0.f, 0.f, 0.f};
#pragma unroll 1
      for (int ks = 0; ks < 4; ++ks) {
        bf16x8 vf[4], wf[4];
#pragma unroll
        for (int n = 0; n < 4; ++n) {
#pragma unroll
          for (int j = 0; j < 8; ++j) vf[n][j] = (short)smem[(ks * 32 + fq * 8 + j) * VRS + g * 64 + n * 16 + fr];
        }
#pragma unroll
        for (int m = 0; m < 4; ++m) wf[m] = *(const bf16x8*)(W + (long)(th * 64 + m * 16 + fr) * 128 + ks * 32 + fq * 8);
#pragma unroll
        for (int m = 0; m < 4; ++m)
#pragma unroll
          for (int n = 0; n < 4; ++n) acc[m][n] = __builtin_amdgcn_mfma_f32_16x16x32_bf16(vf[n], wf[m], acc[m][n], 0, 0, 0);
      }
#pragma unroll
      for (int m = 0; m < 4; ++m) {
        const int t = th * 64 + m * 16 + fr;
        const float bt = bs[t];
#pragma unroll
        for (int n = 0; n < 4; ++n) {
          const int c = g * 64 + n * 16 + fq * 4;
          const u32x2 ur = *(const u32x2*)(p.h + (T0 + t) * HC + 1024 + c);
          const f32x4 sv = acc[m][n] + bt;
          u32x2 w; w[0] = pk2(bflo(ur[0]) * sv[0], bfhi(ur[0]) * sv[1]); w[1] = pk2(bflo(ur[1]) * sv[2], bfhi(ur[1]) * sv[3]);
          *(u32x2*)(p.y + (T0 + t) * DM + 768 + c) = w;
        }
      }
    }
  }
  HBAR();
}

constexpr int FRS = 72, FPL = 64 * FRS, FCH = 2 * FPL + 64;
NI void fft_item(int l, int id, LAS3 unsigned* cnt, unsigned& target) {
  KPARAMS;
  const int tidf = otid(), half = __builtin_amdgcn_readfirstlane(tidf >> 8), tid = tidf & 255, lane = tid & 63, wid = __builtin_amdgcn_readfirstlane(tid >> 6);
  const int fr = lane & 15, fq = lane >> 4;
  bf16_t* smem = SMEM + half * HALF_E;
  const int b = id >> 7, ch0 = (id & 127) * 2;
  bf16_t* Ct = smem + 2 * FCH;
  unsigned* TWl = (unsigned*)(Ct + 2 * FPL);
  {
    u32x4 zv[8], cv[4], tv[4];
#pragma unroll
    for (int i = 0; i < 8; ++i) {
      const int chunk = tid + 256 * i, c = chunk >> 10, rem = chunk & 1023, ri = rem >> 9, s8 = rem & 511;
      zv[i] = *(const u32x4*)(p.PQt + ((long)(b * 256 + ch0 + c)) * 8192 + ri * 4096 + s8 * 8);
    }
#pragma unroll
    for (int i = 0; i < 4; ++i) {
      const int chunk = tid + 256 * i, tb = chunk >> 9, row = (chunk >> 3) & 63, c8 = chunk & 7;
      cv[i] = *(const u32x4*)(p.M1 + (tb * 64 + row) * 128 + c8 * 8);
      tv[i] = *(const u32x4*)((const unsigned*)p.TW + chunk * 4);
    }
#pragma unroll
    for (int i = 0; i < 8; ++i) {
      const int chunk = tid + 256 * i, c = chunk >> 10, rem = chunk & 1023, ri = rem >> 9, s8 = rem & 511;
      *(u32x4*)(smem + c * FCH + ri * FPL + (s8 >> 3) * FRS + (s8 & 7) * 8) = zv[i];
    }
#pragma unroll
    for (int i = 0; i < 4; ++i) {
      const int chunk = tid + 256 * i, tb = chunk >> 9, row = (chunk >> 3) & 63, c8 = chunk & 7;
      *(u32x4*)(Ct + tb * FPL + row * FRS + c8 * 8) = cv[i];
      *(u32x4*)(TWl + (chunk >> 4) * 68 + (chunk & 15) * 4) = tv[i];
    }
  }
  HBAR();
  {
    const int c = wid >> 1;
    bf16x8 zf[2][4];
#pragma unroll
    for (int nt = 0; nt < 2; ++nt)
#pragma unroll
      for (int ks = 0; ks < 4; ++ks) {
        const bf16_t* src = smem + c * FCH + (ks >> 1) * FPL + ((ks & 1) * 32 + fq * 8) * FRS + (wid & 1) * 32 + nt * 16 + fr;
#pragma unroll
        for (int j = 0; j < 8; ++j) zf[nt][ks][j] = (short)src[j * FRS];
      }
    f32x4 acc[2][8];
#pragma unroll
    for (int nt = 0; nt < 2; ++nt)
#pragma unroll
      for (int mt = 0; mt < 8; ++mt) acc[nt][mt] = (f32x4){0.f, 0.f, 0.f, 0.f};
#pragma unroll
    for (int mt = 0; mt < 8; ++mt)
#pragma unroll
      for (int ks = 0; ks < 4; ++ks) {
        u32x4 mw = *(const u32x4*)(Ct + (((mt >> 2) == (ks >> 1)) ? 0 : FPL) + ((mt & 3) * 16 + fr) * FRS + (ks & 1) * 32 + fq * 8);
        if ((mt >> 2) == 0 && (ks >> 1) == 1) mw = mw ^ 0x80008000u;
        const bf16x8 mf = __builtin_bit_cast(bf16x8, mw);
#pragma unroll
        for (int nt = 0; nt < 2; ++nt) acc[nt][mt] = __builtin_amdgcn_mfma_f32_16x16x32_bf16(zf[nt][ks], mf, acc[nt][mt], 0, 0, 0);
      }
#pragma unroll
    for (int nt = 0; nt < 2; ++nt)
#pragma unroll
      for (int m4 = 0; m4 < 4; ++m4) {
        const int k1 = m4 * 16 + fr, s2 = (wid & 1) * 32 + nt * 16 + fq * 4;
        const u32x4 tw = *(const u32x4*)(TWl + k1 * 68 + s2);
        const f32x4 yr = acc[nt][m4], yi = acc[nt][m4 + 4];
        const float cs[4] = {bflo(tw[0]), bflo(tw[1]), bflo(tw[2]), bflo(tw[3])}, sn[4] = {bfhi(tw[0]), bfhi(tw[1]), bfhi(tw[2]), bfhi(tw[3])};
        float tr[4], ti[4];
#pragma unroll
        for (int j = 0; j < 4; ++j) { tr[j] = yr[j] * cs[j] - yi[j] * sn[j]; ti[j] = yr[j] * sn[j] + yi[j] * cs[j]; }
        u32x2 wr_, wi_; wr_[0] = pk2(tr[0], tr[1]); wr_[1] = pk2(tr[2], tr[3]); wi_[0] = pk2(ti[0], ti[1]); wi_[1] = pk2(ti[2], ti[3]);
        *(u32x2*)(smem + c * FCH + k1 * FRS + s2) = wr_;
        *(u32x2*)(smem + c * FCH + FPL + k1 * FRS + s2) = wi_;
      }
  }
  HBAR();
  {
    f32x4 acc[2][4];
#pragma unroll
    for (int t = 0; t < 2; ++t)
#pragma unroll
      for (int mt = 0; mt < 4; ++mt) acc[t][mt] = (f32x4){0.f, 0.f, 0.f, 0.f};
#pragma unroll
    for (int ks = 0; ks < 4; ++ks) {
      bf16x8 tf[2];
#pragma unroll
      for (int t = 0; t < 2; ++t) {
        const int k1 = (wid * 2 + t) * 8 + (fr >> 1), c = fr & 1;
        tf[t] = *(const bf16x8*)(smem + c * FCH + (ks >> 1) * FPL + k1 * FRS + (ks & 1) * 32 + fq * 8);
      }
#pragma unroll
      for (int mt = 0; mt < 4; ++mt) {
        u32x4 mw = *(const u32x4*)(Ct + ((ks >> 1) ? FPL : 0) + (mt * 16 + fr) * FRS + (ks & 1) * 32 + fq * 8);
        if (ks >> 1) mw = mw ^ 0x80008000u;
        const bf16x8 mf = __builtin_bit_cast(bf16x8, mw);
#pragma unroll
        for (int t = 0; t < 2; ++t) acc[t][mt] = __builtin_amdgcn_mfma_f32_16x16x32_bf16(tf[t], mf, acc[t][mt], 0, 0, 0);
      }
    }
    const float b0 = p.fnet_b[l * 256 + ch0], b1 = p.fnet_b[l * 256 + ch0 + 1];
#pragma unroll
    for (int t = 0; t < 2; ++t)
#pragma unroll
      for (int mt = 0; mt < 4; ++mt)
#pragma unroll
        for (int jj = 0; jj < 2; ++jj) {
          const int k1 = (wid * 2 + t) * 8 + 2 * fq + jj, k2 = mt * 16 + fr;
          *(unsigned*)(p.y + ((long)(b * SEQ + k1 + 64 * k2)) * DM + 512 + ch0) = pk2(acc[t][mt][2 * jj] + b0, acc[t][mt][2 * jj + 1] + b1);
        }
  }
  HBAR();
}

NI void mixer_phase(int l, int rep) {
  KPARAMS;
  constexpr int NA = 1024, NF = 1024, NC = 512, ND = 256;
  const int tidf = otid(), half = __builtin_amdgcn_readfirstlane(tidf >> 8), tid = tidf & 255, lane = tid & 63;
  LAS3 unsigned* ctl = (LAS3 unsigned*)(LDSP + 2 * HALF_B);
  LAS3 unsigned* cnt = ctl + 8 + 4 * half;
  LAS3 unsigned* nx = ctl + 16 + 4 * half;
  if (tid == 0) *cnt = 0u;
  __syncthreads();
  unsigned target = 0u;
  for (int it = 0;; ++it) {
    if (tid == 0) nx[it & 1] = (unsigned)atomicAdd(p.ctr + l + 4 * rep, 1);
    HBAR();
    const int id = __builtin_amdgcn_readfirstlane((int)nx[it & 1]);
    if (id >= NA + NF + NC + ND) break;
    if (id < NA) attn_tile(l, id, cnt, target);
    else if (id < NA + NC) conv_tile(l, id - NA, cnt, target);
    else if (id < NA + NC + ND) sgu_tile(l, id - NA - NC, cnt, target);
    else fft_item(l, id - NA - NC - ND, cnt, target);
  }
}

#define LAS __attribute__((address_space(3)))
#define XB_TMO      128
#define XB_XCNT(j)  (256  + 64 * (j))
#define XB_XSUB(j)  (1280 + 64 * (j))
#define XB_XGEN(j)  (2304 + 64 * (j))
#define XB_TOP      3328
#define XB_TOPGEN   3392
#define XCD_BAR_WORDS 3456
#define XB_SPIN_CAP (1u << 18)

__device__ __forceinline__ unsigned xb_ld(unsigned* p)              { return __hip_atomic_load(p, __ATOMIC_RELAXED, __HIP_MEMORY_SCOPE_AGENT); }
__device__ __forceinline__ unsigned xb_add(unsigned* p, unsigned v) { return __hip_atomic_fetch_add(p, v, __ATOMIC_RELAXED, __HIP_MEMORY_SCOPE_AGENT); }
__device__ __forceinline__ unsigned xb_xcc_id() { return (unsigned)__builtin_amdgcn_s_getreg((3 << 11) | 20) & 0xFu; }
#define XB_SPIN(cond, bar) do { unsigned _sp = 0; while (cond) { __builtin_amdgcn_s_sleep(1); \
    if ((++_sp & 255u) == 0u) { if (xb_ld(&(bar)[XB_TMO])) break; if (_sp > XB_SPIN_CAP) { atomicAdd(&(bar)[XB_TMO], 1u); break; } } } } while (0)

struct XcdBarrier {
    unsigned* bar; unsigned x;
    volatile LAS unsigned* st;
};

__device__ __forceinline__ XcdBarrier xcd_barrier_post(unsigned* bar, volatile LAS unsigned* st) {
    XcdBarrier b; b.bar = bar; b.x = xb_xcc_id(); b.st = st;
    if (threadIdx.x == 0) (void)xb_add(&bar[XB_XCNT(b.x)], 1u);
    return b;
}
__device__ __forceinline__ void xcd_barrier_complete(unsigned* bar, unsigned x, unsigned& nloc, unsigned& nx) {
    const unsigned G = gridDim.x * gridDim.y * gridDim.z;
    unsigned sum, cnt, mine, sp = 0u;
    for (;;) {
        sum = 0u; cnt = 0u; mine = 0u;
#pragma unroll
        for (unsigned j = 0; j < 16; ++j) { const unsigned c = xb_ld(&bar[XB_XCNT(j)]); sum += c; cnt += (c > 0u) ? 1u : 0u; mine = (j == x) ? c : mine; }
        if (sum == G) break;
        __builtin_amdgcn_s_sleep(1);
        if ((++sp & 255u) == 0u) { if (xb_ld(&bar[XB_TMO])) break; if (sp > XB_SPIN_CAP) { atomicAdd(&bar[XB_TMO], 1u); break; } }
    }
    nloc = mine > 0u ? mine : 1u; nx = cnt > 0u ? cnt : 1u;
}

__device__ __forceinline__ void xcd_barrier(const XcdBarrier& b) {
    asm volatile("s_waitcnt vmcnt(0)" ::: "memory");
    __syncthreads();
    if (threadIdx.x == 0) {
        unsigned* bar = b.bar;
        __builtin_amdgcn_s_waitcnt(0);
        unsigned nloc = b.st[0], nx = b.st[1];
        if (nloc == 0u) { xcd_barrier_complete(bar, b.x, nloc, nx); b.st[0] = nloc; b.st[1] = nx; }
        const unsigned old = xb_add(&bar[XB_XSUB(b.x)], 1u);
        const unsigned gen = old / nloc;
        if (old + 1u == (gen + 1u) * nloc) {
            __builtin_amdgcn_fence(__ATOMIC_RELEASE, "agent");
            asm volatile("s_waitcnt vmcnt(0)" ::: "memory");
            const unsigned og = xb_add(&bar[XB_TOP], 1u);
            const unsigned tg = og / nx;
            if (og + 1u == (tg + 1u) * nx) xb_add(&bar[XB_TOPGEN], 1u);
            else XB_SPIN(xb_ld(&bar[XB_TOPGEN]) == tg, bar);
            __builtin_amdgcn_fence(__ATOMIC_ACQUIRE, "agent");
            xb_add(&bar[XB_XGEN(b.x)], 1u);
            asm volatile("s_waitcnt vmcnt(0)" ::: "memory");
        } else {
            XB_SPIN(xb_ld(&bar[XB_XGEN(b.x)]) == gen, bar);
            __builtin_amdgcn_fence(__ATOMIC_ACQUIRE, "agent");
            asm volatile("s_waitcnt vmcnt(0)" ::: "memory");
        }
    }
    __syncthreads();
}

constexpr int NPHASE = 2 + 5 * DEPTH;
__global__ void __launch_bounds__(512, 2) mk_fwd(Params p, int ph_lo, int ph_hi, int coop) {
  int rep = 0;
  volatile LAS unsigned* bst = (volatile LAS unsigned*)(LDSP + 2 * HALF_B + 16);
  if (otid() < 2) bst[otid()] = 0u;
  __syncthreads();
  XcdBarrier xbar = xcd_barrier_post(p.barw, bst);
  for (int ph = ph_lo; ph < ph_hi; ++ph) {
    if (ph == 0) {
      prep_phase();
      if (REP_PREP) { __syncthreads(); prep_phase(); }
    } else if (ph == NPHASE - 1) {
      final_rms_phase(p.xn, p.final_g, p.out);
    } else {
      const int l = (ph - 1) / 5, s = (ph - 1) % 5;
      if (s == 0) gemm_in_phase(l);
      else if (s == 1) mixer_phase(l, rep);
      else if (s == 2) gemm_out_phase(l, (REP_S == 2 && rep == 0) ? 0.f : 1.f);
      else if (s == 3) gemm_up_phase(l);
      else gemm_down_phase(l, (REP_S == 4 && rep == 0) ? 0.f : 1.f);
    }
    if (coop && ph + 1 < ph_hi) { if (ph == 0) cg::this_grid().sync(); else xcd_barrier(xbar); }
    if (coop && ph == 1) for (int i = 0; i < EXTRA_SYNCS; ++i) xcd_barrier(xbar);
    if (REP_S >= 0 && rep == 0 && ph >= 1 && ph < NPHASE - 1 && ((ph - 1) % 5) == REP_S) { rep = 1; --ph; } else rep = 0;
  }
}

extern "C" void kernel_launch(void* const* d_in, const int* in_sizes, int n_in, void* d_out, int out_size, void* d_ws, size_t ws_size, hipStream_t stream) {
  Params p{};
  const float** pf = (const float**)&p;
  for (int i = 0; i < 25; ++i) pf[i] = (const float*)d_in[i];
  p.out = (float*)d_out;
  unsigned char* w = (unsigned char*)d_ws;
  size_t off = 0;
  auto take = [&](size_t bytes) { unsigned char* r = w + off; off += (bytes + 255) & ~(size_t)255; return r; };
  p.WallT = (bf16_t*)take((size_t)DEPTH * WALL_N * DM * 2);
  p.WoutT = (bf16_t*)take((size_t)DEPTH * DM * DM * 2);
  p.WupT = (bf16_t*)take((size_t)DEPTH * DFF * DM * 2);
  p.WdownT = (bf16_t*)take((size_t)DEPTH * DFF * DM * 2);
  p.pwT = (bf16_t*)take((size_t)DEPTH * 65536 * 2);
  p.sguW = (bf16_t*)take((size_t)DEPTH * 4 * 16384 * 2);
  p.lam = (float*)take(256);
  unsigned char* ctl = take(16384);
  p.ctr = (int*)ctl;
  p.barw = (unsigned*)(ctl + 256);
  p.M1 = (bf16_t*)take(128 * 128 * 2);
  p.M3 = (bf16_t*)take(64 * 128 * 2);
  p.TW = (float*)take(4096 * 2 * 4);
  p.part = (float*)take((size_t)NTOK * 16 * 4);
  p.xn = (bf16_t*)take((size_t)NTOK * DM * 2);
  unsigned char* region = take((size_t)NTOK * DFF * 2);
  p.hid = (bf16_t*)region;
  p.h = (bf16_t*)region;
  p.Vt = (bf16_t*)(region + (size_t)NTOK * HC * 2);
  p.PQt = (bf16_t*)(region + (size_t)NTOK * HC * 2 + (size_t)NTOK * 256 * 2);
  p.y = (bf16_t*)(region + (size_t)NTOK * HC * 2 + (size_t)NTOK * 256 * 2 + (size_t)BATCH * 256 * 8192 * 2);
  if (off > ws_size) { fprintf(stderr, "workspace too small: need %zu have %zu\n", off, ws_size); return; }

  static int grid_blocks = 0;
  if (!grid_blocks) {
    int dev = 0, cus = 0, per_cu = 0;
    hipGetDevice(&dev);
    hipDeviceGetAttribute(&cus, hipDeviceAttributeMultiprocessorCount, dev);
    hipOccupancyMaxActiveBlocksPerMultiprocessor(&per_cu, mk_fwd, 512, 0);
    if (per_cu < 1) per_cu = 1;
    grid_blocks = cus * per_cu;
  }
  hipMemsetAsync(ctl, 0, 16384, stream);
#if MK_ONE_LAUNCH
  int lo = 0, hi = NPHASE, coop = 1;
  void* args[] = {&p, &lo, &hi, &coop};
  hipError_t e = hipLaunchCooperativeKernel((void*)mk_fwd, dim3(grid_blocks), dim3(512), args, 0, stream);
  if (e != hipSuccess) fprintf(stderr, "cooperative launch failed: %s (grid %d)\n", hipGetErrorString(e), grid_blocks);
#else
  for (int ph = 0; ph < NPHASE; ++ph) mk_fwd<<<grid_blocks, 512, 0, stream>>>(p, ph, ph + 1, 0);
#endif
}
```

```cpp
#include <hip/hip_runtime.h>
#include <hip/hip_cooperative_groups.h>
#include <cstdint>
#include <cstdio>
#include <cmath>
namespace cg = cooperative_groups;

#ifndef EXTRA_SYNCS
#define EXTRA_SYNCS 0
#endif
#ifndef REP_PREP
#define REP_PREP 0
#endif
#ifndef REP_S
#define REP_S -1
#endif
#ifndef MK_ONE_LAUNCH
#define MK_ONE_LAUNCH 1
#endif

#define DI __device__ __forceinline__
typedef unsigned short bf16_t;
typedef short bf16x8 __attribute__((ext_vector_type(8)));
typedef float f32x4 __attribute__((ext_vector_type(4)));
typedef float f32x16 __attribute__((ext_vector_type(16)));
typedef float f32x2 __attribute__((ext_vector_type(2)));
typedef __bf16 bf16x2v __attribute__((ext_vector_type(2)));
typedef unsigned u32x4 __attribute__((ext_vector_type(4)));
typedef unsigned u32x2 __attribute__((ext_vector_type(2)));

constexpr int BATCH = 8, SEQ = 4096, DM = 1024, DEPTH = 4, NTOK = BATCH * SEQ;
constexpr int HC = 1536;
constexpr int WALL_N = 2304;
constexpr int DFF = 4096;
constexpr float EPS = 1e-6f;
constexpr float LOG2E = 1.4426950408889634f;

DI unsigned pk2(float lo, float hi) { f32x2 v = {lo, hi}; bf16x2v b = __builtin_convertvector(v, bf16x2v); return __builtin_bit_cast(unsigned, b); }
DI float bflo(unsigned u) { return __uint_as_float(u << 16); }
DI float bfhi(unsigned u) { return __uint_as_float(u & 0xffff0000u); }
DI float bf2f(bf16_t u) { return __uint_as_float(((unsigned)u) << 16); }
template <int CTRL> DI float dppf(float v) { return __builtin_bit_cast(float, __builtin_amdgcn_update_dpp(0, __builtin_bit_cast(int, v), CTRL, 0xf, 0xf, true)); }
DI float xch32(float v, int x32) { return __builtin_bit_cast(float, __builtin_amdgcn_ds_bpermute(x32, __builtin_bit_cast(int, v))); }
DI float wave_sum(float v, int x32) {
  v += dppf<0xB1>(v); v += dppf<0x4E>(v); v += dppf<0x141>(v); v += dppf<0x140>(v);
  v += __builtin_bit_cast(float, __builtin_amdgcn_ds_swizzle(__builtin_bit_cast(int, v), 0x401f));
  v += xch32(v, x32);
  return v;
}

#define LAS3 __attribute__((address_space(3)))
DI void half_bar(LAS3 unsigned* cnt, unsigned& target, int lane) {
  asm volatile("s_waitcnt lgkmcnt(0)" ::: "memory");
  target += 4u;
  if (lane == 0) __hip_atomic_fetch_add(cnt, 1u, __ATOMIC_RELAXED, __HIP_MEMORY_SCOPE_WORKGROUP);
  while (__hip_atomic_load(cnt, __ATOMIC_RELAXED, __HIP_MEMORY_SCOPE_WORKGROUP) < target) __builtin_amdgcn_s_sleep(1);
  asm volatile("" ::: "memory");
}
#define HBAR() half_bar(cnt, target, lane)

struct Params {
  const float *x, *norm1_g, *w_in, *lam_q1, *lam_k1, *lam_q2, *lam_k2, *subln_g, *conv_dw_w, *conv_dw_b, *conv_ln_g, *conv_ln_b,
      *conv_pw_w, *conv_pw_b, *fnet_w, *fnet_b, *sgu_ln_g, *sgu_ln_b, *sgu_w, *sgu_b, *w_out, *norm2_g, *w_up, *w_down, *final_g;
  float* out;
  bf16_t *WallT, *WoutT, *WupT, *WdownT, *pwT, *sguW, *M1, *M3, *xn, *h, *Vt, *PQt, *y, *hid;
  float* lam;
  float* TW;
  float* part;
  int* ctr;
  unsigned* barw;
};

constexpr int HALF_B = 72960;
constexpr int SMEM_BYTES = 2 * HALF_B + 256;
constexpr int HALF_E = HALF_B / 2;
__shared__ __attribute__((aligned(16))) unsigned char smem_raw[SMEM_BYTES];
#define SMEM ((bf16_t*)smem_raw)
#define NI __device__ __forceinline__
DI int otid() { int t = threadIdx.x; asm volatile("" : "+v"(t)); return t; }
#define KPARAMS const Params& p = *(const Params*)__builtin_amdgcn_kernarg_segment_ptr()

namespace pg8 {
#define PG8_LAS __attribute__((address_space(3)))
typedef unsigned short bf16_t;
typedef short bf16x8 __attribute__((ext_vector_type(8)));
typedef float f32x4 __attribute__((ext_vector_type(4)));
typedef unsigned u32x4 __attribute__((ext_vector_type(4)));
constexpr int BM = 256, BK = 64, HALF = 128, HTB = HALF * BK * 2  , STAGE_BYTES = 8 * HTB, NXCD = 8, WGM = 8;

__host__ __device__ __forceinline__ int lds_byte(int r, int c) { const int st = (r >> 4) * 2 + (c >> 5), rr = r & 15, cc = c & 31, ob = rr * 64 + cc * 2; return st * 1024 + (ob ^ (((ob >> 9) & 1) << 5)); }
__host__ __device__ __forceinline__ void stage_rc(int b, int& R, int& C) { const int st = b / 1024, sb = b % 1024, swz = sb ^ (((sb >> 9) & 1) << 5); R = (st >> 1) * 16 + swz / 64; C = (st & 1) * 32 + (swz % 64) / 2; }
__host__ __device__ __forceinline__ int perm32(int rho) { const int n = rho >> 4, i = rho & 15; return 8 * (i >> 2) + 4 * n + (i & 3); }

struct Unit { int pm, pn; };
struct Gemm { const bf16_t* A; const bf16_t* Bt; int M, N, K; };

struct StaticOrder {
    int nM, nN, nwg, G, c;
    __host__ __device__ void init(int M, int N, int G_, int c_) { nM = M / BM; nN = N / BM; nwg = nM * nN; G = G_; c = c_; }
    __host__ __device__ bool next(int i, Unit& u) const {
        const long L = (long)i * G + c; if (L >= nwg) return false;
        int wgid = (int)L; { const int q = nwg / NXCD, r = nwg % NXCD, xcd = wgid % NXCD, off = wgid / NXCD; wgid = (xcd < r ? xcd * (q + 1) : r * (q + 1) + (xcd - r) * q) + off; }
        const int nig = WGM * nN, gid = wgid / nig, fm = gid * WGM, gsz = (nM - fm) < WGM ? (nM - fm) : WGM;
        u.pm = fm + ((wgid % nig) % gsz); u.pn = (wgid % nig) / gsz; return true;
    }
    __device__ __forceinline__ void a_ready(const Unit&) const {}
    __device__ __forceinline__ void done(const Unit&) const {}
};
template <class Epi, class Sched, bool ALIGN_EPI = false, bool SP2 = false>
__device__ __forceinline__ void gemm_phase(PG8_LAS unsigned char* lds, const Gemm g, const Sched& S, const Epi& E) {
    const int tid = otid(), wid = __builtin_amdgcn_readfirstlane(tid >> 6), lane = tid & 63, wr = wid >> 2, wc = wid & 3, fr = lane & 15, fq = lane >> 4;
    const int K = g.K, nt = K / BK;
    unsigned voffA[2], voffB[2];
#pragma unroll
    for (int i = 0; i < 2; ++i) { int R, C; stage_rc(tid * 16 + i * 8192, R, C); const int Rb = Epi::PERM ? ((R & ~31) + perm32(R & 31)) : R;
        voffA[i] = (unsigned)(R * K + C) * 2u; voffB[i] = (unsigned)(Rb * K + C) * 2u; }
    const size_t kstep = (size_t)(BK * 2);
    const size_t hstep = (size_t)HALF * K * 2;
    const size_t tstep = 2 * hstep;
    const unsigned ldsw = (unsigned)wid * 1024u;
    const int aoff = lds_byte(wr * 64 + fr, fq * 8), boff = lds_byte(wc * 32 + fr, fq * 8);
#define PG8_SA(b, h) (((b) * 2 + (h)) * HTB)
#define PG8_SB(b, h) ((4 + (b) * 2 + (h)) * HTB)
#define PG8_STAGE(bufoff, gbase, voff) do { _Pragma("unroll") for (int _i = 0; _i < 2; ++_i) \
        __builtin_amdgcn_global_load_lds((const unsigned*)((const char*)(gbase) + (voff)[_i]), (PG8_LAS unsigned*)(lds + (bufoff) + ldsw + _i * 8192), 16, 0, 0); } while (0)
#define PG8_LDA(dst, b, h) do { _Pragma("unroll") for (int m = 0; m < 4; ++m) _Pragma("unroll") for (int k = 0; k < 2; ++k) dst[m][k] = *(const PG8_LAS bf16x8*)(lds + PG8_SA(b, h) + aoff + m * 2048 + k * 1024); } while (0)
#define PG8_LDB(dst, b, h) do { _Pragma("unroll") for (int n = 0; n < 2; ++n) _Pragma("unroll") for (int k = 0; k < 2; ++k) dst[n][k] = *(const PG8_LAS bf16x8*)(lds + PG8_SB(b, h) + boff + n * 2048 + k * 1024); } while (0)
#define PG8_MMA(ai, bj, At, Bt) do { __builtin_amdgcn_s_setprio(1); _Pragma("unroll") for (int m = 0; m < 4; ++m) _Pragma("unroll") for (int n = 0; n < 2; ++n) _Pragma("unroll") for (int k = 0; k < 2; ++k) \
        acc[ai][bj][m][n] = __builtin_amdgcn_mfma_f32_16x16x32_bf16(Bt[n][k], At[m][k], acc[ai][bj][m][n], 0, 0, 0); __builtin_amdgcn_s_setprio(0); } while (0)
#define PG8_WAIT_V(n) asm volatile("s_waitcnt vmcnt(" #n ")" ::: "memory")
#define PG8_WAIT_L(n) asm volatile("s_waitcnt lgkmcnt(" #n ")" ::: "memory")
#define PG8_BAR __builtin_amdgcn_s_barrier()
#define PG8_SCHED __builtin_amdgcn_sched_barrier(0)
    Unit cur, nxt; int ui = 0;
    if (!S.next(0, cur)) return;
    f32x4 acc[2][2][4][2];
#pragma unroll
    for (int a = 0; a < 2; ++a)
#pragma unroll
        for (int b = 0; b < 2; ++b)
#pragma unroll
            for (int m = 0; m < 4; ++m)
#pragma unroll
                for (int n = 0; n < 2; ++n) acc[a][b][m][n] = (f32x4){0.f, 0.f, 0.f, 0.f};
    bf16x8 At[4][2], B0[2][2], B1[2][2];
    const char* cA = (const char*)g.A + (size_t)cur.pm * tstep; const char* cB = (const char*)g.Bt + (size_t)cur.pn * tstep;
    S.a_ready(cur);
    if constexpr (SP2) {
        PG8_STAGE(PG8_SB(0, 0), cB, voffB); PG8_STAGE(PG8_SB(0, 1), cB + hstep, voffB); PG8_STAGE(PG8_SA(0, 0), cA, voffA); PG8_STAGE(PG8_SA(0, 1), cA + hstep, voffA);
        if (wr == 1) PG8_BAR;
        PG8_WAIT_V(2); PG8_BAR;
        PG8_STAGE(PG8_SB(1, 0), cB + kstep, voffB); PG8_STAGE(PG8_SA(1, 0), cA + kstep, voffA); PG8_STAGE(PG8_SB(1, 1), cB + hstep + kstep, voffB);
        PG8_WAIT_V(6); PG8_BAR;
    } else {
        PG8_STAGE(PG8_SB(0, 0), cB, voffB); PG8_STAGE(PG8_SA(0, 0), cA, voffA); PG8_STAGE(PG8_SB(0, 1), cB + hstep, voffB); PG8_STAGE(PG8_SA(0, 1), cA + hstep, voffA);
        if (wr == 1) PG8_BAR;
        PG8_WAIT_V(4); PG8_BAR;
        PG8_STAGE(PG8_SB(1, 0), cB + kstep, voffB); PG8_STAGE(PG8_SA(1, 0), cA + kstep, voffA); PG8_STAGE(PG8_SB(1, 1), cB + hstep + kstep, voffB);
        PG8_WAIT_V(6); PG8_BAR;
    }
    for (;;) {
        const bool has_next = S.next(ui + 1, nxt);
        const char* nA = has_next ? (const char*)g.A + (size_t)nxt.pm * tstep : cA; const char* nB = has_next ? (const char*)g.Bt + (size_t)nxt.pn * tstep : cB;
        for (int t = 0; t < nt; t += 2) {
            const bool last = (t == nt - 2);
            const char* a1 = cA + (size_t)(t + 1) * kstep;
            const char* a2 = last ? nA : cA + (size_t)(t + 2) * kstep; const char* b2 = last ? nB : cB + (size_t)(t + 2) * kstep;
            const char* a3 = a2 + kstep; const char* b3 = b2 + kstep;
            if (last && has_next) S.a_ready(nxt);
            if constexpr (SP2) {
            PG8_LDB(B0, 0, 0); PG8_LDB(B1, 0, 1); PG8_SCHED; PG8_LDA(At, 0, 0); PG8_STAGE(PG8_SA(1, 1), a1 + hstep, voffA);
            PG8_WAIT_V(8); PG8_WAIT_L(0); PG8_BAR; PG8_MMA(0, 0, At, B0); PG8_MMA(0, 1, At, B1); PG8_BAR; PG8_SCHED;
            PG8_LDA(At, 0, 1); PG8_STAGE(PG8_SB(0, 0), b2, voffB); PG8_STAGE(PG8_SB(0, 1), b2 + hstep, voffB); PG8_STAGE(PG8_SA(0, 0), a2, voffA);
            PG8_WAIT_V(8); PG8_WAIT_L(0); PG8_BAR; PG8_MMA(1, 0, At, B0); PG8_MMA(1, 1, At, B1); PG8_BAR; PG8_SCHED;
            PG8_LDB(B0, 1, 0); PG8_LDB(B1, 1, 1); PG8_SCHED; PG8_LDA(At, 1, 0); PG8_STAGE(PG8_SA(0, 1), a2 + hstep, voffA);
            PG8_WAIT_V(8); PG8_WAIT_L(0); PG8_BAR; PG8_MMA(0, 0, At, B0); PG8_MMA(0, 1, At, B1); PG8_BAR; PG8_SCHED;
            PG8_LDA(At, 1, 1); PG8_STAGE(PG8_SB(1, 0), b3, voffB); PG8_STAGE(PG8_SB(1, 1), b3 + hstep, voffB); PG8_STAGE(PG8_SA(1, 0), a3, voffA);
            PG8_WAIT_V(8); PG8_WAIT_L(0); PG8_BAR; PG8_MMA(1, 0, At, B0); PG8_MMA(1, 1, At, B1); PG8_BAR; PG8_SCHED;
            } else {
            PG8_LDB(B0, 0, 0); PG8_SCHED; PG8_LDA(At, 0, 0); PG8_STAGE(PG8_SA(1, 1), a1 + hstep, voffA);
            PG8_WAIT_L(8); PG8_BAR; PG8_WAIT_L(0); PG8_MMA(0, 0, At, B0); PG8_BAR; PG8_SCHED;
            PG8_LDB(B1, 0, 1); PG8_STAGE(PG8_SB(0, 0), b2, voffB);
            PG8_BAR; PG8_WAIT_L(0); PG8_MMA(0, 1, At, B1); PG8_BAR;
            PG8_LDA(At, 0, 1); PG8_STAGE(PG8_SA(0, 0), a2, voffA);
            PG8_BAR; PG8_WAIT_L(0); PG8_MMA(1, 0, At, B0); PG8_BAR; PG8_SCHED;
            PG8_STAGE(PG8_SB(0, 1), b2 + hstep, voffB);
            PG8_WAIT_V(6); PG8_BAR; PG8_MMA(1, 1, At, B1); PG8_BAR;
            PG8_LDB(B0, 1, 0); PG8_SCHED; PG8_LDA(At, 1, 0); PG8_STAGE(PG8_SA(0, 1), a2 + hstep, voffA);
            PG8_WAIT_L(8); PG8_BAR; PG8_WAIT_L(0); PG8_MMA(0, 0, At, B0); PG8_BAR; PG8_SCHED;
            PG8_LDB(B1, 1, 1); PG8_STAGE(PG8_SB(1, 0), b3, voffB);
            PG8_BAR; PG8_WAIT_L(0); PG8_MMA(0, 1, At, B1); PG8_BAR;
            PG8_LDA(At, 1, 1); PG8_STAGE(PG8_SA(1, 0), a3, voffA);
            PG8_BAR; PG8_WAIT_L(0); PG8_MMA(1, 0, At, B0); PG8_BAR; PG8_SCHED;
            PG8_STAGE(PG8_SB(1, 1), b3 + hstep, voffB);
            PG8_WAIT_V(6); PG8_BAR; PG8_MMA(1, 1, At, B1); PG8_BAR;
            }
        }
        if constexpr (ALIGN_EPI) { if (wr == 0) PG8_BAR; }
        if constexpr (!Epi::AFTER_DRAIN) { E(acc, cur, wr, wc, fr, fq); S.done(cur); }
        if (!has_next) break;
#pragma unroll
        for (int a = 0; a < 2; ++a)
#pragma unroll
            for (int b = 0; b < 2; ++b)
#pragma unroll
                for (int m = 0; m < 4; ++m)
#pragma unroll
                    for (int n = 0; n < 2; ++n) acc[a][b][m][n] = (f32x4){0.f, 0.f, 0.f, 0.f};
        cur = nxt; cA = nA; cB = nB; ++ui;
        if constexpr (ALIGN_EPI) { if (wr == 1) PG8_BAR; }
    }
    PG8_WAIT_V(0);
    if constexpr (!ALIGN_EPI) { if (wr == 0) PG8_BAR; }
    PG8_BAR;
    if constexpr (Epi::AFTER_DRAIN) { E.fused(acc, cur, wr, wc, fr, fq, lds, wid, lane); S.done(cur); }
#undef PG8_SA
#undef PG8_SB
#undef PG8_STAGE
#undef PG8_LDA
#undef PG8_LDB
#undef PG8_MMA
#undef PG8_WAIT_V
#undef PG8_WAIT_L
#undef PG8_BAR
#undef PG8_SCHED
}
}

template <class F> struct Epi8 {
  static constexpr bool PERM = true, AFTER_DRAIN = false;
  F f;
  DI void operator()(const pg8::f32x4 (&acc)[2][2][4][2], const pg8::Unit& u, int wr, int wc, int fr, int fq) const {
#pragma unroll
    for (int ai = 0; ai < 2; ++ai)
#pragma unroll
      for (int m = 0; m < 4; ++m) {
        const int row = u.pm * 256 + ai * 128 + wr * 64 + m * 16 + fr;
#pragma unroll
        for (int bj = 0; bj < 2; ++bj) f.st(row, u.pn * 256 + bj * 128 + wc * 32 + 8 * fq, acc[ai][bj][m][0], acc[ai][bj][m][1]);
      }
  }
};
#define LDSP ((__attribute__((address_space(3))) unsigned char*)smem_raw)
DI float row_rs(const float* __restrict__ part, int row) {
  const f32x4 a = *(const f32x4*)(part + (long)row * 16), b = *(const f32x4*)(part + (long)row * 16 + 4), c = *(const f32x4*)(part + (long)row * 16 + 8), d = *(const f32x4*)(part + (long)row * 16 + 12);
  const f32x4 s = (a + b) + (c + d);
  return rsqrtf(((s[0] + s[1]) + (s[2] + s[3])) * (1.f / 1024.f) + EPS);
}
template <class F> struct Epi8Rows {
  static constexpr bool PERM = true, AFTER_DRAIN = false;
  F f; const float* part;
  DI void operator()(const pg8::f32x4 (&acc)[2][2][4][2], const pg8::Unit& u, int wr, int wc, int fr, int fq) const {
    const int x32 = (((fq * 16 + fr) ^ 32) << 2);
#pragma unroll
    for (int ai = 0; ai < 2; ++ai)
#pragma unroll
      for (int m = 0; m < 4; ++m) {
        const int row = u.pm * 256 + ai * 128 + wr * 64 + m * 16 + fr;
        const f32x4 pp = *(const f32x4*)(part + (long)row * 16 + fq * 4);
        float sq = (pp[0] + pp[1]) + (pp[2] + pp[3]);
        sq += __builtin_bit_cast(float, __builtin_amdgcn_ds_swizzle(__builtin_bit_cast(int, sq), 0x401f));
        sq += xch32(sq, x32);
        const float rs = rsqrtf(sq * (1.f / 1024.f) + EPS);
#pragma unroll
        for (int bj = 0; bj < 2; ++bj) f.st(row, u.pn * 256 + bj * 128 + wc * 32 + 8 * fq, acc[ai][bj][m][0] * rs, acc[ai][bj][m][1] * rs);
      }
  }
};
template <class F> struct Epi8Cols {
  static constexpr bool PERM = true, AFTER_DRAIN = false;
  F f; const float* part;
  DI void operator()(const pg8::f32x4 (&acc)[2][2][4][2], const pg8::Unit& u, int wr, int wc, int fr, int fq) const {
    f32x4 r0[2], r1[2];
    const float rsl = row_rs(part, u.pn * 256 + (fr >> 3) * 128 + wc * 32 + 8 * fq + (fr & 7));
#pragma unroll
    for (int bj = 0; bj < 2; ++bj)
#pragma unroll
      for (int j = 0; j < 4; ++j) {
        r0[bj][j] = __builtin_bit_cast(float, __builtin_amdgcn_ds_bpermute(4 * (fq * 16 + bj * 8 + j), __builtin_bit_cast(int, rsl)));
        r1[bj][j] = __builtin_bit_cast(float, __builtin_amdgcn_ds_bpermute(4 * (fq * 16 + bj * 8 + 4 + j), __builtin_bit_cast(int, rsl)));
      }
#pragma unroll
    for (int ai = 0; ai < 2; ++ai)
#pragma unroll
      for (int m = 0; m < 4; ++m) {
        const int row = u.pm * 256 + ai * 128 + wr * 64 + m * 16 + fr;
#pragma unroll
        for (int bj = 0; bj < 2; ++bj) f.st(row, u.pn * 256 + bj * 128 + wc * 32 + 8 * fq, acc[ai][bj][m][0] * r0[bj], acc[ai][bj][m][1] * r1[bj]);
      }
  }
};
struct Epi8Res {
  static constexpr bool PERM = true, AFTER_DRAIN = false;
  bf16_t* xb; float* part; float accscale;
  DI void operator()(const pg8::f32x4 (&acc)[2][2][4][2], const pg8::Unit& u, int wr, int wc, int fr, int fq) const {
    const int x32 = (((fq * 16 + fr) ^ 32) << 2);
#pragma unroll
    for (int ai = 0; ai < 2; ++ai)
#pragma unroll
      for (int m = 0; m < 4; ++m) {
        const int row = u.pm * 256 + ai * 128 + wr * 64 + m * 16 + fr;
        float ss = 0.f;
#pragma unroll
        for (int bj = 0; bj < 2; ++bj) {
          const long o = (long)row * DM + u.pn * 256 + bj * 128 + wc * 32 + 8 * fq;
          const u32x4 xr = *(const u32x4*)(xb + o);
          f32x4 v0, v1;
          v0[0] = bflo(xr[0]); v0[1] = bfhi(xr[0]); v0[2] = bflo(xr[1]); v0[3] = bfhi(xr[1]);
          v1[0] = bflo(xr[2]); v1[1] = bfhi(xr[2]); v1[2] = bflo(xr[3]); v1[3] = bfhi(xr[3]);
          v0 = v0 + acc[ai][bj][m][0] * accscale; v1 = v1 + acc[ai][bj][m][1] * accscale;
          u32x4 w; w[0] = pk2(v0[0], v0[1]); w[1] = pk2(v0[2], v0[3]); w[2] = pk2(v1[0], v1[1]); w[3] = pk2(v1[2], v1[3]);
          *(u32x4*)(xb + o) = w;
          ss += (v0[0] * v0[0] + v0[1] * v0[1]) + (v0[2] * v0[2] + v0[3] * v0[3]) + (v1[0] * v1[0] + v1[1] * v1[1]) + (v1[2] * v1[2] + v1[3] * v1[3]);
        }
        ss += __builtin_bit_cast(float, __builtin_amdgcn_ds_swizzle(__builtin_bit_cast(int, ss), 0x401f));
        ss += xch32(ss, x32);
        if (fq == 0) part[(long)row * 16 + u.pn * 4 + wc] = ss;
      }
  }
};
template <class E> DI void run_gemm_e(const bf16_t* A, const bf16_t* Bt, int M, int N, int K, const E& e) {
  pg8::Gemm g{A, Bt, M, N, K};
  pg8::StaticOrder so; so.init(M, N, (int)gridDim.x, (int)blockIdx.x);
  pg8::gemm_phase<E, pg8::StaticOrder, true, true>(LDSP, g, so, e);
}
template <class F> DI void run_gemm(const bf16_t* A, const bf16_t* Bt, int M, int N, int K, const F& f) {
  pg8::Gemm g{A, Bt, M, N, K};
  pg8::StaticOrder so; so.init(M, N, (int)gridDim.x, (int)blockIdx.x);
  Epi8<F> e{f};
  pg8::gemm_phase<Epi8<F>, pg8::StaticOrder, true, true>(LDSP, g, so, e);
}
struct OneUnit { int pm, pn;
  DI bool next(int i, pg8::Unit& u) const { if (i) return false; u.pm = pm; u.pn = pn; return true; }
  DI void a_ready(const pg8::Unit&) const {}
  DI void done(const pg8::Unit&) const {} };

DI void tr_tile(const float* __restrict__ src, int lds_, int k0, int n0, bf16_t* __restrict__ dst, int ldd, int nd0, float scale, float* sm, const float* __restrict__ gk = nullptr) {
  const int t = otid() & 255;
#pragma unroll
  for (int i = 0; i < 4; ++i) {
    const int kr = (t >> 4) + 16 * i, nc = (t & 15) * 4;
    f32x4 v = *(const f32x4*)(src + (long)(k0 + kr) * lds_ + n0 + nc);
    if (gk) v = v * gk[k0 + kr];
    sm[kr * 65 + nc + 0] = v[0]; sm[kr * 65 + nc + 1] = v[1]; sm[kr * 65 + nc + 2] = v[2]; sm[kr * 65 + nc + 3] = v[3];
  }
  __syncthreads();
  const int n = t >> 2, ks = (t & 3) * 16;
  u32x4 w0, w1;
#pragma unroll
  for (int j = 0; j < 4; ++j) {
    w0[j] = pk2(sm[(ks + 2 * j) * 65 + n] * scale, sm[(ks + 2 * j + 1) * 65 + n] * scale);
    w1[j] = pk2(sm[(ks + 8 + 2 * j) * 65 + n] * scale, sm[(ks + 8 + 2 * j + 1) * 65 + n] * scale);
  }
  bf16_t* d = dst + (long)(nd0 + n) * ldd + k0 + ks;
  *(u32x4*)d = w0; *(u32x4*)(d + 8) = w1;
  __syncthreads();
}

constexpr int NT_ALL = DEPTH * 28 * 16, NT_OUT = DEPTH * 16 * 16, NT_UP = DEPTH * 64 * 16, NT_DOWN = DEPTH * 16 * 64, NT_PW = DEPTH * 4 * 4;
constexpr int N_FOLD = DEPTH * 2 * 4 * 4, N_SGU = 128, N_DM = 112, N_LAM = 1;
constexpr int PREP_ITEMS = NT_ALL + NT_OUT + NT_UP + NT_DOWN + NT_PW + N_FOLD + N_SGU + N_DM + N_LAM;

DI void prep_item(const Params& p, int it, float* sm) {
  const int t = otid() & 255;
  if (it < NT_ALL) {
    const int l = it / (28 * 16), rem = it % (28 * 16), nt = rem / 16, kt = rem % 16;
    const int nd = nt * 64;
    int nsrc; float scale = 1.f;
    if (nd < 512) { nsrc = nd; if (nd < 256) scale = 0.17677669529663687f * LOG2E; }
    else if (nd < 1024) nsrc = 768 + (nd - 512);
    else if (nd < 1536) nsrc = 1536 + (nd - 1024);
    else nsrc = 512 + (nd - 1536);
    tr_tile(p.w_in + (long)l * DM * 2048, 2048, kt * 64, nsrc, p.WallT + (long)l * WALL_N * DM, DM, nd, scale, sm, p.norm1_g + l * DM);
    return;
  }
  it -= NT_ALL;
  if (it < NT_OUT) {
    const int l = it / 256, rem = it % 256, nt = rem / 16, kt = rem % 16;
    tr_tile(p.w_out + (long)l * DM * DM, DM, kt * 64, nt * 64, p.WoutT + (long)l * DM * DM, DM, nt * 64, 1.f, sm);
    return;
  }
  it -= NT_OUT;
  if (it < NT_UP) {
    const int l = it / 1024, rem = it % 1024, nt = rem / 16, kt = rem % 16;
    tr_tile(p.w_up + (long)l * DM * DFF, DFF, kt * 64, nt * 64, p.WupT + (long)l * DFF * DM, DM, nt * 64, 1.f, sm, p.norm2_g + l * DM);
    return;
  }
  it -= NT_UP;
  if (it < NT_DOWN) {
    const int l = it / 1024, rem = it % 1024, nt = rem / 64, kt = rem % 64;
    tr_tile(p.w_down + (long)l * DFF * DM, DM, kt * 64, nt * 64, p.WdownT + (long)l * DM * DFF, DFF, nt * 64, 1.f, sm);
    return;
  }
  it -= NT_DOWN;
  if (it < NT_PW) {
    const int l = it / 16, rem = it % 16, nt = rem / 4, kt = rem % 4;
    tr_tile(p.conv_pw_w + (long)l * 65536, 256, kt * 64, nt * 64, p.pwT + (long)l * 65536, 256, nt * 64, 1.f, sm);
    return;
  }
  it -= NT_PW;
  if (it < N_FOLD) {
    const int l = it >> 5, pq = (it >> 4) & 1, g = (it >> 2) & 3, kcn = it & 3;
    const float* fw = p.fnet_w + ((long)l * 4 + g) * 4096;
    float* trig = sm + 4096;
    if (t < 64) trig[t] = pq ? sinpif((float)t * (1.f / 32.f)) : cospif((float)t * (1.f / 32.f));
    __syncthreads();
    for (int idx = t; idx < 4096; idx += 256) {
      const int c = idx >> 6, e = idx & 63;
      float s = 0.f;
      for (int kc = 0; kc < 64; ++kc) s += trig[(c * kc) & 63] * fw[kc * 64 + e];
      sm[idx] = s * (1.f / 512.f);
    }
    __syncthreads();
    const int k = kcn * 256 + t;
    const float gk1 = p.norm1_g[l * DM + k];
    const float* wr = p.w_in + (long)l * DM * 2048 + (long)k * 2048 + 1280 + g * 64;
    f32x4 wv[16];
#pragma unroll
    for (int i = 0; i < 16; ++i) wv[i] = *(const f32x4*)(wr + 4 * i);
    bf16_t* dst = p.WallT + (long)l * WALL_N * DM + (long)(1792 + pq * 256 + g * 64) * DM + k;
#pragma unroll 1
    for (int e = 0; e < 64; ++e) {
      float s = 0.f;
#pragma unroll
      for (int i = 0; i < 16; ++i) {
        s += wv[i][0] * sm[(4 * i + 0) * 64 + e]; s += wv[i][1] * sm[(4 * i + 1) * 64 + e];
        s += wv[i][2] * sm[(4 * i + 2) * 64 + e]; s += wv[i][3] * sm[(4 * i + 3) * 64 + e];
      }
      dst[(long)e * DM] = (bf16_t)(pk2(s * gk1, 0.f) & 0xffffu);
    }
    __syncthreads();
    return;
  }
  it -= N_FOLD;
  if (it < N_SGU) {
    const long o = (long)it * 2048 + t * 8;
    const f32x4 a = *(const f32x4*)(p.sgu_w + o), b = *(const f32x4*)(p.sgu_w + o + 4);
    u32x4 w; w[0] = pk2(a[0], a[1]); w[1] = pk2(a[2], a[3]); w[2] = pk2(b[0], b[1]); w[3] = pk2(b[2], b[3]);
    *(u32x4*)(p.sguW + o) = w;
    return;
  }
  it -= N_SGU;
  if (it < N_DM) {
    const int e = it * 256 + t;
    if (e < 16384) {
      const int m = e >> 7, k = e & 127, ro = m >> 6, k1 = m & 63, ri = k >> 6, s1 = k & 63;
      const float ang = (float)((s1 * k1) & 63) * (1.f / 32.f);
      const float c = cospif(ang), sn = sinpif(ang);
      const float v = (ro == 0) ? (ri == 0 ? c : -sn) : (ri == 0 ? sn : c);
      p.M1[e] = (bf16_t)(pk2(v, 0.f) & 0xffffu);
    } else if (e < 16384 + 8192) {
      const int e2 = e - 16384, k2 = e2 >> 7, k = e2 & 127, ri = k >> 6, s2 = k & 63;
      const float ang = (float)((s2 * k2) & 63) * (1.f / 32.f);
      const float v = (ri == 0) ? cospif(ang) : -sinpif(ang);
      p.M3[e2] = (bf16_t)(pk2(v, 0.f) & 0xffffu);
    } else {
      const int e3 = e - 16384 - 8192, k1 = e3 >> 6, s2 = e3 & 63;
      const float ang = (float)(s2 * k1) * (1.f / 2048.f);
      ((unsigned*)p.TW)[e3] = pk2(cospif(ang), sinpif(ang));
    }
    return;
  }
  it -= N_DM;
  if (t < DEPTH) {
    const int l = t;
    float s1 = 0.f, s2 = 0.f;
    for (int i = 0; i < 32; ++i) { s1 += p.lam_q1[l * 32 + i] * p.lam_k1[l * 32 + i]; s2 += p.lam_q2[l * 32 + i] * p.lam_k2[l * 32 + i]; }
    const float lam_init = 0.8f - 0.6f * expf(-0.3f * (float)l);
    p.lam[l] = expf(s1) - expf(s2) + lam_init;
  }
}

NI void prep_phase() {
  KPARAMS;
  const int half = otid() >> 8;
  float* sm = (float*)smem_raw + half * (HALF_E / 2);
  for (int it0 = blockIdx.x * 2 + half; it0 < PREP_ITEMS; it0 += gridDim.x * 2) prep_item(p, it0, sm);
  const int tid_ = otid(); const int lane = tid_ & 63, wid = tid_ >> 6, x32 = ((lane ^ 32) << 2);
  for (int row = blockIdx.x * 8 + wid; row < NTOK; row += gridDim.x * 8) {
    const float* sp = p.x + (long)row * DM;
    float ss = 0.f;
#pragma unroll
    for (int i = 0; i < 4; ++i) {
      const f32x4 v = *(const f32x4*)(sp + lane * 4 + 256 * i);
      ss += v[0] * v[0] + v[1] * v[1] + v[2] * v[2] + v[3] * v[3];
      u32x2 w; w[0] = pk2(v[0], v[1]); w[1] = pk2(v[2], v[3]); *(u32x2*)(p.xn + (long)row * DM + lane * 4 + 256 * i) = w;
    }
    ss = wave_sum(ss, x32);
    if (lane < 16) p.part[(long)row * 16 + lane] = (lane == 0) ? ss : 0.f;
  }
}

NI void final_rms_phase(const bf16_t* __restrict__ src, const float* __restrict__ g, float* __restrict__ dstf) {
  const int tid_ = otid(); const int lane = tid_ & 63, wid = tid_ >> 6, x32 = ((lane ^ 32) << 2);
  f32x4 gv[4];
#pragma unroll
  for (int i = 0; i < 4; ++i) gv[i] = *(const f32x4*)(g + lane * 4 + 256 * i);
  for (int row = blockIdx.x * 8 + wid; row < NTOK; row += gridDim.x * 8) {
    f32x4 v[4];
    float ss = 0.f;
#pragma unroll
    for (int i = 0; i < 4; ++i) {
      const u32x2 r = *(const u32x2*)(src + (long)row * DM + lane * 4 + 256 * i);
      v[i][0] = bflo(r[0]); v[i][1] = bfhi(r[0]); v[i][2] = bflo(r[1]); v[i][3] = bfhi(r[1]);
      ss += v[i][0] * v[i][0] + v[i][1] * v[i][1] + v[i][2] * v[i][2] + v[i][3] * v[i][3];
    }
    ss = wave_sum(ss, x32);
    const float rs = rsqrtf(ss * (1.f / 1024.f) + EPS);
#pragma unroll
    for (int i = 0; i < 4; ++i) *(f32x4*)(dstf + (long)row * DM + lane * 4 + 256 * i) = v[i] * rs * gv[i];
  }
}

DI u32x4 pk8(f32x4 a, f32x4 b) { u32x4 w; w[0] = pk2(a[0], a[1]); w[1] = pk2(a[2], a[3]); w[2] = pk2(b[0], b[1]); w[3] = pk2(b[2], b[3]); return w; }
struct StH { bf16_t* h; DI void st(int r, int c, f32x4 a, f32x4 b) const { *(u32x4*)(h + (long)r * HC + c) = pk8(a, b); } };
struct StT { bf16_t* Vt; bf16_t* PQt;
  DI void st(int n, int tok, f32x4 a, f32x4 b) const {
    const int bb = tok >> 12, s = tok & 4095; const u32x4 w = pk8(a, b);
    if (n < 256) *(u32x4*)(Vt + ((long)(bb * 256 + n)) * 4096 + s) = w;
    else { const int np = n - 256, pq = np >> 8, ch = np & 255; *(u32x4*)(PQt + ((long)(bb * 256 + ch)) * 8192 + pq * 4096 + s) = w; }
  } };
struct StRes { const float* xin; float* out;
  DI void st(int r, int c, f32x4 a, f32x4 b) const { const long o = (long)r * DM + c; const f32x4 x0 = *(const f32x4*)(xin + o), x1 = *(const f32x4*)(xin + o + 4); *(f32x4*)(out + o) = x0 + a; *(f32x4*)(out + o + 4) = x1 + b; } };
struct StUp { bf16_t* hid;
  DI void st(int r, int c, f32x4 a, f32x4 b) const {
#pragma unroll
    for (int j = 0; j < 4; ++j) { a[j] = fmaxf(a[j], 0.f); b[j] = fmaxf(b[j], 0.f); }
    *(u32x4*)(hid + (long)r * DFF + c) = pk8(a * a, b * b); } };

NI void gemm_in_phase(int l) {
  KPARAMS;
  const bf16_t* W = p.WallT + (long)l * WALL_N * DM;
  run_gemm_e(p.xn, W, NTOK, HC, DM, Epi8Rows<StH>{StH{p.h}, p.part});
  run_gemm_e(W + (long)HC * DM, p.xn, 768, NTOK, DM, Epi8Cols<StT>{StT{p.Vt, p.PQt}, p.part});
}
NI void gemm_out_phase(int l, float accscale) {
  KPARAMS;
  run_gemm_e(p.y, p.WoutT + (long)l * DM * DM, NTOK, DM, DM, Epi8Res{p.xn, p.part, accscale});
}
NI void gemm_up_phase(int l) {
  KPARAMS;
  run_gemm_e(p.xn, p.WupT + (long)l * DFF * DM, NTOK, DFF, DM, Epi8Rows<StUp>{StUp{p.hid}, p.part});
}
NI void gemm_down_phase(int l, float accscale) {
  KPARAMS;
  run_gemm_e(p.hid, p.WdownT + (long)l * DM * DFF, NTOK, DM, DFF, Epi8Res{p.xn, p.part, accscale});
}

constexpr int ARS = 72;
constexpr int ATILE = 64 * ARS;
NI void attn_tile(int l, int id, LAS3 unsigned* cnt, unsigned& target) {
  KPARAMS;
  const int tidf = otid(), half = __builtin_amdgcn_readfirstlane(tidf >> 8), tid = tidf & 255, lane = tid & 63, wid = __builtin_amdgcn_readfirstlane(tid >> 6), r = lane & 31, hh = lane >> 5, x32 = ((lane ^ 32) << 2);
  bf16_t* smem = SMEM + half * HALF_E;
  const int head = 3 - (id >> 8), b = (id >> 5) & 7, qb = id & 31;
  const float slope = (head == 0) ? 0.25f : (head == 1) ? 0.0625f : (head == 2) ? 0.015625f : 0.00390625f;
  const float ncs = -slope * LOG2E, cs = slope * LOG2E;
  const int qi = qb * 128 + wid * 32 + r;
  const bf16_t* qrow = p.h + ((long)(b * SEQ + qi)) * HC + head * 64;
  bf16x8 qf[2][2];
#pragma unroll
  for (int m = 0; m < 2; ++m)
#pragma unroll
    for (int s = 0; s < 2; ++s) qf[m][s] = *(const bf16x8*)(qrow + m * 32 + s * 16 + hh * 8);
  const bf16_t* kbase = p.h + ((long)(b * SEQ)) * HC + 256 + head * 64;
  const bf16_t* vbase = p.Vt + ((long)((b * 4 + head) * 64)) * SEQ;
  const int srow = tid >> 3, scol = (tid & 7) * 8;
  u32x4 rk[2], rv[2];
  f32x16 O[2][2];
#pragma unroll
  for (int m = 0; m < 2; ++m)
#pragma unroll
    for (int vb = 0; vb < 2; ++vb)
#pragma unroll
      for (int i = 0; i < 16; ++i) O[m][vb][i] = 0.f;
  float mrun[2] = {0.f, 0.f}, lrun[2] = {0.f, 0.f};
  const int kperm = (r & 19) | ((r & 4) << 1) | ((r & 8) >> 1);
  const int ktd = (qb * 128 + wid * 32) >> 6;
  unsigned csw, jrelw[2];
  { const unsigned h_ = pk2(cs, 0.f) & 0xffffu; csw = h_ | (pk2(cs - bflo(h_), 0.f) << 16); }
#pragma unroll
  for (int kb = 0; kb < 2; ++kb) { const float j_ = (float)(kb * 32 + kperm); jrelw[kb] = pk2(j_, j_); }

  const int wkeys = (head == 0) ? 305 : (head == 1) ? 1220 : SEQ;
  const int kt_lo = max(0, qb * 128 - wkeys) >> 6, kt_hi = min(SEQ, qb * 128 + 128 + wkeys + 63) >> 6;
#pragma unroll
  for (int i = 0; i < 2; ++i) {
    rk[i] = *(const u32x4*)(kbase + (long)(kt_lo * 64 + srow + 32 * i) * HC + scol);
    rv[i] = *(const u32x4*)(vbase + (long)(srow + 32 * i) * SEQ + kt_lo * 64 + scol);
  }
#pragma unroll
  for (int i = 0; i < 2; ++i) { *(u32x4*)(smem + (srow + 32 * i) * ARS + scol) = rk[i]; *(u32x4*)(smem + ATILE + (srow + 32 * i) * ARS + scol) = rv[i]; }
  asm volatile("" :: "v"(qf[0][0]), "v"(qf[0][1]), "v"(qf[1][0]), "v"(qf[1][1]));
  HBAR();
  for (int kt = kt_lo; kt < kt_hi; ++kt) {
    const bool more = (kt + 1) < kt_hi;
    if (more) {
#pragma unroll
      for (int i = 0; i < 2; ++i) {
        rk[i] = *(const u32x4*)(kbase + (long)((kt + 1) * 64 + srow + 32 * i) * HC + scol);
        rv[i] = *(const u32x4*)(vbase + (long)(srow + 32 * i) * SEQ + (kt + 1) * 64 + scol);
      }
    }
    const bf16_t* Ks = smem + ((kt - kt_lo) & 1) * 2 * ATILE;
    const bf16_t* Vs = Ks + ATILE;
    const float dbase = (float)(qi - kt * 64 - 8 * hh);
    const bool diag = (kt == ktd);
#pragma unroll
    for (int m = 0; m < 2; ++m) {
      __builtin_amdgcn_sched_barrier(0);
      f32x16 x[2];
      if (!diag) {
        const bool left = kt < ktd;
        const float C = fmaf(left ? cs : -cs, (float)(kt * 64 - qi), -mrun[m]);
        const unsigned wC = pk2(C, 0.f), wL = pk2(C - bflo(wC), 0.f);
        u32x4 qa; qa[0] = hh ? 0u : (left ? csw : (csw ^ 0x80008000u)); qa[1] = hh ? 0u : ((wC & 0xffffu) | (wL << 16)); qa[2] = 0u; qa[3] = 0u;
#pragma unroll
        for (int kb = 0; kb < 2; ++kb) {
          u32x4 ka; ka[0] = hh ? 0u : jrelw[kb]; ka[1] = hh ? 0u : 0x3f803f80u; ka[2] = 0u; ka[3] = 0u;
#pragma unroll
          for (int i = 0; i < 16; ++i) x[kb][i] = 0.f;
          x[kb] = __builtin_amdgcn_mfma_f32_32x32x16_bf16(__builtin_bit_cast(bf16x8, ka), __builtin_bit_cast(bf16x8, qa), x[kb], 0, 0, 0);
#pragma unroll
          for (int s = 0; s < 2; ++s) {
            const bf16x8 kf = *(const bf16x8*)(Ks + (kb * 32 + kperm) * ARS + m * 32 + s * 16 + hh * 8);
            x[kb] = __builtin_amdgcn_mfma_f32_32x32x16_bf16(kf, qf[m][s], x[kb], 0, 0, 0);
          }
        }
      } else {
#pragma unroll
        for (int kb = 0; kb < 2; ++kb) {
#pragma unroll
          for (int i = 0; i < 16; ++i) x[kb][i] = 0.f;
#pragma unroll
          for (int s = 0; s < 2; ++s) {
            const bf16x8 kf = *(const bf16x8*)(Ks + (kb * 32 + kperm) * ARS + m * 32 + s * 16 + hh * 8);
            x[kb] = __builtin_amdgcn_mfma_f32_32x32x16_bf16(kf, qf[m][s], x[kb], 0, 0, 0);
          }
        }
        const float nm = -mrun[m];
#pragma unroll
        for (int kb = 0; kb < 2; ++kb)
#pragma unroll
          for (int i = 0; i < 16; ++i) {
            const float off = (float)(kb * 32 + 16 * (i >> 3) + (i & 7));
            x[kb][i] = fmaf(ncs, fabsf(dbase - off), x[kb][i]) + nm;
          }
      }
      float mx = -1e30f;
#pragma unroll
      for (int kb = 0; kb < 2; ++kb)
#pragma unroll
        for (int i = 0; i < 16; ++i) mx = fmaxf(mx, x[kb][i]);
      mx = fmaxf(mx, xch32(mx, x32));
      if (__builtin_amdgcn_ballot_w64(mx > 8.f) != 0ull) {
        const float delta = fmaxf(mx, 0.f);
        const float alpha = __builtin_amdgcn_exp2f(-delta);
        mrun[m] += delta;
        lrun[m] *= alpha;
#pragma unroll
        for (int vb = 0; vb < 2; ++vb)
#pragma unroll
          for (int i = 0; i < 16; ++i) O[m][vb][i] *= alpha;
#pragma unroll
        for (int kb = 0; kb < 2; ++kb)
#pragma unroll
          for (int i = 0; i < 16; ++i) x[kb][i] -= delta;
      }
      float ps = 0.f;
#pragma unroll
      for (int kb = 0; kb < 2; ++kb)
#pragma unroll
        for (int i = 0; i < 16; ++i) { x[kb][i] = __builtin_amdgcn_exp2f(x[kb][i]); ps += x[kb][i]; }
      lrun[m] += ps;
#pragma unroll
      for (int kb = 0; kb < 2; ++kb)
#pragma unroll
        for (int s = 0; s < 2; ++s) {
          u32x4 pw;
#pragma unroll
          for (int j = 0; j < 4; ++j) pw[j] = pk2(x[kb][8 * s + 2 * j], x[kb][8 * s + 2 * j + 1]);
          const bf16x8 pf = __builtin_bit_cast(bf16x8, pw);
#pragma unroll
          for (int vb = 0; vb < 2; ++vb) {
            const bf16x8 vf = *(const bf16x8*)(Vs + (vb * 32 + r) * ARS + kb * 32 + s * 16 + hh * 8);
            O[m][vb] = __builtin_amdgcn_mfma_f32_32x32x16_bf16(vf, pf, O[m][vb], 0, 0, 0);
          }
        }
    }
    if (more) {
      bf16_t* wk = smem + ((kt + 1 - kt_lo) & 1) * 2 * ATILE;
#pragma unroll
      for (int i = 0; i < 2; ++i) { *(u32x4*)(wk + (srow + 32 * i) * ARS + scol) = rk[i]; *(u32x4*)(wk + ATILE + (srow + 32 * i) * ARS + scol) = rv[i]; }
    }
    HBAR();
  }
  asm volatile("" ::: "memory");
  const int tid2 = otid() & 255, lane2 = tid2 & 63, hh2 = lane2 >> 5, qi2 = qb * 128 + __builtin_amdgcn_readfirstlane(tid2 >> 6) * 32 + (lane2 & 31);
  const float lam = p.lam[l];
  int lx = l; asm volatile("" : "+s"(lx));
  const float lam_init = (lx == 0) ? 0.2f : (lx == 1) ? 0.35550907f : (lx == 2) ? 0.47071302f : 0.55605820f;
  const float l1 = lrun[0] + xch32(lrun[0], x32), l2 = lrun[1] + xch32(lrun[1], x32);
  const float i1 = 1.f / l1, i2 = lam / l2;
  float ss = 0.f;
#pragma unroll
  for (int vb = 0; vb < 2; ++vb)
#pragma unroll
    for (int i = 0; i < 16; ++i) { const float o = O[0][vb][i] * i1 - O[1][vb][i] * i2; O[0][vb][i] = o; ss += o * o; }
  ss += xch32(ss, x32);
  const float rs = rsqrtf(ss * (1.f / 64.f) + EPS) * (1.f - lam_init);
  const float* sg = p.subln_g + l * 64;
  bf16_t* yrow = p.y + ((long)(b * SEQ + qi2)) * DM + head * 64;
#pragma unroll
  for (int vb = 0; vb < 2; ++vb)
#pragma unroll
    for (int g4 = 0; g4 < 4; ++g4) {
      const int vc = vb * 32 + 8 * g4 + 4 * hh2;
      const f32x4 gg = *(const f32x4*)(sg + vc);
      u32x2 w;
      w[0] = pk2(O[0][vb][4 * g4 + 0] * rs * gg[0], O[0][vb][4 * g4 + 1] * rs * gg[1]);
      w[1] = pk2(O[0][vb][4 * g4 + 2] * rs * gg[2], O[0][vb][4 * g4 + 3] * rs * gg[3]);
      *(u32x2*)(yrow + vc) = w;
    }
}

constexpr int ZRS = 264;
NI void conv_tile(int l, int id, LAS3 unsigned* cnt, unsigned& target) {
  KPARAMS;
  const int tidf = otid(), half = __builtin_amdgcn_readfirstlane(tidf >> 8), tid = tidf & 255, lane = tid & 63, wid = __builtin_amdgcn_readfirstlane(tid >> 6), x32 = ((lane ^ 32) << 2);
  bf16_t* smem = SMEM + half * HALF_E;
  const int b = id >> 6, t0 = (id & 63) * 64;
  for (int idx = tid; idx < 94 * 32; idx += 256) {
    const int row = idx >> 5, c8 = (idx & 31) * 8;
    const int tok = t0 - 15 + row;
    u32x4 w = (u32x4){0u, 0u, 0u, 0u};
    if (tok >= 0 && tok < SEQ) {
      const bf16_t* hp = p.h + ((long)(b * SEQ + tok)) * HC + 512 + c8;
      const u32x4 a = *(const u32x4*)hp, g = *(const u32x4*)(hp + 256);
#pragma unroll
      for (int j = 0; j < 4; ++j) {
        const float a0 = bflo(a[j]), a1 = bfhi(a[j]), g0 = bflo(g[j]), g1 = bfhi(g[j]);
        w[j] = pk2(a0 * __builtin_amdgcn_rcpf(1.f + __builtin_amdgcn_exp2f(-LOG2E * g0)), a1 * __builtin_amdgcn_rcpf(1.f + __builtin_amdgcn_exp2f(-LOG2E * g1)));
      }
    }
    *(u32x4*)(smem + row * ZRS + c8) = w;
  }
  HBAR();
  {
    const int c = tid;
    float wv[31];
#pragma unroll
    for (int j = 0; j < 31; ++j) wv[j] = p.conv_dw_w[((long)l * 31 + j) * 256 + c];
    const float cb = p.conv_dw_b[l * 256 + c], lg = p.conv_ln_g[l * 256 + c], lb = p.conv_ln_b[l * 256 + c];
#pragma unroll 1
    for (int ch = 0; ch < 8; ++ch) {
      float zw[38];
#pragma unroll
      for (int j = 0; j < 38; ++j) zw[j] = bf2f(smem[(ch * 8 + j) * ZRS + c]);
      float o[8];
#pragma unroll
      for (int tt = 0; tt < 8; ++tt) {
        float s = cb;
#pragma unroll
        for (int j = 0; j < 31; ++j) s = fmaf(wv[j], zw[tt + j], s);
        o[tt] = s;
      }
#pragma unroll
      for (int tt = 0; tt < 8; ++tt) {
        const float s1 = wave_sum(o[tt], x32), s2 = wave_sum(o[tt] * o[tt], x32);
        const float mu = s1 * (1.f / 64.f);
        const float var = fmaxf(s2 * (1.f / 64.f) - mu * mu, 0.f);
        const float yv = (o[tt] - mu) * rsqrtf(var + EPS) * lg + lb;
        const float sv = yv * __builtin_amdgcn_rcpf(1.f + __builtin_amdgcn_exp2f(-LOG2E * yv));
        smem[(ch * 8 + tt) * ZRS + c] = (bf16_t)(pk2(sv, 0.f) & 0xffffu);
      }
    }
  }
  HBAR();
  {
    const int fr = lane & 15, fq = lane >> 4;
    const bf16_t* W = p.pwT + (long)l * 65536 + (long)(wid * 64) * 256;
    f32x4 acc[4][4];
#pragma unroll
    for (int m = 0; m < 4; ++m)
#pragma unroll
      for (int n = 0; n < 4; ++n) acc[m][n] = (f32x4){0.f, 0.f, 0.f, 0.f};
#pragma unroll 2
    for (int ks = 0; ks < 8; ++ks) {
      bf16x8 af[4], bfr[4];
#pragma unroll
      for (int m = 0; m < 4; ++m) af[m] = *(const bf16x8*)(smem + (m * 16 + fr) * ZRS + ks * 32 + fq * 8);
#pragma unroll
      for (int n = 0; n < 4; ++n) bfr[n] = *(const bf16x8*)(W + (long)(n * 16 + fr) * 256 + ks * 32 + fq * 8);
#pragma unroll
      for (int m = 0; m < 4; ++m)
#pragma unroll
        for (int n = 0; n < 4; ++n) acc[m][n] = __builtin_amdgcn_mfma_f32_16x16x32_bf16(bfr[n], af[m], acc[m][n], 0, 0, 0);
    }
    const float* pb = p.conv_pw_b + l * 256;
#pragma unroll
    for (int m = 0; m < 4; ++m)
#pragma unroll
      for (int n = 0; n < 4; ++n) {
        const int tok = t0 + m * 16 + fr, col = wid * 64 + n * 16 + fq * 4;
        const f32x4 bv = *(const f32x4*)(pb + col);
        const f32x4 v = acc[m][n] + bv;
        u32x2 w; w[0] = pk2(v[0], v[1]); w[1] = pk2(v[2], v[3]);
        *(u32x2*)(p.y + ((long)(b * SEQ + tok)) * DM + 256 + col) = w;
      }
  }
  HBAR();
}

constexpr int VRS = 258;
NI void sgu_tile(int l, int id, LAS3 unsigned* cnt, unsigned& target) {
  KPARAMS;
  const int tidf = otid(), half = __builtin_amdgcn_readfirstlane(tidf >> 8), tid = tidf & 255, lane = tid & 63, wid = __builtin_amdgcn_readfirstlane(tid >> 6), x32 = ((lane ^ 32) << 2);
  bf16_t* smem = SMEM + half * HALF_E;
  const long T0 = (long)id * 128;
  {
    const f32x4 lg = *(const f32x4*)(p.sgu_ln_g + l * 256 + lane * 4), lb = *(const f32x4*)(p.sgu_ln_b + l * 256 + lane * 4);
#pragma unroll 4
    for (int i = 0; i < 32; ++i) {
      const int s = wid * 32 + i;
      const u32x2 raw = *(const u32x2*)(p.h + (T0 + s) * HC + 1280 + lane * 4);
      const float v0 = bflo(raw[0]), v1 = bfhi(raw[0]), v2 = bflo(raw[1]), v3 = bfhi(raw[1]);
      const float s1 = wave_sum(v0 + v1 + v2 + v3, x32);
      const float mu = s1 * (1.f / 256.f);
      const float d0 = v0 - mu, d1 = v1 - mu, d2 = v2 - mu, d3 = v3 - mu;
      const float s2 = wave_sum(d0 * d0 + d1 * d1 + d2 * d2 + d3 * d3, x32);
      const float rs = rsqrtf(s2 * (1.f / 256.f) + EPS);
      unsigned* dst = (unsigned*)(smem + s * VRS + lane * 4);
      dst[0] = pk2(d0 * rs * lg[0] + lb[0], d1 * rs * lg[1] + lb[1]);
      dst[1] = pk2(d2 * rs * lg[2] + lb[2], d3 * rs * lg[3] + lb[3]);
    }
  }
  HBAR();
  {
    const int fr = lane & 15, fq = lane >> 4, g = wid;
    const bf16_t* W = p.sguW + ((long)(l * 4 + g)) * 16384;
    const float* bs = p.sgu_b + ((long)(l * 4 + g)) * 128;
#pragma unroll 1
    for (int th = 0; th < 2; ++th) {
      f32x4 acc[4][4];
#pragma unroll
      for (int m = 0; m < 4; ++m)
#pragma unroll
        for (int n = 0; n < 4; ++n) acc[m][n] = (f32x4){0.f, 0.f, 0.f, 0.f};
#pragma unroll 1
      for (int ks = 0; ks < 4; ++ks) {
        bf16x8 vf[4], wf[4];
#pragma unroll
        for (int n = 0; n < 4; ++n) {
#pragma unroll
          for (int j = 0; j < 8; ++j) vf[n][j] = (short)smem[(ks * 32 + fq * 8 + j) * VRS + g * 64 + n * 16 + fr];
        }
#pragma unroll
        for (int m = 0; m < 4; ++m) wf[m] = *(const bf16x8*)(W + (long)(th * 64 + m * 16 + fr) * 128 + ks * 32 + fq * 8);
#pragma unroll
        for (int m = 0; m < 4; ++m)
#pragma unroll
          for (int n = 0; n < 4; ++n) acc[m][n] = __builtin_amdgcn_mfma_f32_16x16x32_bf16(vf[n], wf[m], acc[m][n], 0, 0, 0);
      }
#pragma unroll
      for (int m = 0; m < 4; ++m) {
        const int t = th * 64 + m * 16 + fr;
        const float bt = bs[t];
#pragma unroll
        for (int n = 0; n < 4; ++n) {
          const int c = g * 64 + n * 16 + fq * 4;
          const u32x2 ur = *(const u32x2*)(p.h + (T0 + t) * HC + 1024 + c);
          const f32x4 sv = acc[m][n] + bt;
          u32x2 w; w[0] = pk2(bflo(ur[0]) * sv[0], bfhi(ur[0]) * sv[1]); w[1] = pk2(bflo(ur[1]) * sv[2], bfhi(ur[1]) * sv[3]);
          *(u32x2*)(p.y + (T0 + t) * DM + 768 + c) = w;
        }
      }
    }
  }
  HBAR();
}

constexpr int FRS = 72, FPL = 64 * FRS, FCH = 2 * FPL + 64;
NI void fft_item(int l, int id, LAS3 unsigned* cnt, unsigned& target) {
  KPARAMS;
  const int tidf = otid(), half = __builtin_amdgcn_readfirstlane(tidf >> 8), tid = tidf & 255, lane = tid & 63, wid = __builtin_amdgcn_readfirstlane(tid >> 6);
  const int fr = lane & 15, fq = lane >> 4;
  bf16_t* smem = SMEM + half * HALF_E;
  const int b = id >> 7, ch0 = (id & 127) * 2;
  bf16_t* Ct = smem + 2 * FCH;
  unsigned* TWl = (unsigned*)(Ct + 2 * FPL);
  {
    u32x4 zv[8], cv[4], tv[4];
#pragma unroll
    for (int i = 0; i < 8; ++i) {
      const int chunk = tid + 256 * i, c = chunk >> 10, rem = chunk & 1023, ri = rem >> 9, s8 = rem & 511;
      zv[i] = *(const u32x4*)(p.PQt + ((long)(b * 256 + ch0 + c)) * 8192 + ri * 4096 + s8 * 8);
    }
#pragma unroll
    for (int i = 0; i < 4; ++i) {
      const int chunk = tid + 256 * i, tb = chunk >> 9, row = (chunk >> 3) & 63, c8 = chunk & 7;
      cv[i] = *(const u32x4*)(p.M1 + (tb * 64 + row) * 128 + c8 * 8);
      tv[i] = *(const u32x4*)((const unsigned*)p.TW + chunk * 4);
    }
#pragma unroll
    for (int i = 0; i < 8; ++i) {
      const int chunk = tid + 256 * i, c = chunk >> 10, rem = chunk & 1023, ri = rem >> 9, s8 = rem & 511;
      *(u32x4*)(smem + c * FCH + ri * FPL + (s8 >> 3) * FRS + (s8 & 7) * 8) = zv[i];
    }
#pragma unroll
    for (int i = 0; i < 4; ++i) {
      const int chunk = tid + 256 * i, tb = chunk >> 9, row = (chunk >> 3) & 63, c8 = chunk & 7;
      *(u32x4*)(Ct + tb * FPL + row * FRS + c8 * 8) = cv[i];
      *(u32x4*)(TWl + (chunk >> 4) * 68 + (chunk & 15) * 4) = tv[i];
    }
  }
  HBAR();
  {
    const int c = wid >> 1;
    bf16x8 zf[2][4];
#pragma unroll
    for (int nt = 0; nt < 2; ++nt)
#pragma unroll
      for (int ks = 0; ks < 4; ++ks) {
        const bf16_t* src = smem + c * FCH + (ks >> 1) * FPL + ((ks & 1) * 32 + fq * 8) * FRS + (wid & 1) * 32 + nt * 16 + fr;
#pragma unroll
        for (int j = 0; j < 8; ++j) zf[nt][ks][j] = (short)src[j * FRS];
      }
    f32x4 acc[2][8];
#pragma unroll
    for (int nt = 0; nt < 2; ++nt)
#pragma unroll
      for (int mt = 0; mt < 8; ++mt) acc[nt][mt] = (f32x4){0.f, 0.f, 0.f, 0.f};
#pragma unroll
    for (int mt = 0; mt < 8; ++mt)
#pragma unroll
      for (int ks = 0; ks < 4; ++ks) {
        u32x4 mw = *(const u32x4*)(Ct + (((mt >> 2) == (ks >> 1)) ? 0 : FPL) + ((mt & 3) * 16 + fr) * FRS + (ks & 1) * 32 + fq * 8);
        if ((mt >> 2) == 0 && (ks >> 1) == 1) mw = mw ^ 0x80008000u;
        const bf16x8 mf = __builtin_bit_cast(bf16x8, mw);
#pragma unroll
        for (int nt = 0; nt < 2; ++nt) acc[nt][mt] = __builtin_amdgcn_mfma_f32_16x16x32_bf16(zf[nt][ks], mf, acc[nt][mt], 0, 0, 0);
      }
#pragma unroll
    for (int nt = 0; nt < 2; ++nt)
#pragma unroll
      for (int m4 = 0; m4 < 4; ++m4) {
        const int k1 = m4 * 16 + fr, s2 = (wid & 1) * 32 + nt * 16 + fq * 4;
        const u32x4 tw = *(const u32x4*)(TWl + k1 * 68 + s2);
        const f32x4 yr = acc[nt][m4], yi = acc[nt][m4 + 4];
        const float cs[4] = {bflo(tw[0]), bflo(tw[1]), bflo(tw[2]), bflo(tw[3])}, sn[4] = {bfhi(tw[0]), bfhi(tw[1]), bfhi(tw[2]), bfhi(tw[3])};
        float tr[4], ti[4];
#pragma unroll
        for (int j = 0; j < 4; ++j) { tr[j] = yr[j] * cs[j] - yi[j] * sn[j]; ti[j] = yr[j] * sn[j] + yi[j] * cs[j]; }
        u32x2 wr_, wi_; wr_[0] = pk2(tr[0], tr[1]); wr_[1] = pk2(tr[2], tr[3]); wi_[0] = pk2(ti[0], ti[1]); wi_[1] = pk2(ti[2], ti[3]);
        *(u32x2*)(smem + c * FCH + k1 * FRS + s2) = wr_;
        *(u32x2*)(smem + c * FCH + FPL + k1 * FRS + s2) = wi_;
      }
  }
  HBAR();
  {
    f32x4 acc[2][4];
#pragma unroll
    for (int t = 0; t < 2; ++t)
#pragma unroll
      for (int mt = 0; mt < 4; ++mt) acc[t][mt] = (f32x4){0.f, 0.f, 0.f, 0.f};
#pragma unroll
    for (int ks = 0; ks < 4; ++ks) {
      bf16x8 tf[2];
#pragma unroll
      for (int t = 0; t < 2; ++t) {
        const int k1 = (wid * 2 + t) * 8 + (fr >> 1), c = fr & 1;
        tf[t] = *(const bf16x8*)(smem + c * FCH + (ks >> 1) * FPL + k1 * FRS + (ks & 1) * 32 + fq * 8);
      }
#pragma unroll
      for (int mt = 0; mt < 4; ++mt) {
        u32x4 mw = *(const u32x4*)(Ct + ((ks >> 1) ? FPL : 0) + (mt * 16 + fr) * FRS + (ks & 1) * 32 + fq * 8);
        if (ks >> 1) mw = mw ^ 0x80008000u;
        const bf16x8 mf = __builtin_bit_cast(bf16x8, mw);
#pragma unroll
        for (int t = 0; t < 2; ++t) acc[t][mt] = __builtin_amdgcn_mfma_f32_16x16x32_bf16(tf[t], mf, acc[t][mt], 0, 0, 0);
      }
    }
    const float b0 = p.fnet_b[l * 256 + ch0], b1 = p.fnet_b[l * 256 + ch0 + 1];
#pragma unroll
    for (int t = 0; t < 2; ++t)
#pragma unroll
      for (int mt = 0; mt < 4; ++mt)
#pragma unroll
        for (int jj = 0; jj < 2; ++jj) {
          const int k1 = (wid * 2 + t) * 8 + 2 * fq + jj, k2 = mt * 16 + fr;
          *(unsigned*)(p.y + ((long)(b * SEQ + k1 + 64 * k2)) * DM + 512 + ch0) = pk2(acc[t][mt][2 * jj] + b0, acc[t][mt][2 * jj + 1] + b1);
        }
  }
  HBAR();
}

NI void mixer_phase(int l, int rep) {
  KPARAMS;
  constexpr int NA = 1024, NF = 1024, NC = 512, ND = 256;
  const int tidf = otid(), half = __builtin_amdgcn_readfirstlane(tidf >> 8), tid = tidf & 255, lane = tid & 63;
  LAS3 unsigned* ctl = (LAS3 unsigned*)(LDSP + 2 * HALF_B);
  LAS3 unsigned* cnt = ctl + 8 + 4 * half;
  LAS3 unsigned* nx = ctl + 16 + 4 * half;
  if (tid == 0) *cnt = 0u;
  __syncthreads();
  unsigned target = 0u;
  for (int it = 0;; ++it) {
    if (tid == 0) nx[it & 1] = (unsigned)atomicAdd(p.ctr + l + 4 * rep, 1);
    HBAR();
    const int id = __builtin_amdgcn_readfirstlane((int)nx[it & 1]);
    if (id >= NA + NF + NC + ND) break;
    if (id < NA) attn_tile(l, id, cnt, target);
    else if (id < NA + NC) conv_tile(l, id - NA, cnt, target);
    else if (id < NA + NC + ND) sgu_tile(l, id - NA - NC, cnt, target);
    else fft_item(l, id - NA - NC - ND, cnt, target);
  }
}

#define LAS __attribute__((address_space(3)))
#define XB_TMO      128
#define XB_XCNT(j)  (256  + 64 * (j))
#define XB_XSUB(j)  (1280 + 64 * (j))
#define XB_XGEN(j)  (2304 + 64 * (j))
#define XB_TOP      3328
#define XB_TOPGEN   3392
#define XCD_BAR_WORDS 3456
#define XB_SPIN_CAP (1u << 18)

__device__ __forceinline__ unsigned xb_ld(unsigned* p)              { return __hip_atomic_load(p, __ATOMIC_RELAXED, __HIP_MEMORY_SCOPE_AGENT); }
__device__ __forceinline__ unsigned xb_add(unsigned* p, unsigned v) { return __hip_atomic_fetch_add(p, v, __ATOMIC_RELAXED, __HIP_MEMORY_SCOPE_AGENT); }
__device__ __forceinline__ unsigned xb_xcc_id() { return (unsigned)__builtin_amdgcn_s_getreg((3 << 11) | 20) & 0xFu; }
#define XB_SPIN(cond, bar) do { unsigned _sp = 0; while (cond) { __builtin_amdgcn_s_sleep(1); \
    if ((++_sp & 255u) == 0u) { if (xb_ld(&(bar)[XB_TMO])) break; if (_sp > XB_SPIN_CAP) { atomicAdd(&(bar)[XB_TMO], 1u); break; } } } } while (0)

struct XcdBarrier {
    unsigned* bar; unsigned x;
    volatile LAS unsigned* st;
};

__device__ __forceinline__ XcdBarrier xcd_barrier_post(unsigned* bar, volatile LAS unsigned* st) {
    XcdBarrier b; b.bar = bar; b.x = xb_xcc_id(); b.st = st;
    if (threadIdx.x == 0) (void)xb_add(&bar[XB_XCNT(b.x)], 1u);
    return b;
}
__device__ __forceinline__ void xcd_barrier_complete(unsigned* bar, unsigned x, unsigned& nloc, unsigned& nx) {
    const unsigned G = gridDim.x * gridDim.y * gridDim.z;
    unsigned sum, cnt, mine, sp = 0u;
    for (;;) {
        sum = 0u; cnt = 0u; mine = 0u;
#pragma unroll
        for (unsigned j = 0; j < 16; ++j) { const unsigned c = xb_ld(&bar[XB_XCNT(j)]); sum += c; cnt += (c > 0u) ? 1u : 0u; mine = (j == x) ? c : mine; }
        if (sum == G) break;
        __builtin_amdgcn_s_sleep(1);
        if ((++sp & 255u) == 0u) { if (xb_ld(&bar[XB_TMO])) break; if (sp > XB_SPIN_CAP) { atomicAdd(&bar[XB_TMO], 1u); break; } }
    }
    nloc = mine > 0u ? mine : 1u; nx = cnt > 0u ? cnt : 1u;
}

__device__ __forceinline__ void xcd_barrier(const XcdBarrier& b) {
    asm volatile("s_waitcnt vmcnt(0)" ::: "memory");
    __syncthreads();
    if (threadIdx.x == 0) {
        unsigned* bar = b.bar;
        __builtin_amdgcn_s_waitcnt(0);
        unsigned nloc = b.st[0], nx = b.st[1];
        if (nloc == 0u) { xcd_barrier_complete(bar, b.x, nloc, nx); b.st[0] = nloc; b.st[1] = nx; }
        const unsigned old = xb_add(&bar[XB_XSUB(b.x)], 1u);
        const unsigned gen = old / nloc;
        if (old + 1u == (gen + 1u) * nloc) {
            __builtin_amdgcn_fence(__ATOMIC_RELEASE, "agent");
            asm volatile("s_waitcnt vmcnt(0)" ::: "memory");
            const unsigned og = xb_add(&bar[XB_TOP], 1u);
            const unsigned tg = og / nx;
            if (og + 1u == (tg + 1u) * nx) xb_add(&bar[XB_TOPGEN], 1u);
            else XB_SPIN(xb_ld(&bar[XB_TOPGEN]) == tg, bar);
            __builtin_amdgcn_fence(__ATOMIC_ACQUIRE, "agent");
            xb_add(&bar[XB_XGEN(b.x)], 1u);
            asm volatile("s_waitcnt vmcnt(0)" ::: "memory");
        } else {
            XB_SPIN(xb_ld(&bar[XB_XGEN(b.x)]) == gen, bar);
            __builtin_amdgcn_fence(__ATOMIC_ACQUIRE, "agent");
            asm volatile("s_waitcnt vmcnt(0)" ::: "memory");
        }
    }
    __syncthreads();
}

constexpr int NPHASE = 2 + 5 * DEPTH;
__global__ void __launch_bounds__(512, 2) mk_fwd(Params p, int ph_lo, int ph_hi, int coop) {
  int rep = 0;
  volatile LAS unsigned* bst = (volatile LAS unsigned*)(LDSP + 2 * HALF_B + 16);
  if (otid() < 2) bst[otid()] = 0u;
  __syncthreads();
  XcdBarrier xbar = xcd_barrier_post(p.barw, bst);
  for (int ph = ph_lo; ph < ph_hi; ++ph) {
    if (ph == 0) {
      prep_phase();
      if (REP_PREP) { __syncthreads(); prep_phase(); }
    } else if (ph == NPHASE - 1) {
      final_rms_phase(p.xn, p.final_g, p.out);
    } else {
      const int l = (ph - 1) / 5, s = (ph - 1) % 5;
      if (s == 0) gemm_in_phase(l);
      else if (s == 1) mixer_phase(l, rep);
      else if (s == 2) gemm_out_phase(l, (REP_S == 2 && rep == 0) ? 0.f : 1.f);
      else if (s == 3) gemm_up_phase(l);
      else gemm_down_phase(l, (REP_S == 4 && rep == 0) ? 0.f : 1.f);
    }
    if (coop && ph + 1 < ph_hi) { if (ph == 0) cg::this_grid().sync(); else xcd_barrier(xbar); }
    if (coop && ph == 1) for (int i = 0; i < EXTRA_SYNCS; ++i) xcd_barrier(xbar);
    if (REP_S >= 0 && rep == 0 && ph >= 1 && ph < NPHASE - 1 && ((ph - 1) % 5) == REP_S) { rep = 1; --ph; } else rep = 0;
  }
}

extern "C" void kernel_launch(void* const* d_in, const int* in_sizes, int n_in, void* d_out, int out_size, void* d_ws, size_t ws_size, hipStream_t stream) {
  Params p{};
  const float** pf = (const float**)&p;
  for (int i = 0; i < 25; ++i) pf[i] = (const float*)d_in[i];
  p.out = (float*)d_out;
  unsigned char* w = (unsigned char*)d_ws;
  size_t off = 0;
  auto take = [&](size_t bytes) { unsigned char* r = w + off; off += (bytes + 255) & ~(size_t)255; return r; };
  p.WallT = (bf16_t*)take((size_t)DEPTH * WALL_N * DM * 2);
  p.WoutT = (bf16_t*)take((size_t)DEPTH * DM * DM * 2);
  p.WupT = (bf16_t*)take((size_t)DEPTH * DFF * DM * 2);
  p.WdownT = (bf16_t*)take((size_t)DEPTH * DFF * DM * 2);
  p.pwT = (bf16_t*)take((size_t)DEPTH * 65536 * 2);
  p.sguW = (bf16_t*)take((size_t)DEPTH * 4 * 16384 * 2);
  p.lam = (float*)take(256);
  unsigned char* ctl = take(16384);
  p.ctr = (int*)ctl;
  p.barw = (unsigned*)(ctl + 256);
  p.M1 = (bf16_t*)take(128 * 128 * 2);
  p.M3 = (bf16_t*)take(64 * 128 * 2);
  p.TW = (float*)take(4096 * 2 * 4);
  p.part = (float*)take((size_t)NTOK * 16 * 4);
  p.xn = (bf16_t*)take((size_t)NTOK * DM * 2);
  unsigned char* region = take((size_t)NTOK * DFF * 2);
  p.hid = (bf16_t*)region;
  p.h = (bf16_t*)region;
  p.Vt = (bf16_t*)(region + (size_t)NTOK * HC * 2);
  p.PQt = (bf16_t*)(region + (size_t)NTOK * HC * 2 + (size_t)NTOK * 256 * 2);
  p.y = (bf16_t*)(region + (size_t)NTOK * HC * 2 + (size_t)NTOK * 256 * 2 + (size_t)BATCH * 256 * 8192 * 2);
  if (off > ws_size) { fprintf(stderr, "workspace too small: need %zu have %zu\n", off, ws_size); return; }

  static int grid_blocks = 0;
  if (!grid_blocks) {
    int dev = 0, cus = 0, per_cu = 0;
    hipGetDevice(&dev);
    hipDeviceGetAttribute(&cus, hipDeviceAttributeMultiprocessorCount, dev);
    hipOccupancyMaxActiveBlocksPerMultiprocessor(&per_cu, mk_fwd, 512, 0);
    if (per_cu < 1) per_cu = 1;
    grid_blocks = cus * per_cu;
  }
  hipMemsetAsync(ctl, 0, 16384, stream);
#if MK_ONE_LAUNCH
  int lo = 0, hi = NPHASE, coop = 1;
  void* args[] = {&p, &lo, &hi, &coop};
  hipError_t e = hipLaunchCooperativeKernel((void*)mk_fwd, dim3(grid_blocks), dim3(512), args, 0, stream);
  if (e != hipSuccess) fprintf(stderr, "cooperative launch failed: %s (grid %d)\n", hipGetErrorString(e), grid_blocks);
#else
  for (int ph = 0; ph < NPHASE; ++ph) mk_fwd<<<grid_blocks, 512, 0, stream>>>(p, ph, ph + 1, 0);
#endif
}
```

```cpp
#include <hip/hip_runtime.h>
#include <hip/hip_cooperative_groups.h>
#include <cstdint>
#include <cstdio>
#include <cmath>
namespace cg = cooperative_groups;

#ifndef EXTRA_SYNCS
#define EXTRA_SYNCS 0
#endif
#ifndef REP_PREP
#define REP_PREP 0
#endif
#ifndef REP_S
#define REP_S -1
#endif
#ifndef MK_ONE_LAUNCH
#define MK_ONE_LAUNCH 1
#endif

#define DI __device__ __forceinline__
typedef unsigned short bf16_t;
typedef short bf16x8 __attribute__((ext_vector_type(8)));
typedef float f32x4 __attribute__((ext_vector_type(4)));
typedef float f32x16 __attribute__((ext_vector_type(16)));
typedef float f32x2 __attribute__((ext_vector_type(2)));
typedef __bf16 bf16x2v __attribute__((ext_vector_type(2)));
typedef unsigned u32x4 __attribute__((ext_vector_type(4)));
typedef unsigned u32x2 __attribute__((ext_vector_type(2)));

constexpr int BATCH = 8, SEQ = 4096, DM = 1024, DEPTH = 4, NTOK = BATCH * SEQ;
constexpr int HC = 1536;
constexpr int WALL_N = 2304;
constexpr int DFF = 4096;
constexpr float EPS = 1e-6f;
constexpr float LOG2E = 1.4426950408889634f;

DI unsigned pk2(float lo, float hi) { f32x2 v = {lo, hi}; bf16x2v b = __builtin_convertvector(v, bf16x2v); return __builtin_bit_cast(unsigned, b); }
DI float bflo(unsigned u) { return __uint_as_float(u << 16); }
DI float bfhi(unsigned u) { return __uint_as_float(u & 0xffff0000u); }
DI float bf2f(bf16_t u) { return __uint_as_float(((unsigned)u) << 16); }
template <int CTRL> DI float dppf(float v) { return __builtin_bit_cast(float, __builtin_amdgcn_update_dpp(0, __builtin_bit_cast(int, v), CTRL, 0xf, 0xf, true)); }
DI float xch32(float v, int x32) { return __builtin_bit_cast(float, __builtin_amdgcn_ds_bpermute(x32, __builtin_bit_cast(int, v))); }
DI float wave_sum(float v, int x32) {
  v += dppf<0xB1>(v); v += dppf<0x4E>(v); v += dppf<0x141>(v); v += dppf<0x140>(v);
  v += __builtin_bit_cast(float, __builtin_amdgcn_ds_swizzle(__builtin_bit_cast(int, v), 0x401f));
  v += xch32(v, x32);
  return v;
}

#define LAS3 __attribute__((address_space(3)))
DI void half_bar(LAS3 unsigned* cnt, unsigned& target, int lane) {
  asm volatile("s_waitcnt lgkmcnt(0)" ::: "memory");
  target += 4u;
  if (lane == 0) __hip_atomic_fetch_add(cnt, 1u, __ATOMIC_RELAXED, __HIP_MEMORY_SCOPE_WORKGROUP);
  while (__hip_atomic_load(cnt, __ATOMIC_RELAXED, __HIP_MEMORY_SCOPE_WORKGROUP) < target) __builtin_amdgcn_s_sleep(1);
  asm volatile("" ::: "memory");
}
#define HBAR() half_bar(cnt, target, lane)

struct Params {
  const float *x, *norm1_g, *w_in, *lam_q1, *lam_k1, *lam_q2, *lam_k2, *subln_g, *conv_dw_w, *conv_dw_b, *conv_ln_g, *conv_ln_b,
      *conv_pw_w, *conv_pw_b, *fnet_w, *fnet_b, *sgu_ln_g, *sgu_ln_b, *sgu_w, *sgu_b, *w_out, *norm2_g, *w_up, *w_down, *final_g;
  float* out;
  bf16_t *WallT, *WoutT, *WupT, *WdownT, *pwT, *sguW, *M1, *M3, *xn, *h, *Vt, *PQt, *y, *hid;
  float* lam;
  float* TW;
  float* part;
  int* ctr;
  unsigned* barw;
};

constexpr int HALF_B = 72960;
constexpr int SMEM_BYTES = 2 * HALF_B + 256;
constexpr int HALF_E = HALF_B / 2;
__shared__ __attribute__((aligned(16))) unsigned char smem_raw[SMEM_BYTES];
#define SMEM ((bf16_t*)smem_raw)
#define NI __device__ __forceinline__
DI int otid() { int t = threadIdx.x; asm volatile("" : "+v"(t)); return t; }
#define KPARAMS const Params& p = *(const Params*)__builtin_amdgcn_kernarg_segment_ptr()

namespace pg8 {
#define PG8_LAS __attribute__((address_space(3)))
typedef unsigned short bf16_t;
typedef short bf16x8 __attribute__((ext_vector_type(8)));
typedef float f32x4 __attribute__((ext_vector_type(4)));
typedef unsigned u32x4 __attribute__((ext_vector_type(4)));
constexpr int BM = 256, BK = 64, HALF = 128, HTB = HALF * BK * 2  , STAGE_BYTES = 8 * HTB, NXCD = 8, WGM = 8;

__host__ __device__ __forceinline__ int lds_byte(int r, int c) { const int st = (r >> 4) * 2 + (c >> 5), rr = r & 15, cc = c & 31, ob = rr * 64 + cc * 2; return st * 1024 + (ob ^ (((ob >> 9) & 1) << 5)); }
__host__ __device__ __forceinline__ void stage_rc(int b, int& R, int& C) { const int st = b / 1024, sb = b % 1024, swz = sb ^ (((sb >> 9) & 1) << 5); R = (st >> 1) * 16 + swz / 64; C = (st & 1) * 32 + (swz % 64) / 2; }
__host__ __device__ __forceinline__ int perm32(int rho) { const int n = rho >> 4, i = rho & 15; return 8 * (i >> 2) + 4 * n + (i & 3); }

struct Unit { int pm, pn; };
struct Gemm { const bf16_t* A; const bf16_t* Bt; int M, N, K; };

struct StaticOrder {
    int nM, nN, nwg, G, c;
    __host__ __device__ void init(int M, int N, int G_, int c_) { nM = M / BM; nN = N / BM; nwg = nM * nN; G = G_; c = c_; }
    __host__ __device__ bool next(int i, Unit& u) const {
        const long L = (long)i * G + c; if (L >= nwg) return false;
        int wgid = (int)L; { const int q = nwg / NXCD, r = nwg % NXCD, xcd = wgid % NXCD, off = wgid / NXCD; wgid = (xcd < r ? xcd * (q + 1) : r * (q + 1) + (xcd - r) * q) + off; }
        const int nig = WGM * nN, gid = wgid / nig, fm = gid * WGM, gsz = (nM - fm) < WGM ? (nM - fm) : WGM;
        u.pm = fm + ((wgid % nig) % gsz); u.pn = (wgid % nig) / gsz; return true;
    }
    __device__ __forceinline__ void a_ready(const Unit&) const {}
    __device__ __forceinline__ void done(const Unit&) const {}
};
template <class Epi, class Sched, bool ALIGN_EPI = false, bool SP2 = false>
__device__ __forceinline__ void gemm_phase(PG8_LAS unsigned char* lds, const Gemm g, const Sched& S, const Epi& E) {
    const int tid = otid(), wid = __builtin_amdgcn_readfirstlane(tid >> 6), lane = tid & 63, wr = wid >> 2, wc = wid & 3, fr = lane & 15, fq = lane >> 4;
    const int K = g.K, nt = K / BK;
    unsigned voffA[2], voffB[2];
#pragma unroll
    for (int i = 0; i < 2; ++i) { int R, C; stage_rc(tid * 16 + i * 8192, R, C); const int Rb = Epi::PERM ? ((R & ~31) + perm32(R & 31)) : R;
        voffA[i] = (unsigned)(R * K + C) * 2u; voffB[i] = (unsigned)(Rb * K + C) * 2u; }
    const size_t kstep = (size_t)(BK * 2);
    const size_t hstep = (size_t)HALF * K * 2;
    const size_t tstep = 2 * hstep;
    const unsigned ldsw = (unsigned)wid * 1024u;
    const int aoff = lds_byte(wr * 64 + fr, fq * 8), boff = lds_byte(wc * 32 + fr, fq * 8);
#define PG8_SA(b, h) (((b) * 2 + (h)) * HTB)
#define PG8_SB(b, h) ((4 + (b) * 2 + (h)) * HTB)
#define PG8_STAGE(bufoff, gbase, voff) do { _Pragma("unroll") for (int _i = 0; _i < 2; ++_i) \
        __builtin_amdgcn_global_load_lds((const unsigned*)((const char*)(gbase) + (voff)[_i]), (PG8_LAS unsigned*)(lds + (bufoff) + ldsw + _i * 8192), 16, 0, 0); } while (0)
#define PG8_LDA(dst, b, h) do { _Pragma("unroll") for (int m = 0; m < 4; ++m) _Pragma("unroll") for (int k = 0; k < 2; ++k) dst[m][k] = *(const PG8_LAS bf16x8*)(lds + PG8_SA(b, h) + aoff + m * 2048 + k * 1024); } while (0)
#define PG8_LDB(dst, b, h) do { _Pragma("unroll") for (int n = 0; n < 2; ++n) _Pragma("unroll") for (int k = 0; k < 2; ++k) dst[n][k] = *(const PG8_LAS bf16x8*)(lds + PG8_SB(b, h) + boff + n * 2048 + k * 1024); } while (0)
#define PG8_MMA(ai, bj, At, Bt) do { __builtin_amdgcn_s_setprio(1); _Pragma("unroll") for (int m = 0; m < 4; ++m) _Pragma("unroll") for (int n = 0; n < 2; ++n) _Pragma("unroll") for (int k = 0; k < 2; ++k) \
        acc[ai][bj][m][n] = __builtin_amdgcn_mfma_f32_16x16x32_bf16(Bt[n][k], At[m][k], acc[ai][bj][m][n], 0, 0, 0); __builtin_amdgcn_s_setprio(0); } while (0)
#define PG8_WAIT_V(n) asm volatile("s_waitcnt vmcnt(" #n ")" ::: "memory")
#define PG8_WAIT_L(n) asm volatile("s_waitcnt lgkmcnt(" #n ")" ::: "memory")
#define PG8_BAR __builtin_amdgcn_s_barrier()
#define PG8_SCHED __builtin_amdgcn_sched_barrier(0)
    Unit cur, nxt; int ui = 0;
    if (!S.next(0, cur)) return;
    f32x4 acc[2][2][4][2];
#pragma unroll
    for (int a = 0; a < 2; ++a)
#pragma unroll
        for (int b = 0; b < 2; ++b)
#pragma unroll
            for (int m = 0; m < 4; ++m)
#pragma unroll
                for (int n = 0; n < 2; ++n) acc[a][b][m][n] = (f32x4){0.f, 0.f, 0.f, 0.f};
    bf16x8 At[4][2], B0[2][2], B1[2][2];
    const char* cA = (const char*)g.A + (size_t)cur.pm * tstep; const char* cB = (const char*)g.Bt + (size_t)cur.pn * tstep;
    S.a_ready(cur);
    if constexpr (SP2) {
        PG8_STAGE(PG8_SB(0, 0), cB, voffB); PG8_STAGE(PG8_SB(0, 1), cB + hstep, voffB); PG8_STAGE(PG8_SA(0, 0), cA, voffA); PG8_STAGE(PG8_SA(0, 1), cA + hstep, voffA);
        if (wr == 1) PG8_BAR;
        PG8_WAIT_V(2); PG8_BAR;
        PG8_STAGE(PG8_SB(1, 0), cB + kstep, voffB); PG8_STAGE(PG8_SA(1, 0), cA + kstep, voffA); PG8_STAGE(PG8_SB(1, 1), cB + hstep + kstep, voffB);
        PG8_WAIT_V(6); PG8_BAR;
    } else {
        PG8_STAGE(PG8_SB(0, 0), cB, voffB); PG8_STAGE(PG8_SA(0, 0), cA, voffA); PG8_STAGE(PG8_SB(0, 1), cB + hstep, voffB); PG8_STAGE(PG8_SA(0, 1), cA + hstep, voffA);
        if (wr == 1) PG8_BAR;
        PG8_WAIT_V(4); PG8_BAR;
        PG8_STAGE(PG8_SB(1, 0), cB + kstep, voffB); PG8_STAGE(PG8_SA(1, 0), cA + kstep, voffA); PG8_STAGE(PG8_SB(1, 1), cB + hstep + kstep, voffB);
        PG8_WAIT_V(6); PG8_BAR;
    }
    for (;;) {
        const bool has_next = S.next(ui + 1, nxt);
        const char* nA = has_next ? (const char*)g.A + (size_t)nxt.pm * tstep : cA; const char* nB = has_next ? (const char*)g.Bt + (size_t)nxt.pn * tstep : cB;
        for (int t = 0; t < nt; t += 2) {
            const bool last = (t == nt - 2);
            const char* a1 = cA + (size_t)(t + 1) * kstep;
            const char* a2 = last ? nA : cA + (size_t)(t + 2) * kstep; const char* b2 = last ? nB : cB + (size_t)(t + 2) * kstep;
            const char* a3 = a2 + kstep; const char* b3 = b2 + kstep;
            if (last && has_next) S.a_ready(nxt);
            if constexpr (SP2) {
            PG8_LDB(B0, 0, 0); PG8_LDB(B1, 0, 1); PG8_SCHED; PG8_LDA(At, 0, 0); PG8_STAGE(PG8_SA(1, 1), a1 + hstep, voffA);
            PG8_WAIT_V(8); PG8_WAIT_L(0); PG8_BAR; PG8_MMA(0, 0, At, B0); PG8_MMA(0, 1, At, B1); PG8_BAR; PG8_SCHED;
            PG8_LDA(At, 0, 1); PG8_STAGE(PG8_SB(0, 0), b2, voffB); PG8_STAGE(PG8_SB(0, 1), b2 + hstep, voffB); PG8_STAGE(PG8_SA(0, 0), a2, voffA);
            PG8_WAIT_V(8); PG8_WAIT_L(0); PG8_BAR; PG8_MMA(1, 0, At, B0); PG8_MMA(1, 1, At, B1); PG8_BAR; PG8_SCHED;
            PG8_LDB(B0, 1, 0); PG8_LDB(B1, 1, 1); PG8_SCHED; PG8_LDA(At, 1, 0); PG8_STAGE(PG8_SA(0, 1), a2 + hstep, voffA);
            PG8_WAIT_V(8); PG8_WAIT_L(0); PG8_BAR; PG8_MMA(0, 0, At, B0); PG8_MMA(0, 1, At, B1); PG8_BAR; PG8_SCHED;
            PG8_LDA(At, 1, 1); PG8_STAGE(PG8_SB(1, 0), b3, voffB); PG8_STAGE(PG8_SB(1, 1), b3 + hstep, voffB); PG8_STAGE(PG8_SA(1, 0), a3, voffA);
            PG8_WAIT_V(8); PG8_WAIT_L(0); PG8_BAR; PG8_MMA(1, 0, At, B0); PG8_MMA(1, 1, At, B1); PG8_BAR; PG8_SCHED;
            } else {
            PG8_LDB(B0, 0, 0); PG8_SCHED; PG8_LDA(At, 0, 0); PG8_STAGE(PG8_SA(1, 1), a1 + hstep, voffA);
            PG8_WAIT_L(8); PG8_BAR; PG8_WAIT_L(0); PG8_MMA(0, 0, At, B0); PG8_BAR; PG8_SCHED;
            PG8_LDB(B1, 0, 1); PG8_STAGE(PG8_SB(0, 0), b2, voffB);
            PG8_BAR; PG8_WAIT_L(0); PG8_MMA(0, 1, At, B1); PG8_BAR;
            PG8_LDA(At, 0, 1); PG8_STAGE(PG8_SA(0, 0), a2, voffA);
            PG8_BAR; PG8_WAIT_L(0); PG8_MMA(1, 0, At, B0); PG8_BAR; PG8_SCHED;
            PG8_STAGE(PG8_SB(0, 1), b2 + hstep, voffB);
            PG8_WAIT_V(6); PG8_BAR; PG8_MMA(1, 1, At, B1); PG8_BAR;
            PG8_LDB(B0, 1, 0); PG8_SCHED; PG8_LDA(At, 1, 0); PG8_STAGE(PG8_SA(0, 1), a2 + hstep, voffA);
            PG8_WAIT_L(8); PG8_BAR; PG8_WAIT_L(0); PG8_MMA(0, 0, At, B0); PG8_BAR; PG8_SCHED;
            PG8_LDB(B1, 1, 1); PG8_STAGE(PG8_SB(1, 0), b3, voffB);
            PG8_BAR; PG8_WAIT_L(0); PG8_MMA(0, 1, At, B1); PG8_BAR;
            PG8_LDA(At, 1, 1); PG8_STAGE(PG8_SA(1, 0), a3, voffA);
            PG8_BAR; PG8_WAIT_L(0); PG8_MMA(1, 0, At, B0); PG8_BAR; PG8_SCHED;
            PG8_STAGE(PG8_SB(1, 1), b3 + hstep, voffB);
            PG8_WAIT_V(6); PG8_BAR; PG8_MMA(1, 1, At, B1); PG8_BAR;
            }
        }
        if constexpr (ALIGN_EPI) { if (wr == 0) PG8_BAR; }
        if constexpr (!Epi::AFTER_DRAIN) { E(acc, cur, wr, wc, fr, fq); S.done(cur); }
        if (!has_next) break;
#pragma unroll
        for (int a = 0; a < 2; ++a)
#pragma unroll
            for (int b = 0; b < 2; ++b)
#pragma unroll
                for (int m = 0; m < 4; ++m)
#pragma unroll
                    for (int n = 0; n < 2; ++n) acc[a][b][m][n] = (f32x4){0.f, 0.f, 0.f, 0.f};
        cur = nxt; cA = nA; cB = nB; ++ui;
        if constexpr (ALIGN_EPI) { if (wr == 1) PG8_BAR; }
    }
    PG8_WAIT_V(0);
    if constexpr (!ALIGN_EPI) { if (wr == 0) PG8_BAR; }
    PG8_BAR;
    if constexpr (Epi::AFTER_DRAIN) { E.fused(acc, cur, wr, wc, fr, fq, lds, wid, lane); S.done(cur); }
#undef PG8_SA
#undef PG8_SB
#undef PG8_STAGE
#undef PG8_LDA
#undef PG8_LDB
#undef PG8_MMA
#undef PG8_WAIT_V
#undef PG8_WAIT_L
#undef PG8_BAR
#undef PG8_SCHED
}
}

template <class F> struct Epi8 {
  static constexpr bool PERM = true, AFTER_DRAIN = false;
  F f;
  DI void operator()(const pg8::f32x4 (&acc)[2][2][4][2], const pg8::Unit& u, int wr, int wc, int fr, int fq) const {
#pragma unroll
    for (int ai = 0; ai < 2; ++ai)
#pragma unroll
      for (int m = 0; m < 4; ++m) {
        const int row = u.pm * 256 + ai * 128 + wr * 64 + m * 16 + fr;
#pragma unroll
        for (int bj = 0; bj < 2; ++bj) f.st(row, u.pn * 256 + bj * 128 + wc * 32 + 8 * fq, acc[ai][bj][m][0], acc[ai][bj][m][1]);
      }
  }
};
#define LDSP ((__attribute__((address_space(3))) unsigned char*)smem_raw)
DI float row_rs(const float* __restrict__ part, int row) {
  const f32x4 a = *(const f32x4*)(part + (long)row * 16), b = *(const f32x4*)(part + (long)row * 16 + 4), c = *(const f32x4*)(part + (long)row * 16 + 8), d = *(const f32x4*)(part + (long)row * 16 + 12);
  const f32x4 s = (a + b) + (c + d);
  return rsqrtf(((s[0] + s[1]) + (s[2] + s[3])) * (1.f / 1024.f) + EPS);
}
template <class F> struct Epi8Rows {
  static constexpr bool PERM = true, AFTER_DRAIN = false;
  F f; const float* part;
  DI void operator()(const pg8::f32x4 (&acc)[2][2][4][2], const pg8::Unit& u, int wr, int wc, int fr, int fq) const {
    const int x32 = (((fq * 16 + fr) ^ 32) << 2);
#pragma unroll
    for (int ai = 0; ai < 2; ++ai)
#pragma unroll
      for (int m = 0; m < 4; ++m) {
        const int row = u.pm * 256 + ai * 128 + wr * 64 + m * 16 + fr;
        const f32x4 pp = *(const f32x4*)(part + (long)row * 16 + fq * 4);
        float sq = (pp[0] + pp[1]) + (pp[2] + pp[3]);
        sq += __builtin_bit_cast(float, __builtin_amdgcn_ds_swizzle(__builtin_bit_cast(int, sq), 0x401f));
        sq += xch32(sq, x32);
        const float rs = rsqrtf(sq * (1.f / 1024.f) + EPS);
#pragma unroll
        for (int bj = 0; bj < 2; ++bj) f.st(row, u.pn * 256 + bj * 128 + wc * 32 + 8 * fq, acc[ai][bj][m][0] * rs, acc[ai][bj][m][1] * rs);
      }
  }
};
template <class F> struct Epi8Cols {
  static constexpr bool PERM = true, AFTER_DRAIN = false;
  F f; const float* part;
  DI void operator()(const pg8::f32x4 (&acc)[2][2][4][2], const pg8::Unit& u, int wr, int wc, int fr, int fq) const {
    f32x4 r0[2], r1[2];
    const float rsl = row_rs(part, u.pn * 256 + (fr >> 3) * 128 + wc * 32 + 8 * fq + (fr & 7));
#pragma unroll
    for (int bj = 0; bj < 2; ++bj)
#pragma unroll
      for (int j = 0; j < 4; ++j) {
        r0[bj][j] = __builtin_bit_cast(float, __builtin_amdgcn_ds_bpermute(4 * (fq * 16 + bj * 8 + j), __builtin_bit_cast(int, rsl)));
        r1[bj][j] = __builtin_bit_cast(float, __builtin_amdgcn_ds_bpermute(4 * (fq * 16 + bj * 8 + 4 + j), __builtin_bit_cast(int, rsl)));
      }
#pragma unroll
    for (int ai = 0; ai < 2; ++ai)
#pragma unroll
      for (int m = 0; m < 4; ++m) {
        const int row = u.pm * 256 + ai * 128 + wr * 64 + m * 16 + fr;
#pragma unroll
        for (int bj = 0; bj < 2; ++bj) f.st(row, u.pn * 256 + bj * 128 + wc * 32 + 8 * fq, acc[ai][bj][m][0] * r0[bj], acc[ai][bj][m][1] * r1[bj]);
      }
  }
};
struct Epi8Res {
  static constexpr bool PERM = true, AFTER_DRAIN = false;
  bf16_t* xb; float* part; float accscale;
  DI void operator()(const pg8::f32x4 (&acc)[2][2][4][2], const pg8::Unit& u, int wr, int wc, int fr, int fq) const {
    const int x32 = (((fq * 16 + fr) ^ 32) << 2);
#pragma unroll
    for (int ai = 0; ai < 2; ++ai)
#pragma unroll
      for (int m = 0; m < 4; ++m) {
        const int row = u.pm * 256 + ai * 128 + wr * 64 + m * 16 + fr;
        float ss = 0.f;
#pragma unroll
        for (int bj = 0; bj < 2; ++bj) {
          const long o = (long)row * DM + u.pn * 256 + bj * 128 + wc * 32 + 8 * fq;
          const u32x4 xr = *(const u32x4*)(xb + o);
          f32x4 v0, v1;
          v0[0] = bflo(xr[0]); v0[1] = bfhi(xr[0]); v0[2] = bflo(xr[1]); v0[3] = bfhi(xr[1]);
          v1[0] = bflo(xr[2]); v1[1] = bfhi(xr[2]); v1[2] = bflo(xr[3]); v1[3] = bfhi(xr[3]);
          v0 = v0 + acc[ai][bj][m][0] * accscale; v1 = v1 + acc[ai][bj][m][1] * accscale;
          u32x4 w; w[0] = pk2(v0[0], v0[1]); w[1] = pk2(v0[2], v0[3]); w[2] = pk2(v1[0], v1[1]); w[3] = pk2(v1[2], v1[3]);
          *(u32x4*)(xb + o) = w;
          ss += (v0[0] * v0[0] + v0[1] * v0[1]) + (v0[2] * v0[2] + v0[3] * v0[3]) + (v1[0] * v1[0] + v1[1] * v1[1]) + (v1[2] * v1[2] + v1[3] * v1[3]);
        }
        ss += __builtin_bit_cast(float, __builtin_amdgcn_ds_swizzle(__builtin_bit_cast(int, ss), 0x401f));
        ss += xch32(ss, x32);
        if (fq == 0) part[(long)row * 16 + u.pn * 4 + wc] = ss;
      }
  }
};
template <class E> DI void run_gemm_e(const bf16_t* A, const bf16_t* Bt, int M, int N, int K, const E& e) {
  pg8::Gemm g{A, Bt, M, N, K};
  pg8::StaticOrder so; so.init(M, N, (int)gridDim.x, (int)blockIdx.x);
  pg8::gemm_phase<E, pg8::StaticOrder, true, true>(LDSP, g, so, e);
}
template <class F> DI void run_gemm(const bf16_t* A, const bf16_t* Bt, int M, int N, int K, const F& f) {
  pg8::Gemm g{A, Bt, M, N, K};
  pg8::StaticOrder so; so.init(M, N, (int)gridDim.x, (int)blockIdx.x);
  Epi8<F> e{f};
  pg8::gemm_phase<Epi8<F>, pg8::StaticOrder, true, true>(LDSP, g, so, e);
}
struct OneUnit { int pm, pn;
  DI bool next(int i, pg8::Unit& u) const { if (i) return false; u.pm = pm; u.pn = pn; return true; }
  DI void a_ready(const pg8::Unit&) const {}
  DI void done(const pg8::Unit&) const {} };

DI void tr_tile(const float* __restrict__ src, int lds_, int k0, int n0, bf16_t* __restrict__ dst, int ldd, int nd0, float scale, float* sm, const float* __restrict__ gk = nullptr) {
  const int t = otid() & 255;
  f32x4 v[8];
#pragma unroll
  for (int i = 0; i < 8; ++i) {
    const int kr = (t >> 4) + 16 * i, nc = (t & 15) * 4;
    v[i] = *(const f32x4*)(src + (long)(k0 + kr) * lds_ + n0 + nc);
    if (gk) v[i] = v[i] * gk[k0 + kr];
  }
#pragma unroll
  for (int i = 0; i < 8; ++i) {
    const int kr = (t >> 4) + 16 * i, nc = (t & 15) * 4;
    sm[kr * 65 + nc + 0] = v[i][0]; sm[kr * 65 + nc + 1] = v[i][1]; sm[kr * 65 + nc + 2] = v[i][2]; sm[kr * 65 + nc + 3] = v[i][3];
  }
  __syncthreads();
  const int n = t >> 2, ks = (t & 3) * 32;
  bf16_t* d = dst + (long)(nd0 + n) * ldd + k0 + ks;
#pragma unroll
  for (int q = 0; q < 4; ++q) {
    u32x4 w;
#pragma unroll
    for (int j = 0; j < 4; ++j) w[j] = pk2(sm[(ks + 8 * q + 2 * j) * 65 + n] * scale, sm[(ks + 8 * q + 2 * j + 1) * 65 + n] * scale);
    *(u32x4*)(d + 8 * q) = w;
  }
  __syncthreads();
}

constexpr int NT_ALL = DEPTH * 28 * 8, NT_OUT = DEPTH * 16 * 8, NT_UP = DEPTH * 64 * 8, NT_DOWN = DEPTH * 16 * 32, NT_PW = DEPTH * 4 * 2;
constexpr int N_FOLD = DEPTH * 2 * 4 * 4, N_SGU = 128, N_DM = 112, N_LAM = 1;
constexpr int PREP_ITEMS = NT_ALL + NT_OUT + NT_UP + NT_DOWN + NT_PW + N_FOLD + N_SGU + N_DM + N_LAM;

DI void prep_item(const Params& p, int it, float* sm) {
  const int t = otid() & 255;
  if (it < NT_ALL) {
    const int l = it / (28 * 8), rem = it % (28 * 8), nt = rem / 8, kt = rem % 8;
    const int nd = nt * 64;
    int nsrc; float scale = 1.f;
    if (nd < 512) { nsrc = nd; if (nd < 256) scale = 0.17677669529663687f * LOG2E; }
    else if (nd < 1024) nsrc = 768 + (nd - 512);
    else if (nd < 1536) nsrc = 1536 + (nd - 1024);
    else nsrc = 512 + (nd - 1536);
    tr_tile(p.w_in + (long)l * DM * 2048, 2048, kt * 128, nsrc, p.WallT + (long)l * WALL_N * DM, DM, nd, scale, sm, p.norm1_g + l * DM);
    return;
  }
  it -= NT_ALL;
  if (it < NT_OUT) {
    const int l = it / 128, rem = it % 128, nt = rem / 8, kt = rem % 8;
    tr_tile(p.w_out + (long)l * DM * DM, DM, kt * 128, nt * 64, p.WoutT + (long)l * DM * DM, DM, nt * 64, 1.f, sm);
    return;
  }
  it -= NT_OUT;
  if (it < NT_UP) {
    const int l = it / 512, rem = it % 512, nt = rem / 8, kt = rem % 8;
    tr_tile(p.w_up + (long)l * DM * DFF, DFF, kt * 128, nt * 64, p.WupT + (long)l * DFF * DM, DM, nt * 64, 1.f, sm, p.norm2_g + l * DM);
    return;
  }
  it -= NT_UP;
  if (it < NT_DOWN) {
    const int l = it / 512, rem = it % 512, nt = rem / 32, kt = rem % 32;
    tr_tile(p.w_down + (long)l * DFF * DM, DM, kt * 128, nt * 64, p.WdownT + (long)l * DM * DFF, DFF, nt * 64, 1.f, sm);
    return;
  }
  it -= NT_DOWN;
  if (it < NT_PW) {
    const int l = it / 8, rem = it % 8, nt = rem / 2, kt = rem % 2;
    tr_tile(p.conv_pw_w + (long)l * 65536, 256, kt * 128, nt * 64, p.pwT + (long)l * 65536, 256, nt * 64, 1.f, sm);
    return;
  }
  it -= NT_PW;
  if (it < N_FOLD) {
    const int l = it >> 5, pq = (it >> 4) & 1, g = (it >> 2) & 3, kcn = it & 3;
    const float* fw = p.fnet_w + ((long)l * 4 + g) * 4096;
    float* trig = sm + 4096;
    if (t < 64) trig[t] = pq ? sinpif((float)t * (1.f / 32.f)) : cospif((float)t * (1.f / 32.f));
    __syncthreads();
    for (int idx = t; idx < 4096; idx += 256) {
      const int c = idx >> 6, e = idx & 63;
      float s = 0.f;
      for (int kc = 0; kc < 64; ++kc) s += trig[(c * kc) & 63] * fw[kc * 64 + e];
      sm[idx] = s * (1.f / 512.f);
    }
    __syncthreads();
    const int k = kcn * 256 + t;
    const float gk1 = p.norm1_g[l * DM + k];
    const float* wr = p.w_in + (long)l * DM * 2048 + (long)k * 2048 + 1280 + g * 64;
    f32x4 wv[16];
#pragma unroll
    for (int i = 0; i < 16; ++i) wv[i] = *(const f32x4*)(wr + 4 * i);
    bf16_t* dst = p.WallT + (long)l * WALL_N * DM + (long)(1792 + pq * 256 + g * 64) * DM + k;
#pragma unroll 1
    for (int e = 0; e < 64; ++e) {
      float s = 0.f;
#pragma unroll
      for (int i = 0; i < 16; ++i) {
        s += wv[i][0] * sm[(4 * i + 0) * 64 + e]; s += wv[i][1] * sm[(4 * i + 1) * 64 + e];
        s += wv[i][2] * sm[(4 * i + 2) * 64 + e]; s += wv[i][3] * sm[(4 * i + 3) * 64 + e];
      }
      dst[(long)e * DM] = (bf16_t)(pk2(s * gk1, 0.f) & 0xffffu);
    }
    __syncthreads();
    return;
  }
  it -= N_FOLD;
  if (it < N_SGU) {
    const long o = (long)it * 2048 + t * 8;
    const f32x4 a = *(const f32x4*)(p.sgu_w + o), b = *(const f32x4*)(p.sgu_w + o + 4);
    u32x4 w; w[0] = pk2(a[0], a[1]); w[1] = pk2(a[2], a[3]); w[2] = pk2(b[0], b[1]); w[3] = pk2(b[2], b[3]);
    *(u32x4*)(p.sguW + o) = w;
    return;
  }
  it -= N_SGU;
  if (it < N_DM) {
    const int e = it * 256 + t;
    if (e < 16384) {
      const int m = e >> 7, k = e & 127, ro = m >> 6, k1 = m & 63, ri = k >> 6, s1 = k & 63;
      const float ang = (float)((s1 * k1) & 63) * (1.f / 32.f);
      const float c = cospif(ang), sn = sinpif(ang);
      const float v = (ro == 0) ? (ri == 0 ? c : -sn) : (ri == 0 ? sn : c);
      p.M1[e] = (bf16_t)(pk2(v, 0.f) & 0xffffu);
    } else if (e < 16384 + 8192) {
      const int e2 = e - 16384, k2 = e2 >> 7, k = e2 & 127, ri = k >> 6, s2 = k & 63;
      const float ang = (float)((s2 * k2) & 63) * (1.f / 32.f);
      const float v = (ri == 0) ? cospif(ang) : -sinpif(ang);
      p.M3[e2] = (bf16_t)(pk2(v, 0.f) & 0xffffu);
    } else {
      const int e3 = e - 16384 - 8192, k1 = e3 >> 6, s2 = e3 & 63;
      const float ang = (float)(s2 * k1) * (1.f / 2048.f);
      ((unsigned*)p.TW)[e3] = pk2(cospif(ang), sinpif(ang));
    }
    return;
  }
  it -= N_DM;
  if (t < DEPTH) {
    const int l = t;
    float s1 = 0.f, s2 = 0.f;
    for (int i = 0; i < 32; ++i) { s1 += p.lam_q1[l * 32 + i] * p.lam_k1[l * 32 + i]; s2 += p.lam_q2[l * 32 + i] * p.lam_k2[l * 32 + i]; }
    const float lam_init = 0.8f - 0.6f * expf(-0.3f * (float)l);
    p.lam[l] = expf(s1) - expf(s2) + lam_init;
  }
}

NI void prep_phase() {
  KPARAMS;
  const int half = otid() >> 8;
  float* sm = (float*)smem_raw + half * (HALF_E / 2);
  for (int it0 = blockIdx.x * 2 + half; it0 < PREP_ITEMS; it0 += gridDim.x * 2) prep_item(p, it0, sm);
  const int tid_ = otid(); const int lane = tid_ & 63, wid = tid_ >> 6, x32 = ((lane ^ 32) << 2);
  for (int row0 = blockIdx.x * 8 + wid; row0 < NTOK; row0 += gridDim.x * 16) {
    f32x4 v[2][4];
#pragma unroll
    for (int rr = 0; rr < 2; ++rr) {
      const int row = row0 + rr * gridDim.x * 8;
#pragma unroll
      for (int i = 0; i < 4; ++i) v[rr][i] = (row < NTOK) ? *(const f32x4*)(p.x + (long)row * DM + lane * 4 + 256 * i) : (f32x4){0.f, 0.f, 0.f, 0.f};
    }
#pragma unroll
    for (int rr = 0; rr < 2; ++rr) {
      const int row = row0 + rr * gridDim.x * 8;
      float ss = 0.f;
#pragma unroll
      for (int i = 0; i < 4; ++i) ss += v[rr][i][0] * v[rr][i][0] + v[rr][i][1] * v[rr][i][1] + v[rr][i][2] * v[rr][i][2] + v[rr][i][3] * v[rr][i][3];
      ss = wave_sum(ss, x32);
      if (row < NTOK) {
#pragma unroll
        for (int i = 0; i < 4; ++i) { u32x2 w; w[0] = pk2(v[rr][i][0], v[rr][i][1]); w[1] = pk2(v[rr][i][2], v[rr][i][3]); *(u32x2*)(p.xn + (long)row * DM + lane * 4 + 256 * i) = w; }
        if (lane < 16) p.part[(long)row * 16 + lane] = (lane == 0) ? ss : 0.f;
      }
    }
  }
}

NI void final_rms_phase(const bf16_t* __restrict__ src, const float* __restrict__ g, float* __restrict__ dstf) {
  const int tid_ = otid(); const int lane = tid_ & 63, wid = tid_ >> 6, x32 = ((lane ^ 32) << 2);
  f32x4 gv[4];
#pragma unroll
  for (int i = 0; i < 4; ++i) gv[i] = *(const f32x4*)(g + lane * 4 + 256 * i);
  for (int row = blockIdx.x * 8 + wid; row < NTOK; row += gridDim.x * 8) {
    f32x4 v[4];
    float ss = 0.f;
#pragma unroll
    for (int i = 0; i < 4; ++i) {
      const u32x2 r = *(const u32x2*)(src + (long)row * DM + lane * 4 + 256 * i);
      v[i][0] = bflo(r[0]); v[i][1] = bfhi(r[0]); v[i][2] = bflo(r[1]); v[i][3] = bfhi(r[1]);
      ss += v[i][0] * v[i][0] + v[i][1] * v[i][1] + v[i][2] * v[i][2] + v[i][3] * v[i][3];
    }
    ss = wave_sum(ss, x32);
    const float rs = rsqrtf(ss * (1.f / 1024.f) + EPS);
#pragma unroll
    for (int i = 0; i < 4; ++i) *(f32x4*)(dstf + (long)row * DM + lane * 4 + 256 * i) = v[i] * rs * gv[i];
  }
}

DI u32x4 pk8(f32x4 a, f32x4 b) { u32x4 w; w[0] = pk2(a[0], a[1]); w[1] = pk2(a[2], a[3]); w[2] = pk2(b[0], b[1]); w[3] = pk2(b[2], b[3]); return w; }
struct StH { bf16_t* h; DI void st(int r, int c, f32x4 a, f32x4 b) const { *(u32x4*)(h + (long)r * HC + c) = pk8(a, b); } };
struct StT { bf16_t* Vt; bf16_t* PQt;
  DI void st(int n, int tok, f32x4 a, f32x4 b) const {
    const int bb = tok >> 12, s = tok & 4095; const u32x4 w = pk8(a, b);
    if (n < 256) *(u32x4*)(Vt + ((long)(bb * 256 + n)) * 4096 + s) = w;
    else { const int np = n - 256, pq = np >> 8, ch = np & 255; *(u32x4*)(PQt + ((long)(bb * 256 + ch)) * 8192 + pq * 4096 + s) = w; }
  } };
struct StRes { const float* xin; float* out;
  DI void st(int r, int c, f32x4 a, f32x4 b) const { const long o = (long)r * DM + c; const f32x4 x0 = *(const f32x4*)(xin + o), x1 = *(const f32x4*)(xin + o + 4); *(f32x4*)(out + o) = x0 + a; *(f32x4*)(out + o + 4) = x1 + b; } };
struct StUp { bf16_t* hid;
  DI void st(int r, int c, f32x4 a, f32x4 b) const {
#pragma unroll
    for (int j = 0; j < 4; ++j) { a[j] = fmaxf(a[j], 0.f); b[j] = fmaxf(b[j], 0.f); }
    *(u32x4*)(hid + (long)r * DFF + c) = pk8(a * a, b * b); } };

NI void gemm_in_phase(int l) {
  KPARAMS;
  const bf16_t* W = p.WallT + (long)l * WALL_N * DM;
  run_gemm_e(p.xn, W, NTOK, HC, DM, Epi8Rows<StH>{StH{p.h}, p.part});
  run_gemm_e(W + (long)HC * DM, p.xn, 768, NTOK, DM, Epi8Cols<StT>{StT{p.Vt, p.PQt}, p.part});
}
NI void gemm_out_phase(int l, float accscale) {
  KPARAMS;
  run_gemm_e(p.y, p.WoutT + (long)l * DM * DM, NTOK, DM, DM, Epi8Res{p.xn, p.part, accscale});
}
NI void gemm_up_phase(int l) {
  KPARAMS;
  run_gemm_e(p.xn, p.WupT + (long)l * DFF * DM, NTOK, DFF, DM, Epi8Rows<StUp>{StUp{p.hid}, p.part});
}
NI void gemm_down_phase(int l, float accscale) {
  KPARAMS;
  run_gemm_e(p.hid, p.WdownT + (long)l * DM * DFF, NTOK, DM, DFF, Epi8Res{p.xn, p.part, accscale});
}

constexpr int ARS = 72;
constexpr int ATILE = 64 * ARS;
NI void attn_tile(int l, int id, LAS3 unsigned* cnt, unsigned& target) {
  KPARAMS;
  const int tidf = otid(), half = __builtin_amdgcn_readfirstlane(tidf >> 8), tid = tidf & 255, lane = tid & 63, wid = __builtin_amdgcn_readfirstlane(tid >> 6), r = lane & 31, hh = lane >> 5, x32 = ((lane ^ 32) << 2);
  bf16_t* smem = SMEM + half * HALF_E;
  const int head = 3 - (id >> 8), b = (id >> 5) & 7, qb = id & 31;
  const float slope = (head == 0) ? 0.25f : (head == 1) ? 0.0625f : (head == 2) ? 0.015625f : 0.00390625f;
  const float ncs = -slope * LOG2E, cs = slope * LOG2E;
  const int qi = qb * 128 + wid * 32 + r;
  const bf16_t* qrow = p.h + ((long)(b * SEQ + qi)) * HC + head * 64;
  bf16x8 qf[2][2];
#pragma unroll
  for (int m = 0; m < 2; ++m)
#pragma unroll
    for (int s = 0; s < 2; ++s) qf[m][s] = *(const bf16x8*)(qrow + m * 32 + s * 16 + hh * 8);
  const bf16_t* kbase = p.h + ((long)(b * SEQ)) * HC + 256 + head * 64;
  const bf16_t* vbase = p.Vt + ((long)((b * 4 + head) * 64)) * SEQ;
  const int srow = tid >> 3, scol = (tid & 7) * 8;
  u32x4 rk[2], rv[2];
  f32x16 O[2][2];
#pragma unroll
  for (int m = 0; m < 2; ++m)
#pragma unroll
    for (int vb = 0; vb < 2; ++vb)
#pragma unroll
      for (int i = 0; i < 16; ++i) O[m][vb][i] = 0.f;
  float mrun[2] = {0.f, 0.f}, lrun[2] = {0.f, 0.f};
  const int kperm = (r & 19) | ((r & 4) << 1) | ((r & 8) >> 1);
  const int ktd = (qb * 128 + wid * 32) >> 6;
  unsigned csw, jrelw[2];
  { const unsigned h_ = pk2(cs, 0.f) & 0xffffu; csw = h_ | (pk2(cs - bflo(h_), 0.f) << 16); }
#pragma unroll
  for (int kb = 0; kb < 2; ++kb) { const float j_ = (float)(kb * 32 + kperm); jrelw[kb] = pk2(j_, j_); }

  const int wkeys = (head == 0) ? 305 : (head == 1) ? 1220 : SEQ;
  const int kt_lo = max(0, qb * 128 - wkeys) >> 6, kt_hi = min(SEQ, qb * 128 + 128 + wkeys + 63) >> 6;
#pragma unroll
  for (int i = 0; i < 2; ++i) {
    rk[i] = *(const u32x4*)(kbase + (long)(kt_lo * 64 + srow + 32 * i) * HC + scol);
    rv[i] = *(const u32x4*)(vbase + (long)(srow + 32 * i) * SEQ + kt_lo * 64 + scol);
  }
#pragma unroll
  for (int i = 0; i < 2; ++i) { *(u32x4*)(smem + (srow + 32 * i) * ARS + scol) = rk[i]; *(u32x4*)(smem + ATILE + (srow + 32 * i) * ARS + scol) = rv[i]; }
  asm volatile("" :: "v"(qf[0][0]), "v"(qf[0][1]), "v"(qf[1][0]), "v"(qf[1][1]));
  HBAR();
  for (int kt = kt_lo; kt < kt_hi; ++kt) {
    const bool more = (kt + 1) < kt_hi;
    if (more) {
#pragma unroll
      for (int i = 0; i < 2; ++i) {
        rk[i] = *(const u32x4*)(kbase + (long)((kt + 1) * 64 + srow + 32 * i) * HC + scol);
        rv[i] = *(const u32x4*)(vbase + (long)(srow + 32 * i) * SEQ + (kt + 1) * 64 + scol);
      }
    }
    const bf16_t* Ks = smem + ((kt - kt_lo) & 1) * 2 * ATILE;
    const bf16_t* Vs = Ks + ATILE;
    const float dbase = (float)(qi - kt * 64 - 8 * hh);
    const bool diag = (kt == ktd);
#pragma unroll
    for (int m = 0; m < 2; ++m) {
      __builtin_amdgcn_sched_barrier(0);
      f32x16 x[2];
      if (!diag) {
        const bool left = kt < ktd;
        const float C = fmaf(left ? cs : -cs, (float)(kt * 64 - qi), -mrun[m]);
        const unsigned wC = pk2(C, 0.f), wL = pk2(C - bflo(wC), 0.f);
        u32x4 qa; qa[0] = hh ? 0u : (left ? csw : (csw ^ 0x80008000u)); qa[1] = hh ? 0u : ((wC & 0xffffu) | (wL << 16)); qa[2] = 0u; qa[3] = 0u;
#pragma unroll
        for (int kb = 0; kb < 2; ++kb) {
          u32x4 ka; ka[0] = hh ? 0u : jrelw[kb]; ka[1] = hh ? 0u : 0x3f803f80u; ka[2] = 0u; ka[3] = 0u;
#pragma unroll
          for (int i = 0; i < 16; ++i) x[kb][i] = 0.f;
          x[kb] = __builtin_amdgcn_mfma_f32_32x32x16_bf16(__builtin_bit_cast(bf16x8, ka), __builtin_bit_cast(bf16x8, qa), x[kb], 0, 0, 0);
#pragma unroll
          for (int s = 0; s < 2; ++s) {
            const bf16x8 kf = *(const bf16x8*)(Ks + (kb * 32 + kperm) * ARS + m * 32 + s * 16 + hh * 8);
            x[kb] = __builtin_amdgcn_mfma_f32_32x32x16_bf16(kf, qf[m][s], x[kb], 0, 0, 0);
          }
        }
      } else {
#pragma unroll
        for (int kb = 0; kb < 2; ++kb) {
#pragma unroll
          for (int i = 0; i < 16; ++i) x[kb][i] = 0.f;
#pragma unroll
          for (int s = 0; s < 2; ++s) {
            const bf16x8 kf = *(const bf16x8*)(Ks + (kb * 32 + kperm) * ARS + m * 32 + s * 16 + hh * 8);
            x[kb] = __builtin_amdgcn_mfma_f32_32x32x16_bf16(kf, qf[m][s], x[kb], 0, 0, 0);
          }
        }
        const float nm = -mrun[m];
#pragma unroll
        for (int kb = 0; kb < 2; ++kb)
#pragma unroll
          for (int i = 0; i < 16; ++i) {
            const float off = (float)(kb * 32 + 16 * (i >> 3) + (i & 7));
            x[kb][i] = fmaf(ncs, fabsf(dbase - off), x[kb][i]) + nm;
          }
      }
      float mx = -1e30f;
#pragma unroll
      for (int kb = 0; kb < 2; ++kb)
#pragma unroll
        for (int i = 0; i < 16; ++i) mx = fmaxf(mx, x[kb][i]);
      mx = fmaxf(mx, xch32(mx, x32));
      if (__builtin_amdgcn_ballot_w64(mx > 8.f) != 0ull) {
        const float delta = fmaxf(mx, 0.f);
        const float alpha = __builtin_amdgcn_exp2f(-delta);
        mrun[m] += delta;
        lrun[m] *= alpha;
#pragma unroll
        for (int vb = 0; vb < 2; ++vb)
#pragma unroll
          for (int i = 0; i < 16; ++i) O[m][vb][i] *= alpha;
#pragma unroll
        for (int kb = 0; kb < 2; ++kb)
#pragma unroll
          for (int i = 0; i < 16; ++i) x[kb][i] -= delta;
      }
      float ps = 0.f;
#pragma unroll
      for (int kb = 0; kb < 2; ++kb)
#pragma unroll
        for (int i = 0; i < 16; ++i) { x[kb][i] = __builtin_amdgcn_exp2f(x[kb][i]); ps += x[kb][i]; }
      lrun[m] += ps;
#pragma unroll
      for (int kb = 0; kb < 2; ++kb)
#pragma unroll
        for (int s = 0; s < 2; ++s) {
          u32x4 pw;
#pragma unroll
          for (int j = 0; j < 4; ++j) pw[j] = pk2(x[kb][8 * s + 2 * j], x[kb][8 * s + 2 * j + 1]);
          const bf16x8 pf = __builtin_bit_cast(bf16x8, pw);
#pragma unroll
          for (int vb = 0; vb < 2; ++vb) {
            const bf16x8 vf = *(const bf16x8*)(Vs + (vb * 32 + r) * ARS + kb * 32 + s * 16 + hh * 8);
            O[m][vb] = __builtin_amdgcn_mfma_f32_32x32x16_bf16(vf, pf, O[m][vb], 0, 0, 0);
          }
        }
    }
    if (more) {
      bf16_t* wk = smem + ((kt + 1 - kt_lo) & 1) * 2 * ATILE;
#pragma unroll
      for (int i = 0; i < 2; ++i) { *(u32x4*)(wk + (srow + 32 * i) * ARS + scol) = rk[i]; *(u32x4*)(wk + ATILE + (srow + 32 * i) * ARS + scol) = rv[i]; }
    }
    HBAR();
  }
  asm volatile("" ::: "memory");
  const int tid2 = otid() & 255, lane2 = tid2 & 63, hh2 = lane2 >> 5, qi2 = qb * 128 + __builtin_amdgcn_readfirstlane(tid2 >> 6) * 32 + (lane2 & 31);
  const float lam = p.lam[l];
  int lx = l; asm volatile("" : "+s"(lx));
  const float lam_init = (lx == 0) ? 0.2f : (lx == 1) ? 0.35550907f : (lx == 2) ? 0.47071302f : 0.55605820f;
  const float l1 = lrun[0] + xch32(lrun[0], x32), l2 = lrun[1] + xch32(lrun[1], x32);
  const float i1 = 1.f / l1, i2 = lam / l2;
  float ss = 0.f;
#pragma unroll
  for (int vb = 0; vb < 2; ++vb)
#pragma unroll
    for (int i = 0; i < 16; ++i) { const float o = O[0][vb][i] * i1 - O[1][vb][i] * i2; O[0][vb][i] = o; ss += o * o; }
  ss += xch32(ss, x32);
  const float rs = rsqrtf(ss * (1.f / 64.f) + EPS) * (1.f - lam_init);
  const float* sg = p.subln_g + l * 64;
  bf16_t* yrow = p.y + ((long)(b * SEQ + qi2)) * DM + head * 64;
#pragma unroll
  for (int vb = 0; vb < 2; ++vb)
#pragma unroll
    for (int g4 = 0; g4 < 4; ++g4) {
      const int vc = vb * 32 + 8 * g4 + 4 * hh2;
      const f32x4 gg = *(const f32x4*)(sg + vc);
      u32x2 w;
      w[0] = pk2(O[0][vb][4 * g4 + 0] * rs * gg[0], O[0][vb][4 * g4 + 1] * rs * gg[1]);
      w[1] = pk2(O[0][vb][4 * g4 + 2] * rs * gg[2], O[0][vb][4 * g4 + 3] * rs * gg[3]);
      *(u32x2*)(yrow + vc) = w;
    }
}

constexpr int ZRS = 264;
NI void conv_tile(int l, int id, LAS3 unsigned* cnt, unsigned& target) {
  KPARAMS;
  const int tidf = otid(), half = __builtin_amdgcn_readfirstlane(tidf >> 8), tid = tidf & 255, lane = tid & 63, wid = __builtin_amdgcn_readfirstlane(tid >> 6), x32 = ((lane ^ 32) << 2);
  bf16_t* smem = SMEM + half * HALF_E;
  const int b = id >> 6, t0 = (id & 63) * 64;
  for (int idx = tid; idx < 94 * 32; idx += 256) {
    const int row = idx >> 5, c8 = (idx & 31) * 8;
    const int tok = t0 - 15 + row;
    u32x4 w = (u32x4){0u, 0u, 0u, 0u};
    if (tok >= 0 && tok < SEQ) {
      const bf16_t* hp = p.h + ((long)(b * SEQ + tok)) * HC + 512 + c8;
      const u32x4 a = *(const u32x4*)hp, g = *(const u32x4*)(hp + 256);
#pragma unroll
      for (int j = 0; j < 4; ++j) {
        const float a0 = bflo(a[j]), a1 = bfhi(a[j]), g0 = bflo(g[j]), g1 = bfhi(g[j]);
        w[j] = pk2(a0 * __builtin_amdgcn_rcpf(1.f + __builtin_amdgcn_exp2f(-LOG2E * g0)), a1 * __builtin_amdgcn_rcpf(1.f + __builtin_amdgcn_exp2f(-LOG2E * g1)));
      }
    }
    *(u32x4*)(smem + row * ZRS + c8) = w;
  }
  HBAR();
  {
    const int c = tid;
    float wv[31];
#pragma unroll
    for (int j = 0; j < 31; ++j) wv[j] = p.conv_dw_w[((long)l * 31 + j) * 256 + c];
    const float cb = p.conv_dw_b[l * 256 + c], lg = p.conv_ln_g[l * 256 + c], lb = p.conv_ln_b[l * 256 + c];
#pragma unroll 1
    for (int ch = 0; ch < 8; ++ch) {
      float zw[38];
#pragma unroll
      for (int j = 0; j < 38; ++j) zw[j] = bf2f(smem[(ch * 8 + j) * ZRS + c]);
      float o[8];
#pragma unroll
      for (int tt = 0; tt < 8; ++tt) {
        float s = cb;
#pragma unroll
        for (int j = 0; j < 31; ++j) s = fmaf(wv[j], zw[tt + j], s);
        o[tt] = s;
      }
#pragma unroll
      for (int tt = 0; tt < 8; ++tt) {
        const float s1 = wave_sum(o[tt], x32), s2 = wave_sum(o[tt] * o[tt], x32);
        const float mu = s1 * (1.f / 64.f);
        const float var = fmaxf(s2 * (1.f / 64.f) - mu * mu, 0.f);
        const float yv = (o[tt] - mu) * rsqrtf(var + EPS) * lg + lb;
        const float sv = yv * __builtin_amdgcn_rcpf(1.f + __builtin_amdgcn_exp2f(-LOG2E * yv));
        smem[(ch * 8 + tt) * ZRS + c] = (bf16_t)(pk2(sv, 0.f) & 0xffffu);
      }
    }
  }
  HBAR();
  {
    const int fr = lane & 15, fq = lane >> 4;
    const bf16_t* W = p.pwT + (long)l * 65536 + (long)(wid * 64) * 256;
    f32x4 acc[4][4];
#pragma unroll
    for (int m = 0; m < 4; ++m)
#pragma unroll
      for (int n = 0; n < 4; ++n) acc[m][n] = (f32x4){0.f, 0.f, 0.f, 0.f};
#pragma unroll 2
    for (int ks = 0; ks < 8; ++ks) {
      bf16x8 af[4], bfr[4];
#pragma unroll
      for (int m = 0; m < 4; ++m) af[m] = *(const bf16x8*)(smem + (m * 16 + fr) * ZRS + ks * 32 + fq * 8);
#pragma unroll
      for (int n = 0; n < 4; ++n) bfr[n] = *(const bf16x8*)(W + (long)(n * 16 + fr) * 256 + ks * 32 + fq * 8);
#pragma unroll
      for (int m = 0; m < 4; ++m)
#pragma unroll
        for (int n = 0; n < 4; ++n) acc[m][n] = __builtin_amdgcn_mfma_f32_16x16x32_bf16(bfr[n], af[m], acc[m][n], 0, 0, 0);
    }
    const float* pb = p.conv_pw_b + l * 256;
#pragma unroll
    for (int m = 0; m < 4; ++m)
#pragma unroll
      for (int n = 0; n < 4; ++n) {
        const int tok = t0 + m * 16 + fr, col = wid * 64 + n * 16 + fq * 4;
        const f32x4 bv = *(const f32x4*)(pb + col);
        const f32x4 v = acc[m][n] + bv;
        u32x2 w; w[0] = pk2(v[0], v[1]); w[1] = pk2(v[2], v[3]);
        *(u32x2*)(p.y + ((long)(b * SEQ + tok)) * DM + 256 + col) = w;
      }
  }
  HBAR();
}

constexpr int VRS = 258;
NI void sgu_tile(int l, int id, LAS3 unsigned* cnt, unsigned& target) {
  KPARAMS;
  const int tidf = otid(), half = __builtin_amdgcn_readfirstlane(tidf >> 8), tid = tidf & 255, lane = tid & 63, wid = __builtin_amdgcn_readfirstlane(tid >> 6), x32 = ((lane ^ 32) << 2);
  bf16_t* smem = SMEM + half * HALF_E;
  const long T0 = (long)id * 128;
  {
    const f32x4 lg = *(const f32x4*)(p.sgu_ln_g + l * 256 + lane * 4), lb = *(const f32x4*)(p.sgu_ln_b + l * 256 + lane * 4);
#pragma unroll 4
    for (int i = 0; i < 32; ++i) {
      const int s = wid * 32 + i;
      const u32x2 raw = *(const u32x2*)(p.h + (T0 + s) * HC + 1280 + lane * 4);
      const float v0 = bflo(raw[0]), v1 = bfhi(raw[0]), v2 = bflo(raw[1]), v3 = bfhi(raw[1]);
      const float s1 = wave_sum(v0 + v1 + v2 + v3, x32);
      const float mu = s1 * (1.f / 256.f);
      const float d0 = v0 - mu, d1 = v1 - mu, d2 = v2 - mu, d3 = v3 - mu;
      const float s2 = wave_sum(d0 * d0 + d1 * d1 + d2 * d2 + d3 * d3, x32);
      const float rs = rsqrtf(s2 * (1.f / 256.f) + EPS);
      unsigned* dst = (unsigned*)(smem + s * VRS + lane * 4);
      dst[0] = pk2(d0 * rs * lg[0] + lb[0], d1 * rs * lg[1] + lb[1]);
      dst[1] = pk2(d2 * rs * lg[2] + lb[2], d3 * rs * lg[3] + lb[3]);
    }
  }
  HBAR();
  {
    const int fr = lane & 15, fq = lane >> 4, g = wid;
    const bf16_t* W = p.sguW + ((long)(l * 4 + g)) * 16384;
    const float* bs = p.sgu_b + ((long)(l * 4 + g)) * 128;
#pragma unroll 1
    for (int th = 0; th < 2; ++th) {
      f32x4 acc[4][4];
#pragma unroll
      for (int m = 0; m < 4; ++m)
#pragma unroll
        for (int n = 0; n < 4; ++n) acc[m][n] = (f32x4){0.f, 0.f, 0.f, 0.f};
#pragma unroll 1
      for (int ks = 0; ks < 4; ++ks) {
        bf16x8 vf[4], wf[4];
#pragma unroll
        for (int n = 0; n < 4; ++n) {
#pragma unroll
          for (int j = 0; j < 8; ++j) vf[n][j] = (short)smem[(ks * 32 + fq * 8 + j) * VRS + g * 64 + n * 16 + fr];
        }
#pragma unroll
        for (int m = 0; m < 4; ++m) wf[m] = *(const bf16x8*)(W + (long)(th * 64 + m * 16 + fr) * 128 + ks * 32 + fq * 8);
#pragma unroll
        for (int m = 0; m < 4; ++m)
#pragma unroll
          for (int n = 0; n < 4; ++n) acc[m][n] = __builtin_amdgcn_mfma_f32_16x16x32_bf16(vf[n], wf[m], acc[m][n], 0, 0, 0);
      }
#pragma unroll
      for (int m = 0; m < 4; ++m) {
        const int t = th * 64 + m * 16 + fr;
        const float bt = bs[t];
#pragma unroll
        for (int n = 0; n < 4; ++n) {
          const int c = g * 64 + n * 16 + fq * 4;
          const u32x2 ur = *(const u32x2*)(p.h + (T0 + t) * HC + 1024 + c);
          const f32x4 sv = acc[m][n] + bt;
          u32x2 w; w[0] = pk2(bflo(ur[0]) * sv[0], bfhi(ur[0]) * sv[1]); w[1] = pk2(bflo(ur[1]) * sv[2], bfhi(ur[1]) * sv[3]);
          *(u32x2*)(p.y + (T0 + t) * DM + 768 + c) = w;
        }
      }
    }
  }
  HBAR();
}

constexpr int FRS = 72, FPL = 64 * FRS, FCH = 2 * FPL + 64;
NI void fft_item(int l, int id, LAS3 unsigned* cnt, unsigned& target) {
  KPARAMS;
  const int tidf = otid(), half = __builtin_amdgcn_readfirstlane(tidf >> 8), tid = tidf & 255, lane = tid & 63, wid = __builtin_amdgcn_readfirstlane(tid >> 6);
  const int fr = lane & 15, fq = lane >> 4;
  bf16_t* smem = SMEM + half * HALF_E;
  const int b = id >> 7, ch0 = (id & 127) * 2;
  bf16_t* Ct = smem + 2 * FCH;
  unsigned* TWl = (unsigned*)(Ct + 2 * FPL);
  {
    u32x4 zv[8], cv[4], tv[4];
#pragma unroll
    for (int i = 0; i < 8; ++i) {
      const int chunk = tid + 256 * i, c = chunk >> 10, rem = chunk & 1023, ri = rem >> 9, s8 = rem & 511;
      zv[i] = *(const u32x4*)(p.PQt + ((long)(b * 256 + ch0 + c)) * 8192 + ri * 4096 + s8 * 8);
    }
#pragma unroll
    for (int i = 0; i < 4; ++i) {
      const int chunk = tid + 256 * i, tb = chunk >> 9, row = (chunk >> 3) & 63, c8 = chunk & 7;
      cv[i] = *(const u32x4*)(p.M1 + (tb * 64 + row) * 128 + c8 * 8);
      tv[i] = *(const u32x4*)((const unsigned*)p.TW + chunk * 4);
    }
#pragma unroll
    for (int i = 0; i < 8; ++i) {
      const int chunk = tid + 256 * i, c = chunk >> 10, rem = chunk & 1023, ri = rem >> 9, s8 = rem & 511;
      *(u32x4*)(smem + c * FCH + ri * FPL + (s8 >> 3) * FRS + (s8 & 7) * 8) = zv[i];
    }
#pragma unroll
    for (int i = 0; i < 4; ++i) {
      const int chunk = tid + 256 * i, tb = chunk >> 9, row = (chunk >> 3) & 63, c8 = chunk & 7;
      *(u32x4*)(Ct + tb * FPL + row * FRS + c8 * 8) = cv[i];
      *(u32x4*)(TWl + (chunk >> 4) * 68 + (chunk & 15) * 4) = tv[i];
    }
  }
  HBAR();
  {
    const int c = wid >> 1;
    bf16x8 zf[2][4];
#pragma unroll
    for (int nt = 0; nt < 2; ++nt)
#pragma unroll
      for (int ks = 0; ks < 4; ++ks) {
        const bf16_t* src = smem + c * FCH + (ks >> 1) * FPL + ((ks & 1) * 32 + fq * 8) * FRS + (wid & 1) * 32 + nt * 16 + fr;
#pragma unroll
        for (int j = 0; j < 8; ++j) zf[nt][ks][j] = (short)src[j * FRS];
      }
    f32x4 acc[2][8];
#pragma unroll
    for (int nt = 0; nt < 2; ++nt)
#pragma unroll
      for (int mt = 0; mt < 8; ++mt) acc[nt][mt] = (f32x4){0.f, 0.f, 0.f, 0.f};
#pragma unroll
    for (int mt = 0; mt < 8; ++mt)
#pragma unroll
      for (int ks = 0; ks < 4; ++ks) {
        u32x4 mw = *(const u32x4*)(Ct + (((mt >> 2) == (ks >> 1)) ? 0 : FPL) + ((mt & 3) * 16 + fr) * FRS + (ks & 1) * 32 + fq * 8);
        if ((mt >> 2) == 0 && (ks >> 1) == 1) mw = mw ^ 0x80008000u;
        const bf16x8 mf = __builtin_bit_cast(bf16x8, mw);
#pragma unroll
        for (int nt = 0; nt < 2; ++nt) acc[nt][mt] = __builtin_amdgcn_mfma_f32_16x16x32_bf16(zf[nt][ks], mf, acc[nt][mt], 0, 0, 0);
      }
#pragma unroll
    for (int nt = 0; nt < 2; ++nt)
#pragma unroll
      for (int m4 = 0; m4 < 4; ++m4) {
        const int k1 = m4 * 16 + fr, s2 = (wid & 1) * 32 + nt * 16 + fq * 4;
        const u32x4 tw = *(const u32x4*)(TWl + k1 * 68 + s2);
        const f32x4 yr = acc[nt][m4], yi = acc[nt][m4 + 4];
        const float cs[4] = {bflo(tw[0]), bflo(tw[1]), bflo(tw[2]), bflo(tw[3])}, sn[4] = {bfhi(tw[0]), bfhi(tw[1]), bfhi(tw[2]), bfhi(tw[3])};
        float tr[4], ti[4];
#pragma unroll
        for (int j = 0; j < 4; ++j) { tr[j] = yr[j] * cs[j] - yi[j] * sn[j]; ti[j] = yr[j] * sn[j] + yi[j] * cs[j]; }
        u32x2 wr_, wi_; wr_[0] = pk2(tr[0], tr[1]); wr_[1] = pk2(tr[2], tr[3]); wi_[0] = pk2(ti[0], ti[1]); wi_[1] = pk2(ti[2], ti[3]);
        *(u32x2*)(smem + c * FCH + k1 * FRS + s2) = wr_;
        *(u32x2*)(smem + c * FCH + FPL + k1 * FRS + s2) = wi_;
      }
  }
  HBAR();
  {
    f32x4 acc[2][4];
#pragma unroll
    for (int t = 0; t < 2; ++t)
#pragma unroll
      for (int mt = 0; mt < 4; ++mt) acc[t][mt] = (f32x4){0.f, 0.f, 0.f, 0.f};
#pragma unroll
    for (int ks = 0; ks < 4; ++ks) {
      bf16x8 tf[2];
#pragma unroll
      for (int t = 0; t < 2; ++t) {
        const int k1 = (wid * 2 + t) * 8 + (fr >> 1), c = fr & 1;
        tf[t] = *(const bf16x8*)(smem + c * FCH + (ks >> 1) * FPL + k1 * FRS + (ks & 1) * 32 + fq * 8);
      }
#pragma unroll
      for (int mt = 0; mt < 4; ++mt) {
        u32x4 mw = *(const u32x4*)(Ct + ((ks >> 1) ? FPL : 0) + (mt * 16 + fr) * FRS + (ks & 1) * 32 + fq * 8);
        if (ks >> 1) mw = mw ^ 0x80008000u;
        const bf16x8 mf = __builtin_bit_cast(bf16x8, mw);
#pragma unroll
        for (int t = 0; t < 2; ++t) acc[t][mt] = __builtin_amdgcn_mfma_f32_16x16x32_bf16(tf[t], mf, acc[t][mt], 0, 0, 0);
      }
    }
    const float b0 = p.fnet_b[l * 256 + ch0], b1 = p.fnet_b[l * 256 + ch0 + 1];
#pragma unroll
    for (int t = 0; t < 2; ++t)
#pragma unroll
      for (int mt = 0; mt < 4; ++mt)
#pragma unroll
        for (int jj = 0; jj < 2; ++jj) {
          const int k1 = (wid * 2 + t) * 8 + 2 * fq + jj, k2 = mt * 16 + fr;
          *(unsigned*)(p.y + ((long)(b * SEQ + k1 + 64 * k2)) * DM + 512 + ch0) = pk2(acc[t][mt][2 * jj] + b0, acc[t][mt][2 * jj + 1] + b1);
        }
  }
  HBAR();
}

NI void mixer_phase(int l, int rep) {
  KPARAMS;
  constexpr int NA = 1024, NF = 1024, NC = 512, ND = 256;
  const int tidf = otid(), half = __builtin_amdgcn_readfirstlane(tidf >> 8), tid = tidf & 255, lane = tid & 63;
  LAS3 unsigned* ctl = (LAS3 unsigned*)(LDSP + 2 * HALF_B);
  LAS3 unsigned* cnt = ctl + 8 + 4 * half;
  LAS3 unsigned* nx = ctl + 16 + 4 * half;
  if (tid == 0) *cnt = 0u;
  __syncthreads();
  unsigned target = 0u;
  for (int it = 0;; ++it) {
    if (tid == 0) nx[it & 1] = (unsigned)atomicAdd(p.ctr + l + 4 * rep, 1);
    HBAR();
    const int id = __builtin_amdgcn_readfirstlane((int)nx[it & 1]);
    if (id >= NA + NF + NC + ND) break;
    if (id < NA) attn_tile(l, id, cnt, target);
    else if (id < NA + NC) conv_tile(l, id - NA, cnt, target);
    else if (id < NA + NC + ND) sgu_tile(l, id - NA - NC, cnt, target);
    else fft_item(l, id - NA - NC - ND, cnt, target);
  }
}

#define LAS __attribute__((address_space(3)))
#define XB_TMO      128
#define XB_XCNT(j)  (256  + 64 * (j))
#define XB_XSUB(j)  (1280 + 64 * (j))
#define XB_XGEN(j)  (2304 + 64 * (j))
#define XB_TOP      3328
#define XB_TOPGEN   3392
#define XCD_BAR_WORDS 3456
#define XB_SPIN_CAP (1u << 18)

__device__ __forceinline__ unsigned xb_ld(unsigned* p)              { return __hip_atomic_load(p, __ATOMIC_RELAXED, __HIP_MEMORY_SCOPE_AGENT); }
__device__ __forceinline__ unsigned xb_add(unsigned* p, unsigned v) { return __hip_atomic_fetch_add(p, v, __ATOMIC_RELAXED, __HIP_MEMORY_SCOPE_AGENT); }
__device__ __forceinline__ unsigned xb_xcc_id() { return (unsigned)__builtin_amdgcn_s_getreg((3 << 11) | 20) & 0xFu; }
#define XB_SPIN(cond, bar) do { unsigned _sp = 0; while (cond) { __builtin_amdgcn_s_sleep(1); \
    if ((++_sp & 255u) == 0u) { if (xb_ld(&(bar)[XB_TMO])) break; if (_sp > XB_SPIN_CAP) { atomicAdd(&(bar)[XB_TMO], 1u); break; } } } } while (0)

struct XcdBarrier {
    unsigned* bar; unsigned x;
    volatile LAS unsigned* st;
};

__device__ __forceinline__ XcdBarrier xcd_barrier_post(unsigned* bar, volatile LAS unsigned* st) {
    XcdBarrier b; b.bar = bar; b.x = xb_xcc_id(); b.st = st;
    if (threadIdx.x == 0) (void)xb_add(&bar[XB_XCNT(b.x)], 1u);
    return b;
}
__device__ __forceinline__ void xcd_barrier_complete(unsigned* bar, unsigned x, unsigned& nloc, unsigned& nx) {
    const unsigned G = gridDim.x * gridDim.y * gridDim.z;
    unsigned sum, cnt, mine, sp = 0u;
    for (;;) {
        sum = 0u; cnt = 0u; mine = 0u;
#pragma unroll
        for (unsigned j = 0; j < 16; ++j) { const unsigned c = xb_ld(&bar[XB_XCNT(j)]); sum += c; cnt += (c > 0u) ? 1u : 0u; mine = (j == x) ? c : mine; }
        if (sum == G) break;
        __builtin_amdgcn_s_sleep(1);
        if ((++sp & 255u) == 0u) { if (xb_ld(&bar[XB_TMO])) break; if (sp > XB_SPIN_CAP) { atomicAdd(&bar[XB_TMO], 1u); break; } }
    }
    nloc = mine > 0u ? mine : 1u; nx = cnt > 0u ? cnt : 1u;
}

__device__ __forceinline__ void xcd_barrier(const XcdBarrier& b) {
    asm volatile("s_waitcnt vmcnt(0)" ::: "memory");
    __syncthreads();
    if (threadIdx.x == 0) {
        unsigned* bar = b.bar;
        __builtin_amdgcn_s_waitcnt(0);
        unsigned nloc = b.st[0], nx = b.st[1];
        if (nloc == 0u) { xcd_barrier_complete(bar, b.x, nloc, nx); b.st[0] = nloc; b.st[1] = nx; }
        const unsigned old = xb_add(&bar[XB_XSUB(b.x)], 1u);
        const unsigned gen = old / nloc;
        if (old + 1u == (gen + 1u) * nloc) {
            __builtin_amdgcn_fence(__ATOMIC_RELEASE, "agent");
            asm volatile("s_waitcnt vmcnt(0)" ::: "memory");
            const unsigned og = xb_add(&bar[XB_TOP], 1u);
            const unsigned tg = og / nx;
            if (og + 1u == (tg + 1u) * nx) xb_add(&bar[XB_TOPGEN], 1u);
            else XB_SPIN(xb_ld(&bar[XB_TOPGEN]) == tg, bar);
            __builtin_amdgcn_fence(__ATOMIC_ACQUIRE, "agent");
            xb_add(&bar[XB_XGEN(b.x)], 1u);
            asm volatile("s_waitcnt vmcnt(0)" ::: "memory");
        } else {
            XB_SPIN(xb_ld(&bar[XB_XGEN(b.x)]) == gen, bar);
            __builtin_amdgcn_fence(__ATOMIC_ACQUIRE, "agent");
            asm volatile("s_waitcnt vmcnt(0)" ::: "memory");
        }
    }
    __syncthreads();
}

constexpr int NPHASE = 2 + 5 * DEPTH;
__global__ void __launch_bounds__(512, 2) mk_fwd(Params p, int ph_lo, int ph_hi, int coop) {
  int rep = 0;
  volatile LAS unsigned* bst = (volatile LAS unsigned*)(LDSP + 2 * HALF_B + 16);
  if (otid() < 2) bst[otid()] = 0u;
  __syncthreads();
  XcdBarrier xbar = xcd_barrier_post(p.barw, bst);
  for (int ph = ph_lo; ph < ph_hi; ++ph) {
    if (ph == 0) {
      prep_phase();
      if (REP_PREP) { __syncthreads(); prep_phase(); }
    } else if (ph == NPHASE - 1) {
      final_rms_phase(p.xn, p.final_g, p.out);
    } else {
      const int l = (ph - 1) / 5, s = (ph - 1) % 5;
      if (s == 0) gemm_in_phase(l);
      else if (s == 1) mixer_phase(l, rep);
      else if (s == 2) gemm_out_phase(l, (REP_S == 2 && rep == 0) ? 0.f : 1.f);
      else if (s == 3) gemm_up_phase(l);
      else gemm_down_phase(l, (REP_S == 4 && rep == 0) ? 0.f : 1.f);
    }
    if (coop && ph + 1 < ph_hi) { if (ph == 0) cg::this_grid().sync(); else xcd_barrier(xbar); }
    if (coop && ph == 1) for (int i = 0; i < EXTRA_SYNCS; ++i) xcd_barrier(xbar);
    if (REP_S >= 0 && rep == 0 && ph >= 1 && ph < NPHASE - 1 && ((ph - 1) % 5) == REP_S) { rep = 1; --ph; } else rep = 0;
  }
}

extern "C" void kernel_launch(void* const* d_in, const int* in_sizes, int n_in, void* d_out, int out_size, void* d_ws, size_t ws_size, hipStream_t stream) {
  Params p{};
  const float** pf = (const float**)&p;
  for (int i = 0; i < 25; ++i) pf[i] = (const float*)d_in[i];
  p.out = (float*)d_out;
  unsigned char* w = (unsigned char*)d_ws;
  size_t off = 0;
  auto take = [&](size_t bytes) { unsigned char* r = w + off; off += (bytes + 255) & ~(size_t)255; return r; };
  p.WallT = (bf16_t*)take((size_t)DEPTH * WALL_N * DM * 2);
  p.WoutT = (bf16_t*)take((size_t)DEPTH * DM * DM * 2);
  p.WupT = (bf16_t*)take((size_t)DEPTH * DFF * DM * 2);
  p.WdownT = (bf16_t*)take((size_t)DEPTH * DFF * DM * 2);
  p.pwT = (bf16_t*)take((size_t)DEPTH * 65536 * 2);
  p.sguW = (bf16_t*)take((size_t)DEPTH * 4 * 16384 * 2);
  p.lam = (float*)take(256);
  unsigned char* ctl = take(16384);
  p.ctr = (int*)ctl;
  p.barw = (unsigned*)(ctl + 256);
  p.M1 = (bf16_t*)take(128 * 128 * 2);
  p.M3 = (bf16_t*)take(64 * 128 * 2);
  p.TW = (float*)take(4096 * 2 * 4);
  p.part = (float*)take((size_t)NTOK * 16 * 4);
  p.xn = (bf16_t*)take((size_t)NTOK * DM * 2);
  unsigned char* region = take((size_t)NTOK * DFF * 2);
  p.hid = (bf16_t*)region;
  p.h = (bf16_t*)region;
  p.Vt = (bf16_t*)(region + (size_t)NTOK * HC * 2);
  p.PQt = (bf16_t*)(region + (size_t)NTOK * HC * 2 + (size_t)NTOK * 256 * 2);
  p.y = (bf16_t*)(region + (size_t)NTOK * HC * 2 + (size_t)NTOK * 256 * 2 + (size_t)BATCH * 256 * 8192 * 2);
  if (off > ws_size) { fprintf(stderr, "workspace too small: need %zu have %zu\n", off, ws_size); return; }

  static int grid_blocks = 0;
  if (!grid_blocks) {
    int dev = 0, cus = 0, per_cu = 0;
    hipGetDevice(&dev);
    hipDeviceGetAttribute(&cus, hipDeviceAttributeMultiprocessorCount, dev);
    hipOccupancyMaxActiveBlocksPerMultiprocessor(&per_cu, mk_fwd, 512, 0);
    if (per_cu < 1) per_cu = 1;
    grid_blocks = cus * per_cu;
  }
  hipMemsetAsync(ctl, 0, 16384, stream);
#if MK_ONE_LAUNCH
  int lo = 0, hi = NPHASE, coop = 1;
  void* args[] = {&p, &lo, &hi, &coop};
  hipError_t e = hipLaunchCooperativeKernel((void*)mk_fwd, dim3(grid_blocks), dim3(512), args, 0, stream);
  if (e != hipSuccess) fprintf(stderr, "cooperative launch failed: %s (grid %d)\n", hipGetErrorString(e), grid_blocks);
#else
  for (int ph = 0; ph < NPHASE; ++ph) mk_fwd<<<grid_blocks, 512, 0, stream>>>(p, ph, ph + 1, 0);
#endif
}
```

```cpp
#include <hip/hip_runtime.h>
#include <hip/hip_cooperative_groups.h>
#include <cstdint>
#include <cstdio>
#include <cmath>
namespace cg = cooperative_groups;

#ifndef EXTRA_SYNCS
#define EXTRA_SYNCS 0
#endif
#ifndef REP_PREP
#define REP_PREP 0
#endif
#ifndef REP_S
#define REP_S -1
#endif
#ifndef MK_ONE_LAUNCH
#define MK_ONE_LAUNCH 1
#endif

#define DI __device__ __forceinline__
typedef unsigned short bf16_t;
typedef short bf16x8 __attribute__((ext_vector_type(8)));
typedef float f32x4 __attribute__((ext_vector_type(4)));
typedef float f32x16 __attribute__((ext_vector_type(16)));
typedef float f32x2 __attribute__((ext_vector_type(2)));
typedef __bf16 bf16x2v __attribute__((ext_vector_type(2)));
typedef unsigned u32x4 __attribute__((ext_vector_type(4)));
typedef unsigned u32x2 __attribute__((ext_vector_type(2)));

constexpr int BATCH = 8, SEQ = 4096, DM = 1024, DEPTH = 4, NTOK = BATCH * SEQ;
constexpr int HC = 1536;
constexpr int WALL_N = 2304;
constexpr int DFF = 4096;
constexpr float EPS = 1e-6f;
constexpr float LOG2E = 1.4426950408889634f;

DI unsigned pk2(float lo, float hi) { f32x2 v = {lo, hi}; bf16x2v b = __builtin_convertvector(v, bf16x2v); return __builtin_bit_cast(unsigned, b); }
DI float bflo(unsigned u) { return __uint_as_float(u << 16); }
DI float bfhi(unsigned u) { return __uint_as_float(u & 0xffff0000u); }
DI float bf2f(bf16_t u) { return __uint_as_float(((unsigned)u) << 16); }
template <int CTRL> DI float dppf(float v) { return __builtin_bit_cast(float, __builtin_amdgcn_update_dpp(0, __builtin_bit_cast(int, v), CTRL, 0xf, 0xf, true)); }
DI float xch32(float v, int x32) { return __builtin_bit_cast(float, __builtin_amdgcn_ds_bpermute(x32, __builtin_bit_cast(int, v))); }
DI float wave_sum(float v, int x32) {
  v += dppf<0xB1>(v); v += dppf<0x4E>(v); v += dppf<0x141>(v); v += dppf<0x140>(v);
  v += __builtin_bit_cast(float, __builtin_amdgcn_ds_swizzle(__builtin_bit_cast(int, v), 0x401f));
  v += xch32(v, x32);
  return v;
}

#define LAS3 __attribute__((address_space(3)))
DI void half_bar(LAS3 unsigned* cnt, unsigned& target, int lane) {
  asm volatile("s_waitcnt lgkmcnt(0)" ::: "memory");
  target += 4u;
  if (lane == 0) __hip_atomic_fetch_add(cnt, 1u, __ATOMIC_RELAXED, __HIP_MEMORY_SCOPE_WORKGROUP);
  while (__hip_atomic_load(cnt, __ATOMIC_RELAXED, __HIP_MEMORY_SCOPE_WORKGROUP) < target) __builtin_amdgcn_s_sleep(1);
  asm volatile("" ::: "memory");
}
#define HBAR() half_bar(cnt, target, lane)

struct Params {
  const float *x, *norm1_g, *w_in, *lam_q1, *lam_k1, *lam_q2, *lam_k2, *subln_g, *conv_dw_w, *conv_dw_b, *conv_ln_g, *conv_ln_b,
      *conv_pw_w, *conv_pw_b, *fnet_w, *fnet_b, *sgu_ln_g, *sgu_ln_b, *sgu_w, *sgu_b, *w_out, *norm2_g, *w_up, *w_down, *final_g;
  float* out;
  bf16_t *WallT, *WoutT, *WupT, *WdownT, *pwT, *sguW, *M1, *M3, *xn, *h, *Vt, *PQt, *y, *hid;
  float* lam;
  float* TW;
  float* part;
  int* ctr;
  unsigned* barw;
};

constexpr int HALF_B = 72960;
constexpr int SMEM_BYTES = 2 * HALF_B + 256;
constexpr int HALF_E = HALF_B / 2;
__shared__ __attribute__((aligned(16))) unsigned char smem_raw[SMEM_BYTES];
#define SMEM ((bf16_t*)smem_raw)
#define NI __device__ __forceinline__
DI int otid() { int t = threadIdx.x; asm volatile("" : "+v"(t)); return t; }
#define KPARAMS const Params& p = *(const Params*)__builtin_amdgcn_kernarg_segment_ptr()

namespace pg8 {
#define PG8_LAS __attribute__((address_space(3)))
typedef unsigned short bf16_t;
typedef short bf16x8 __attribute__((ext_vector_type(8)));
typedef float f32x4 __attribute__((ext_vector_type(4)));
typedef unsigned u32x4 __attribute__((ext_vector_type(4)));
constexpr int BM = 256, BK = 64, HALF = 128, HTB = HALF * BK * 2  , STAGE_BYTES = 8 * HTB, NXCD = 8, WGM = 8;

__host__ __device__ __forceinline__ int lds_byte(int r, int c) { const int st = (r >> 4) * 2 + (c >> 5), rr = r & 15, cc = c & 31, ob = rr * 64 + cc * 2; return st * 1024 + (ob ^ (((ob >> 9) & 1) << 5)); }
__host__ __device__ __forceinline__ void stage_rc(int b, int& R, int& C) { const int st = b / 1024, sb = b % 1024, swz = sb ^ (((sb >> 9) & 1) << 5); R = (st >> 1) * 16 + swz / 64; C = (st & 1) * 32 + (swz % 64) / 2; }
__host__ __device__ __forceinline__ int perm32(int rho) { const int n = rho >> 4, i = rho & 15; return 8 * (i >> 2) + 4 * n + (i & 3); }

struct Unit { int pm, pn; };
struct Gemm { const bf16_t* A; const bf16_t* Bt; int M, N, K; };

struct StaticOrder {
    int nM, nN, nwg, G, c;
    __host__ __device__ void init(int M, int N, int G_, int c_) { nM = M / BM; nN = N / BM; nwg = nM * nN; G = G_; c = c_; }
    __host__ __device__ bool next(int i, Unit& u) const {
        const long L = (long)i * G + c; if (L >= nwg) return false;
        int wgid = (int)L; { const int q = nwg / NXCD, r = nwg % NXCD, xcd = wgid % NXCD, off = wgid / NXCD; wgid = (xcd < r ? xcd * (q + 1) : r * (q + 1) + (xcd - r) * q) + off; }
        const int nig = WGM * nN, gid = wgid / nig, fm = gid * WGM, gsz = (nM - fm) < WGM ? (nM - fm) : WGM;
        u.pm = fm + ((wgid % nig) % gsz); u.pn = (wgid % nig) / gsz; return true;
    }
    __device__ __forceinline__ void a_ready(const Unit&) const {}
    __device__ __forceinline__ void done(const Unit&) const {}
};
template <class Epi, class Sched, bool ALIGN_EPI = false, bool SP2 = false>
__device__ __forceinline__ void gemm_phase(PG8_LAS unsigned char* lds, const Gemm g, const Sched& S, const Epi& E) {
    const int tid = otid(), wid = __builtin_amdgcn_readfirstlane(tid >> 6), lane = tid & 63, wr = wid >> 2, wc = wid & 3, fr = lane & 15, fq = lane >> 4;
    const int K = g.K, nt = K / BK;
    unsigned voffA[2], voffB[2];
#pragma unroll
    for (int i = 0; i < 2; ++i) { int R, C; stage_rc(tid * 16 + i * 8192, R, C); const int Rb = Epi::PERM ? ((R & ~31) + perm32(R & 31)) : R;
        voffA[i] = (unsigned)(R * K + C) * 2u; voffB[i] = (unsigned)(Rb * K + C) * 2u; }
    const size_t kstep = (size_t)(BK * 2);
    const size_t hstep = (size_t)HALF * K * 2;
    const size_t tstep = 2 * hstep;
    const unsigned ldsw = (unsigned)wid * 1024u;
    const int aoff = lds_byte(wr * 64 + fr, fq * 8), boff = lds_byte(wc * 32 + fr, fq * 8);
#define PG8_SA(b, h) (((b) * 2 + (h)) * HTB)
#define PG8_SB(b, h) ((4 + (b) * 2 + (h)) * HTB)
#define PG8_STAGE(bufoff, gbase, voff) do { _Pragma("unroll") for (int _i = 0; _i < 2; ++_i) \
        __builtin_amdgcn_global_load_lds((const unsigned*)((const char*)(gbase) + (voff)[_i]), (PG8_LAS unsigned*)(lds + (bufoff) + ldsw + _i * 8192), 16, 0, 0); } while (0)
#define PG8_LDA(dst, b, h) do { _Pragma("unroll") for (int m = 0; m < 4; ++m) _Pragma("unroll") for (int k = 0; k < 2; ++k) dst[m][k] = *(const PG8_LAS bf16x8*)(lds + PG8_SA(b, h) + aoff + m * 2048 + k * 1024); } while (0)
#define PG8_LDB(dst, b, h) do { _Pragma("unroll") for (int n = 0; n < 2; ++n) _Pragma("unroll") for (int k = 0; k < 2; ++k) dst[n][k] = *(const PG8_LAS bf16x8*)(lds + PG8_SB(b, h) + boff + n * 2048 + k * 1024); } while (0)
#define PG8_MMA(ai, bj, At, Bt) do { __builtin_amdgcn_s_setprio(1); _Pragma("unroll") for (int m = 0; m < 4; ++m) _Pragma("unroll") for (int n = 0; n < 2; ++n) _Pragma("unroll") for (int k = 0; k < 2; ++k) \
        acc[ai][bj][m][n] = __builtin_amdgcn_mfma_f32_16x16x32_bf16(Bt[n][k], At[m][k], acc[ai][bj][m][n], 0, 0, 0); __builtin_amdgcn_s_setprio(0); } while (0)
#define PG8_WAIT_V(n) asm volatile("s_waitcnt vmcnt(" #n ")" ::: "memory")
#define PG8_WAIT_L(n) asm volatile("s_waitcnt lgkmcnt(" #n ")" ::: "memory")
#define PG8_BAR __builtin_amdgcn_s_barrier()
#define PG8_SCHED __builtin_amdgcn_sched_barrier(0)
    Unit cur, nxt; int ui = 0;
    if (!S.next(0, cur)) return;
    f32x4 acc[2][2][4][2];
#pragma unroll
    for (int a = 0; a < 2; ++a)
#pragma unroll
        for (int b = 0; b < 2; ++b)
#pragma unroll
            for (int m = 0; m < 4; ++m)
#pragma unroll
                for (int n = 0; n < 2; ++n) acc[a][b][m][n] = (f32x4){0.f, 0.f, 0.f, 0.f};
    bf16x8 At[4][2], B0[2][2], B1[2][2];
    const char* cA = (const char*)g.A + (size_t)cur.pm * tstep; const char* cB = (const char*)g.Bt + (size_t)cur.pn * tstep;
    S.a_ready(cur);
    if constexpr (SP2) {
        PG8_STAGE(PG8_SB(0, 0), cB, voffB); PG8_STAGE(PG8_SB(0, 1), cB + hstep, voffB); PG8_STAGE(PG8_SA(0, 0), cA, voffA); PG8_STAGE(PG8_SA(0, 1), cA + hstep, voffA);
        if (wr == 1) PG8_BAR;
        PG8_WAIT_V(2); PG8_BAR;
        PG8_STAGE(PG8_SB(1, 0), cB + kstep, voffB); PG8_STAGE(PG8_SA(1, 0), cA + kstep, voffA); PG8_STAGE(PG8_SB(1, 1), cB + hstep + kstep, voffB);
        PG8_WAIT_V(6); PG8_BAR;
    } else {
        PG8_STAGE(PG8_SB(0, 0), cB, voffB); PG8_STAGE(PG8_SA(0, 0), cA, voffA); PG8_STAGE(PG8_SB(0, 1), cB + hstep, voffB); PG8_STAGE(PG8_SA(0, 1), cA + hstep, voffA);
        if (wr == 1) PG8_BAR;
        PG8_WAIT_V(4); PG8_BAR;
        PG8_STAGE(PG8_SB(1, 0), cB + kstep, voffB); PG8_STAGE(PG8_SA(1, 0), cA + kstep, voffA); PG8_STAGE(PG8_SB(1, 1), cB + hstep + kstep, voffB);
        PG8_WAIT_V(6); PG8_BAR;
    }
    for (;;) {
        const bool has_next = S.next(ui + 1, nxt);
        const char* nA = has_next ? (const char*)g.A + (size_t)nxt.pm * tstep : cA; const char* nB = has_next ? (const char*)g.Bt + (size_t)nxt.pn * tstep : cB;
        for (int t = 0; t < nt; t += 2) {
            const bool last = (t == nt - 2);
            const char* a1 = cA + (size_t)(t + 1) * kstep;
            const char* a2 = last ? nA : cA + (size_t)(t + 2) * kstep; const char* b2 = last ? nB : cB + (size_t)(t + 2) * kstep;
            const char* a3 = a2 + kstep; const char* b3 = b2 + kstep;
            if (last && has_next) S.a_ready(nxt);
            if constexpr (SP2) {
            PG8_LDB(B0, 0, 0); PG8_LDB(B1, 0, 1); PG8_SCHED; PG8_LDA(At, 0, 0); PG8_STAGE(PG8_SA(1, 1), a1 + hstep, voffA);
            PG8_WAIT_V(8); PG8_WAIT_L(0); PG8_BAR; PG8_MMA(0, 0, At, B0); PG8_MMA(0, 1, At, B1); PG8_BAR; PG8_SCHED;
            PG8_LDA(At, 0, 1); PG8_STAGE(PG8_SB(0, 0), b2, voffB); PG8_STAGE(PG8_SB(0, 1), b2 + hstep, voffB); PG8_STAGE(PG8_SA(0, 0), a2, voffA);
            PG8_WAIT_V(8); PG8_WAIT_L(0); PG8_BAR; PG8_MMA(1, 0, At, B0); PG8_MMA(1, 1, At, B1); PG8_BAR; PG8_SCHED;
            PG8_LDB(B0, 1, 0); PG8_LDB(B1, 1, 1); PG8_SCHED; PG8_LDA(At, 1, 0); PG8_STAGE(PG8_SA(0, 1), a2 + hstep, voffA);
            PG8_WAIT_V(8); PG8_WAIT_L(0); PG8_BAR; PG8_MMA(0, 0, At, B0); PG8_MMA(0, 1, At, B1); PG8_BAR; PG8_SCHED;
            PG8_LDA(At, 1, 1); PG8_STAGE(PG8_SB(1, 0), b3, voffB); PG8_STAGE(PG8_SB(1, 1), b3 + hstep, voffB); PG8_STAGE(PG8_SA(1, 0), a3, voffA);
            PG8_WAIT_V(8); PG8_WAIT_L(0); PG8_BAR; PG8_MMA(1, 0, At, B0); PG8_MMA(1, 1, At, B1); PG8_BAR; PG8_SCHED;
            } else {
            PG8_LDB(B0, 0, 0); PG8_SCHED; PG8_LDA(At, 0, 0); PG8_STAGE(PG8_SA(1, 1), a1 + hstep, voffA);
            PG8_WAIT_L(8); PG8_BAR; PG8_WAIT_L(0); PG8_MMA(0, 0, At, B0); PG8_BAR; PG8_SCHED;
            PG8_LDB(B1, 0, 1); PG8_STAGE(PG8_SB(0, 0), b2, voffB);
            PG8_BAR; PG8_WAIT_L(0); PG8_MMA(0, 1, At, B1); PG8_BAR;
            PG8_LDA(At, 0, 1); PG8_STAGE(PG8_SA(0, 0), a2, voffA);
            PG8_BAR; PG8_WAIT_L(0); PG8_MMA(1, 0, At, B0); PG8_BAR; PG8_SCHED;
            PG8_STAGE(PG8_SB(0, 1), b2 + hstep, voffB);
            PG8_WAIT_V(6); PG8_BAR; PG8_MMA(1, 1, At, B1); PG8_BAR;
            PG8_LDB(B0, 1, 0); PG8_SCHED; PG8_LDA(At, 1, 0); PG8_STAGE(PG8_SA(0, 1), a2 + hstep, voffA);
            PG8_WAIT_L(8); PG8_BAR; PG8_WAIT_L(0); PG8_MMA(0, 0, At, B0); PG8_BAR; PG8_SCHED;
            PG8_LDB(B1, 1, 1); PG8_STAGE(PG8_SB(1, 0), b3, voffB);
            PG8_BAR; PG8_WAIT_L(0); PG8_MMA(0, 1, At, B1); PG8_BAR;
            PG8_LDA(At, 1, 1); PG8_STAGE(PG8_SA(1, 0), a3, voffA);
            PG8_BAR; PG8_WAIT_L(0); PG8_MMA(1, 0, At, B0); PG8_BAR; PG8_SCHED;
            PG8_STAGE(PG8_SB(1, 1), b3 + hstep, voffB);
            PG8_WAIT_V(6); PG8_BAR; PG8_MMA(1, 1, At, B1); PG8_BAR;
            }
        }
        if constexpr (ALIGN_EPI) { if (wr == 0) PG8_BAR; }
        if constexpr (!Epi::AFTER_DRAIN) { E(acc, cur, wr, wc, fr, fq); S.done(cur); }
        if (!has_next) break;
#pragma unroll
        for (int a = 0; a < 2; ++a)
#pragma unroll
            for (int b = 0; b < 2; ++b)
#pragma unroll
                for (int m = 0; m < 4; ++m)
#pragma unroll
                    for (int n = 0; n < 2; ++n) acc[a][b][m][n] = (f32x4){0.f, 0.f, 0.f, 0.f};
        cur = nxt; cA = nA; cB = nB; ++ui;
        if constexpr (ALIGN_EPI) { if (wr == 1) PG8_BAR; }
    }
    PG8_WAIT_V(0);
    if constexpr (!ALIGN_EPI) { if (wr == 0) PG8_BAR; }
    PG8_BAR;
    if constexpr (Epi::AFTER_DRAIN) { E.fused(acc, cur, wr, wc, fr, fq, lds, wid, lane); S.done(cur); }
#undef PG8_SA
#undef PG8_SB
#undef PG8_STAGE
#undef PG8_LDA
#undef PG8_LDB
#undef PG8_MMA
#undef PG8_WAIT_V
#undef PG8_WAIT_L
#undef PG8_BAR
#undef PG8_SCHED
}
}

template <class F> struct Epi8 {
  static constexpr bool PERM = true, AFTER_DRAIN = false;
  F f;
  DI void operator()(const pg8::f32x4 (&acc)[2][2][4][2], const pg8::Unit& u, int wr, int wc, int fr, int fq) const {
#pragma unroll
    for (int ai = 0; ai < 2; ++ai)
#pragma unroll
      for (int m = 0; m < 4; ++m) {
        const int row = u.pm * 256 + ai * 128 + wr * 64 + m * 16 + fr;
#pragma unroll
        for (int bj = 0; bj < 2; ++bj) f.st(row, u.pn * 256 + bj * 128 + wc * 32 + 8 * fq, acc[ai][bj][m][0], acc[ai][bj][m][1]);
      }
  }
};
#define LDSP ((__attribute__((address_space(3))) unsigned char*)smem_raw)
DI float row_rs(const float* __restrict__ part, int row) {
  const f32x4 a = *(const f32x4*)(part + (long)row * 16), b = *(const f32x4*)(part + (long)row * 16 + 4), c = *(const f32x4*)(part + (long)row * 16 + 8), d = *(const f32x4*)(part + (long)row * 16 + 12);
  const f32x4 s = (a + b) + (c + d);
  return rsqrtf(((s[0] + s[1]) + (s[2] + s[3])) * (1.f / 1024.f) + EPS);
}
template <class F> struct Epi8Rows {
  static constexpr bool PERM = true, AFTER_DRAIN = false;
  F f; const float* part;
  DI void operator()(const pg8::f32x4 (&acc)[2][2][4][2], const pg8::Unit& u, int wr, int wc, int fr, int fq) const {
    const int x32 = (((fq * 16 + fr) ^ 32) << 2);
#pragma unroll
    for (int ai = 0; ai < 2; ++ai)
#pragma unroll
      for (int m = 0; m < 4; ++m) {
        const int row = u.pm * 256 + ai * 128 + wr * 64 + m * 16 + fr;
        const f32x4 pp = *(const f32x4*)(part + (long)row * 16 + fq * 4);
        float sq = (pp[0] + pp[1]) + (pp[2] + pp[3]);
        sq += __builtin_bit_cast(float, __builtin_amdgcn_ds_swizzle(__builtin_bit_cast(int, sq), 0x401f));
        sq += xch32(sq, x32);
        const float rs = rsqrtf(sq * (1.f / 1024.f) + EPS);
#pragma unroll
        for (int bj = 0; bj < 2; ++bj) f.st(row, u.pn * 256 + bj * 128 + wc * 32 + 8 * fq, acc[ai][bj][m][0] * rs, acc[ai][bj][m][1] * rs);
      }
  }
};
template <class F> struct Epi8Cols {
  static constexpr bool PERM = true, AFTER_DRAIN = false;
  F f; const float* part;
  DI void operator()(const pg8::f32x4 (&acc)[2][2][4][2], const pg8::Unit& u, int wr, int wc, int fr, int fq) const {
    f32x4 r0[2], r1[2];
    const float rsl = row_rs(part, u.pn * 256 + (fr >> 3) * 128 + wc * 32 + 8 * fq + (fr & 7));
#pragma unroll
    for (int bj = 0; bj < 2; ++bj)
#pragma unroll
      for (int j = 0; j < 4; ++j) {
        r0[bj][j] = __builtin_bit_cast(float, __builtin_amdgcn_ds_bpermute(4 * (fq * 16 + bj * 8 + j), __builtin_bit_cast(int, rsl)));
        r1[bj][j] = __builtin_bit_cast(float, __builtin_amdgcn_ds_bpermute(4 * (fq * 16 + bj * 8 + 4 + j), __builtin_bit_cast(int, rsl)));
      }
#pragma unroll
    for (int ai = 0; ai < 2; ++ai)
#pragma unroll
      for (int m = 0; m < 4; ++m) {
        const int row = u.pm * 256 + ai * 128 + wr * 64 + m * 16 + fr;
#pragma unroll
        for (int bj = 0; bj < 2; ++bj) f.st(row, u.pn * 256 + bj * 128 + wc * 32 + 8 * fq, acc[ai][bj][m][0] * r0[bj], acc[ai][bj][m][1] * r1[bj]);
      }
  }
};
struct Epi8Res {
  static constexpr bool PERM = true, AFTER_DRAIN = false;
  bf16_t* xb; float* part; float accscale;
  DI void operator()(const pg8::f32x4 (&acc)[2][2][4][2], const pg8::Unit& u, int wr, int wc, int fr, int fq) const {
    const int x32 = (((fq * 16 + fr) ^ 32) << 2);
#pragma unroll
    for (int ai = 0; ai < 2; ++ai)
#pragma unroll
      for (int m = 0; m < 4; ++m) {
        const int row = u.pm * 256 + ai * 128 + wr * 64 + m * 16 + fr;
        float ss = 0.f;
#pragma unroll
        for (int bj = 0; bj < 2; ++bj) {
          const long o = (long)row * DM + u.pn * 256 + bj * 128 + wc * 32 + 8 * fq;
          const u32x4 xr = *(const u32x4*)(xb + o);
          f32x4 v0, v1;
          v0[0] = bflo(xr[0]); v0[1] = bfhi(xr[0]); v0[2] = bflo(xr[1]); v0[3] = bfhi(xr[1]);
          v1[0] = bflo(xr[2]); v1[1] = bfhi(xr[2]); v1[2] = bflo(xr[3]); v1[3] = bfhi(xr[3]);
          v0 = v0 + acc[ai][bj][m][0] * accscale; v1 = v1 + acc[ai][bj][m][1] * accscale;
          u32x4 w; w[0] = pk2(v0[0], v0[1]); w[1] = pk2(v0[2], v0[3]); w[2] = pk2(v1[0], v1[1]); w[3] = pk2(v1[2], v1[3]);
          *(u32x4*)(xb + o) = w;
          ss += (v0[0] * v0[0] + v0[1] * v0[1]) + (v0[2] * v0[2] + v0[3] * v0[3]) + (v1[0] * v1[0] + v1[1] * v1[1]) + (v1[2] * v1[2] + v1[3] * v1[3]);
        }
        ss += __builtin_bit_cast(float, __builtin_amdgcn_ds_swizzle(__builtin_bit_cast(int, ss), 0x401f));
        ss += xch32(ss, x32);
        if (fq == 0) part[(long)row * 16 + u.pn * 4 + wc] = ss;
      }
  }
};
template <class E> DI void run_gemm_e(const bf16_t* A, const bf16_t* Bt, int M, int N, int K, const E& e) {
  pg8::Gemm g{A, Bt, M, N, K};
  pg8::StaticOrder so; so.init(M, N, (int)gridDim.x, (int)blockIdx.x);
  pg8::gemm_phase<E, pg8::StaticOrder, true, true>(LDSP, g, so, e);
}
template <class F> DI void run_gemm(const bf16_t* A, const bf16_t* Bt, int M, int N, int K, const F& f) {
  pg8::Gemm g{A, Bt, M, N, K};
  pg8::StaticOrder so; so.init(M, N, (int)gridDim.x, (int)blockIdx.x);
  Epi8<F> e{f};
  pg8::gemm_phase<Epi8<F>, pg8::StaticOrder, true, true>(LDSP, g, so, e);
}
struct OneUnit { int pm, pn;
  DI bool next(int i, pg8::Unit& u) const { if (i) return false; u.pm = pm; u.pn = pn; return true; }
  DI void a_ready(const pg8::Unit&) const {}
  DI void done(const pg8::Unit&) const {} };

DI void tr_tile(const float* __restrict__ src, int lds_, int k0, int n0, bf16_t* __restrict__ dst, int ldd, int nd0, float scale, float* sm, const float* __restrict__ gk = nullptr) {
  const int t = otid() & 255;
  f32x4 v[8];
#pragma unroll
  for (int i = 0; i < 8; ++i) {
    const int kr = (t >> 4) + 16 * i, nc = (t & 15) * 4;
    v[i] = *(const f32x4*)(src + (long)(k0 + kr) * lds_ + n0 + nc);
    if (gk) v[i] = v[i] * gk[k0 + kr];
  }
#pragma unroll
  for (int i = 0; i < 8; ++i) {
    const int kr = (t >> 4) + 16 * i, nc = (t & 15) * 4;
    sm[kr * 65 + nc + 0] = v[i][0]; sm[kr * 65 + nc + 1] = v[i][1]; sm[kr * 65 + nc + 2] = v[i][2]; sm[kr * 65 + nc + 3] = v[i][3];
  }
  __syncthreads();
  const int n = t >> 2, ks = (t & 3) * 32;
  bf16_t* d = dst + (long)(nd0 + n) * ldd + k0 + ks;
#pragma unroll
  for (int q = 0; q < 4; ++q) {
    u32x4 w;
#pragma unroll
    for (int j = 0; j < 4; ++j) w[j] = pk2(sm[(ks + 8 * q + 2 * j) * 65 + n] * scale, sm[(ks + 8 * q + 2 * j + 1) * 65 + n] * scale);
    *(u32x4*)(d + 8 * q) = w;
  }
  __syncthreads();
}

constexpr int NT_ALL = DEPTH * 28 * 8, NT_OUT = DEPTH * 16 * 8, NT_UP = DEPTH * 64 * 8, NT_DOWN = DEPTH * 16 * 32, NT_PW = DEPTH * 4 * 2;
constexpr int N_FOLD = DEPTH * 2 * 4 * 4, N_SGU = 128, N_DM = 112, N_LAM = 1;
constexpr int PREP_ITEMS = NT_ALL + NT_OUT + NT_UP + NT_DOWN + NT_PW + N_FOLD + N_SGU + N_DM + N_LAM;

DI void prep_item(const Params& p, int it, float* sm) {
  const int t = otid() & 255;
  if (it < NT_ALL) {
    const int l = it / (28 * 8), rem = it % (28 * 8), nt = rem / 8, kt = rem % 8;
    const int nd = nt * 64;
    int nsrc; float scale = 1.f;
    if (nd < 512) { nsrc = nd; if (nd < 256) scale = 0.17677669529663687f * LOG2E; }
    else if (nd < 1024) nsrc = 768 + (nd - 512);
    else if (nd < 1536) nsrc = 1536 + (nd - 1024);
    else nsrc = 512 + (nd - 1536);
    tr_tile(p.w_in + (long)l * DM * 2048, 2048, kt * 128, nsrc, p.WallT + (long)l * WALL_N * DM, DM, nd, scale, sm, p.norm1_g + l * DM);
    return;
  }
  it -= NT_ALL;
  if (it < NT_OUT) {
    const int l = it / 128, rem = it % 128, nt = rem / 8, kt = rem % 8;
    tr_tile(p.w_out + (long)l * DM * DM, DM, kt * 128, nt * 64, p.WoutT + (long)l * DM * DM, DM, nt * 64, 1.f, sm);
    return;
  }
  it -= NT_OUT;
  if (it < NT_UP) {
    const int l = it / 512, rem = it % 512, nt = rem / 8, kt = rem % 8;
    tr_tile(p.w_up + (long)l * DM * DFF, DFF, kt * 128, nt * 64, p.WupT + (long)l * DFF * DM, DM, nt * 64, 1.f, sm, p.norm2_g + l * DM);
    return;
  }
  it -= NT_UP;
  if (it < NT_DOWN) {
    const int l = it / 512, rem = it % 512, nt = rem / 32, kt = rem % 32;
    tr_tile(p.w_down + (long)l * DFF * DM, DM, kt * 128, nt * 64, p.WdownT + (long)l * DM * DFF, DFF, nt * 64, 1.f, sm);
    return;
  }
  it -= NT_DOWN;
  if (it < NT_PW) {
    const int l = it / 8, rem = it % 8, nt = rem / 2, kt = rem % 2;
    tr_tile(p.conv_pw_w + (long)l * 65536, 256, kt * 128, nt * 64, p.pwT + (long)l * 65536, 256, nt * 64, 1.f, sm);
    return;
  }
  it -= NT_PW;
  if (it < N_FOLD) {
    const int l = it >> 5, pq = (it >> 4) & 1, g = (it >> 2) & 3, kcn = it & 3;
    const float* fw = p.fnet_w + ((long)l * 4 + g) * 4096;
    float* trig = sm + 4096;
    if (t < 64) trig[t] = pq ? sinpif((float)t * (1.f / 32.f)) : cospif((float)t * (1.f / 32.f));
    __syncthreads();
    for (int idx = t; idx < 4096; idx += 256) {
      const int c = idx >> 6, e = idx & 63;
      float s = 0.f;
      for (int kc = 0; kc < 64; ++kc) s += trig[(c * kc) & 63] * fw[kc * 64 + e];
      sm[idx] = s * (1.f / 512.f);
    }
    __syncthreads();
    const int k = kcn * 256 + t;
    const float gk1 = p.norm1_g[l * DM + k];
    const float* wr = p.w_in + (long)l * DM * 2048 + (long)k * 2048 + 1280 + g * 64;
    f32x4 wv[16];
#pragma unroll
    for (int i = 0; i < 16; ++i) wv[i] = *(const f32x4*)(wr + 4 * i);
    bf16_t* dst = p.WallT + (long)l * WALL_N * DM + (long)(1792 + pq * 256 + g * 64) * DM + k;
#pragma unroll 1
    for (int e = 0; e < 64; ++e) {
      float s = 0.f;
#pragma unroll
      for (int i = 0; i < 16; ++i) {
        s += wv[i][0] * sm[(4 * i + 0) * 64 + e]; s += wv[i][1] * sm[(4 * i + 1) * 64 + e];
        s += wv[i][2] * sm[(4 * i + 2) * 64 + e]; s += wv[i][3] * sm[(4 * i + 3) * 64 + e];
      }
      dst[(long)e * DM] = (bf16_t)(pk2(s * gk1, 0.f) & 0xffffu);
    }
    __syncthreads();
    return;
  }
  it -= N_FOLD;
  if (it < N_SGU) {
    const long o = (long)it * 2048 + t * 8;
    const f32x4 a = *(const f32x4*)(p.sgu_w + o), b = *(const f32x4*)(p.sgu_w + o + 4);
    u32x4 w; w[0] = pk2(a[0], a[1]); w[1] = pk2(a[2], a[3]); w[2] = pk2(b[0], b[1]); w[3] = pk2(b[2], b[3]);
    *(u32x4*)(p.sguW + o) = w;
    return;
  }
  it -= N_SGU;
  if (it < N_DM) {
    const int e = it * 256 + t;
    if (e < 16384) {
      const int m = e >> 7, k = e & 127, ro = m >> 6, k1 = m & 63, ri = k >> 6, s1 = k & 63;
      const float ang = (float)((s1 * k1) & 63) * (1.f / 32.f);
      const float c = cospif(ang), sn = sinpif(ang);
      const float v = (ro == 0) ? (ri == 0 ? c : -sn) : (ri == 0 ? sn : c);
      p.M1[e] = (bf16_t)(pk2(v, 0.f) & 0xffffu);
    } else if (e < 16384 + 8192) {
      const int e2 = e - 16384, k2 = e2 >> 7, k = e2 & 127, ri = k >> 6, s2 = k & 63;
      const float ang = (float)((s2 * k2) & 63) * (1.f / 32.f);
      const float v = (ri == 0) ? cospif(ang) : -sinpif(ang);
      p.M3[e2] = (bf16_t)(pk2(v, 0.f) & 0xffffu);
    } else {
      const int e3 = e - 16384 - 8192, k1 = e3 >> 6, s2 = e3 & 63;
      const float ang = (float)(s2 * k1) * (1.f / 2048.f);
      ((unsigned*)p.TW)[e3] = pk2(cospif(ang), sinpif(ang));
    }
    return;
  }
  it -= N_DM;
  if (t < DEPTH) {
    const int l = t;
    float s1 = 0.f, s2 = 0.f;
    for (int i = 0; i < 32; ++i) { s1 += p.lam_q1[l * 32 + i] * p.lam_k1[l * 32 + i]; s2 += p.lam_q2[l * 32 + i] * p.lam_k2[l * 32 + i]; }
    const float lam_init = 0.8f - 0.6f * expf(-0.3f * (float)l);
    p.lam[l] = expf(s1) - expf(s2) + lam_init;
  }
}

NI void prep_phase() {
  KPARAMS;
  const int half = otid() >> 8;
  float* sm = (float*)smem_raw + half * (HALF_E / 2);
  for (int it0 = blockIdx.x * 2 + half; it0 < PREP_ITEMS; it0 += gridDim.x * 2) prep_item(p, it0, sm);
  const int tid_ = otid(); const int lane = tid_ & 63, wid = tid_ >> 6, x32 = ((lane ^ 32) << 2);
  for (int row0 = blockIdx.x * 8 + wid; row0 < NTOK; row0 += gridDim.x * 16) {
    f32x4 v[2][4];
#pragma unroll
    for (int rr = 0; rr < 2; ++rr) {
      const int row = row0 + rr * gridDim.x * 8;
#pragma unroll
      for (int i = 0; i < 4; ++i) v[rr][i] = (row < NTOK) ? *(const f32x4*)(p.x + (long)row * DM + lane * 4 + 256 * i) : (f32x4){0.f, 0.f, 0.f, 0.f};
    }
#pragma unroll
    for (int rr = 0; rr < 2; ++rr) {
      const int row = row0 + rr * gridDim.x * 8;
      float ss = 0.f;
#pragma unroll
      for (int i = 0; i < 4; ++i) ss += v[rr][i][0] * v[rr][i][0] + v[rr][i][1] * v[rr][i][1] + v[rr][i][2] * v[rr][i][2] + v[rr][i][3] * v[rr][i][3];
      ss = wave_sum(ss, x32);
      if (row < NTOK) {
#pragma unroll
        for (int i = 0; i < 4; ++i) { u32x2 w; w[0] = pk2(v[rr][i][0], v[rr][i][1]); w[1] = pk2(v[rr][i][2], v[rr][i][3]); *(u32x2*)(p.xn + (long)row * DM + lane * 4 + 256 * i) = w; }
        if (lane < 16) p.part[(long)row * 16 + lane] = (lane == 0) ? ss : 0.f;
      }
    }
  }
}

NI void final_rms_phase(const bf16_t* __restrict__ src, const float* __restrict__ g, float* __restrict__ dstf) {
  const int tid_ = otid(); const int lane = tid_ & 63, wid = tid_ >> 6, x32 = ((lane ^ 32) << 2);
  f32x4 gv[4];
#pragma unroll
  for (int i = 0; i < 4; ++i) gv[i] = *(const f32x4*)(g + lane * 4 + 256 * i);
  for (int row = blockIdx.x * 8 + wid; row < NTOK; row += gridDim.x * 8) {
    f32x4 v[4];
    float ss = 0.f;
#pragma unroll
    for (int i = 0; i < 4; ++i) {
      const u32x2 r = *(const u32x2*)(src + (long)row * DM + lane * 4 + 256 * i);
      v[i][0] = bflo(r[0]); v[i][1] = bfhi(r[0]); v[i][2] = bflo(r[1]); v[i][3] = bfhi(r[1]);
      ss += v[i][0] * v[i][0] + v[i][1] * v[i][1] + v[i][2] * v[i][2] + v[i][3] * v[i][3];
    }
    ss = wave_sum(ss, x32);
    const float rs = rsqrtf(ss * (1.f / 1024.f) + EPS);
#pragma unroll
    for (int i = 0; i < 4; ++i) *(f32x4*)(dstf + (long)row * DM + lane * 4 + 256 * i) = v[i] * rs * gv[i];
  }
}

DI u32x4 pk8(f32x4 a, f32x4 b) { u32x4 w; w[0] = pk2(a[0], a[1]); w[1] = pk2(a[2], a[3]); w[2] = pk2(b[0], b[1]); w[3] = pk2(b[2], b[3]); return w; }
struct StH { bf16_t* h; DI void st(int r, int c, f32x4 a, f32x4 b) const { *(u32x4*)(h + (long)r * HC + c) = pk8(a, b); } };
struct StT { bf16_t* Vt; bf16_t* PQt;
  DI void st(int n, int tok, f32x4 a, f32x4 b) const {
    const int bb = tok >> 12, s = tok & 4095; const u32x4 w = pk8(a, b);
    if (n < 256) *(u32x4*)(Vt + ((long)(bb * 256 + n)) * 4096 + s) = w;
    else { const int np = n - 256, pq = np >> 8, ch = np & 255; *(u32x4*)(PQt + ((long)(bb * 256 + ch)) * 8192 + pq * 4096 + s) = w; }
  } };
struct StRes { const float* xin; float* out;
  DI void st(int r, int c, f32x4 a, f32x4 b) const { const long o = (long)r * DM + c; const f32x4 x0 = *(const f32x4*)(xin + o), x1 = *(const f32x4*)(xin + o + 4); *(f32x4*)(out + o) = x0 + a; *(f32x4*)(out + o + 4) = x1 + b; } };
struct StUp { bf16_t* hid;
  DI void st(int r, int c, f32x4 a, f32x4 b) const {
#pragma unroll
    for (int j = 0; j < 4; ++j) { a[j] = fmaxf(a[j], 0.f); b[j] = fmaxf(b[j], 0.f); }
    *(u32x4*)(hid + (long)r * DFF + c) = pk8(a * a, b * b); } };

NI void gemm_in_phase(int l) {
  KPARAMS;
  const bf16_t* W = p.WallT + (long)l * WALL_N * DM;
  run_gemm_e(p.xn, W, NTOK, HC, DM, Epi8Rows<StH>{StH{p.h}, p.part});
  run_gemm_e(W + (long)HC * DM, p.xn, 768, NTOK, DM, Epi8Cols<StT>{StT{p.Vt, p.PQt}, p.part});
}
NI void gemm_out_phase(int l, float accscale) {
  KPARAMS;
  run_gemm_e(p.y, p.WoutT + (long)l * DM * DM, NTOK, DM, DM, Epi8Res{p.xn, p.part, accscale});
}
NI void gemm_up_phase(int l) {
  KPARAMS;
  run_gemm_e(p.xn, p.WupT + (long)l * DFF * DM, NTOK, DFF, DM, Epi8Rows<StUp>{StUp{p.hid}, p.part});
}
NI void gemm_down_phase(int l, float accscale) {
  KPARAMS;
  run_gemm_e(p.hid, p.WdownT + (long)l * DM * DFF, NTOK, DM, DFF, Epi8Res{p.xn, p.part, accscale});
}

constexpr int ARS = 72;
constexpr int ATILE = 64 * ARS;
NI void attn_tile(int l, int id, LAS3 unsigned* cnt, unsigned& target) {
  KPARAMS;
  const int tidf = otid(), half = __builtin_amdgcn_readfirstlane(tidf >> 8), tid = tidf & 255, lane = tid & 63, wid = __builtin_amdgcn_readfirstlane(tid >> 6), r = lane & 31, hh = lane >> 5, x32 = ((lane ^ 32) << 2);
  bf16_t* smem = SMEM + half * HALF_E;
  const int head = 3 - (id >> 8), b = (id >> 5) & 7, qb = id & 31;
  const float slope = (head == 0) ? 0.25f : (head == 1) ? 0.0625f : (head == 2) ? 0.015625f : 0.00390625f;
  const float ncs = -slope * LOG2E, cs = slope * LOG2E;
  const int qi = qb * 128 + wid * 32 + r;
  const bf16_t* qrow = p.h + ((long)(b * SEQ + qi)) * HC + head * 64;
  bf16x8 qf[2][2];
#pragma unroll
  for (int m = 0; m < 2; ++m)
#pragma unroll
    for (int s = 0; s < 2; ++s) qf[m][s] = *(const bf16x8*)(qrow + m * 32 + s * 16 + hh * 8);
  const bf16_t* kbase = p.h + ((long)(b * SEQ)) * HC + 256 + head * 64;
  const bf16_t* vbase = p.Vt + ((long)((b * 4 + head) * 64)) * SEQ;
  const int srow = tid >> 3, scol = (tid & 7) * 8;
  u32x4 rk[2], rv[2];
  f32x16 O[2][2];
#pragma unroll
  for (int m = 0; m < 2; ++m)
#pragma unroll
    for (int vb = 0; vb < 2; ++vb)
#pragma unroll
      for (int i = 0; i < 16; ++i) O[m][vb][i] = 0.f;
  float mrun[2] = {0.f, 0.f}, lrun[2] = {0.f, 0.f};
  const int kperm = (r & 19) | ((r & 4) << 1) | ((r & 8) >> 1);
  const int ktd = (qb * 128 + wid * 32) >> 6;
  unsigned csw, jrelw[2];
  { const unsigned h_ = pk2(cs, 0.f) & 0xffffu; csw = h_ | (pk2(cs - bflo(h_), 0.f) << 16); }
#pragma unroll
  for (int kb = 0; kb < 2; ++kb) { const float j_ = (float)(kb * 32 + kperm); jrelw[kb] = pk2(j_, j_); }

  const int wkeys = (head == 0) ? 305 : (head == 1) ? 1220 : SEQ;
  const int kt_lo = max(0, qb * 128 - wkeys) >> 6, kt_hi = min(SEQ, qb * 128 + 128 + wkeys + 63) >> 6;
#pragma unroll
  for (int i = 0; i < 2; ++i) {
    rk[i] = *(const u32x4*)(kbase + (long)(kt_lo * 64 + srow + 32 * i) * HC + scol);
    rv[i] = *(const u32x4*)(vbase + (long)(srow + 32 * i) * SEQ + kt_lo * 64 + scol);
  }
#pragma unroll
  for (int i = 0; i < 2; ++i) { *(u32x4*)(smem + (srow + 32 * i) * ARS + scol) = rk[i]; *(u32x4*)(smem + ATILE + (srow + 32 * i) * ARS + scol) = rv[i]; }
  asm volatile("" :: "v"(qf[0][0]), "v"(qf[0][1]), "v"(qf[1][0]), "v"(qf[1][1]));
  HBAR();
  for (int kt = kt_lo; kt < kt_hi; ++kt) {
    const bool more = (kt + 1) < kt_hi;
    if (more) {
#pragma unroll
      for (int i = 0; i < 2; ++i) {
        rk[i] = *(const u32x4*)(kbase + (long)((kt + 1) * 64 + srow + 32 * i) * HC + scol);
        rv[i] = *(const u32x4*)(vbase + (long)(srow + 32 * i) * SEQ + (kt + 1) * 64 + scol);
      }
    }
    const bf16_t* Ks = smem + ((kt - kt_lo) & 1) * 2 * ATILE;
    const bf16_t* Vs = Ks + ATILE;
    const float dbase = (float)(qi - kt * 64 - 8 * hh);
    const bool diag = (kt == ktd);
#pragma unroll
    for (int m = 0; m < 2; ++m) {
      __builtin_amdgcn_sched_barrier(0);
      f32x16 x[2];
      if (!diag) {
        const bool left = kt < ktd;
        const float C = fmaf(left ? cs : -cs, (float)(kt * 64 - qi), -mrun[m]);
        const unsigned wC = pk2(C, 0.f), wL = pk2(C - bflo(wC), 0.f);
        u32x4 qa; qa[0] = hh ? 0u : (left ? csw : (csw ^ 0x80008000u)); qa[1] = hh ? 0u : ((wC & 0xffffu) | (wL << 16)); qa[2] = 0u; qa[3] = 0u;
#pragma unroll
        for (int kb = 0; kb < 2; ++kb) {
          u32x4 ka; ka[0] = hh ? 0u : jrelw[kb]; ka[1] = hh ? 0u : 0x3f803f80u; ka[2] = 0u; ka[3] = 0u;
#pragma unroll
          for (int i = 0; i < 16; ++i) x[kb][i] = 0.f;
          x[kb] = __builtin_amdgcn_mfma_f32_32x32x16_bf16(__builtin_bit_cast(bf16x8, ka), __builtin_bit_cast(bf16x8, qa), x[kb], 0, 0, 0);
#pragma unroll
          for (int s = 0; s < 2; ++s) {
            const bf16x8 kf = *(const bf16x8*)(Ks + (kb * 32 + kperm) * ARS + m * 32 + s * 16 + hh * 8);
            x[kb] = __builtin_amdgcn_mfma_f32_32x32x16_bf16(kf, qf[m][s], x[kb], 0, 0, 0);
          }
        }
      } else {
#pragma unroll
        for (int kb = 0; kb < 2; ++kb) {
#pragma unroll
          for (int i = 0; i < 16; ++i) x[kb][i] = 0.f;
#pragma unroll
          for (int s = 0; s < 2; ++s) {
            const bf16x8 kf = *(const bf16x8*)(Ks + (kb * 32 + kperm) * ARS + m * 32 + s * 16 + hh * 8);
            x[kb] = __builtin_amdgcn_mfma_f32_32x32x16_bf16(kf, qf[m][s], x[kb], 0, 0, 0);
          }
        }
        const float nm = -mrun[m];
#pragma unroll
        for (int kb = 0; kb < 2; ++kb)
#pragma unroll
          for (int i = 0; i < 16; ++i) {
            const float off = (float)(kb * 32 + 16 * (i >> 3) + (i & 7));
            x[kb][i] = fmaf(ncs, fabsf(dbase - off), x[kb][i]) + nm;
          }
      }
      float mx = -1e30f;
#pragma unroll
      for (int kb = 0; kb < 2; ++kb)
#pragma unroll
        for (int i = 0; i < 16; ++i) mx = fmaxf(mx, x[kb][i]);
      mx = fmaxf(mx, xch32(mx, x32));
      if (__builtin_amdgcn_ballot_w64(mx > 8.f) != 0ull) {
        const float delta = fmaxf(mx, 0.f);
        const float alpha = __builtin_amdgcn_exp2f(-delta);
        mrun[m] += delta;
        lrun[m] *= alpha;
#pragma unroll
        for (int vb = 0; vb < 2; ++vb)
#pragma unroll
          for (int i = 0; i < 16; ++i) O[m][vb][i] *= alpha;
#pragma unroll
        for (int kb = 0; kb < 2; ++kb)
#pragma unroll
          for (int i = 0; i < 16; ++i) x[kb][i] -= delta;
      }
      float ps = 0.f;
#pragma unroll
      for (int kb = 0; kb < 2; ++kb)
#pragma unroll
        for (int i = 0; i < 16; ++i) { x[kb][i] = __builtin_amdgcn_exp2f(x[kb][i]); ps += x[kb][i]; }
      lrun[m] += ps;
#pragma unroll
      for (int kb = 0; kb < 2; ++kb)
#pragma unroll
        for (int s = 0; s < 2; ++s) {
          u32x4 pw;
#pragma unroll
          for (int j = 0; j < 4; ++j) pw[j] = pk2(x[kb][8 * s + 2 * j], x[kb][8 * s + 2 * j + 1]);
          const bf16x8 pf = __builtin_bit_cast(bf16x8, pw);
#pragma unroll
          for (int vb = 0; vb < 2; ++vb) {
            const bf16x8 vf = *(const bf16x8*)(Vs + (vb * 32 + r) * ARS + kb * 32 + s * 16 + hh * 8);
            O[m][vb] = __builtin_amdgcn_mfma_f32_32x32x16_bf16(vf, pf, O[m][vb], 0, 0, 0);
          }
        }
    }
    if (more) {
      bf16_t* wk = smem + ((kt + 1 - kt_lo) & 1) * 2 * ATILE;
#pragma unroll
      for (int i = 0; i < 2; ++i) { *(u32x4*)(wk + (srow + 32 * i) * ARS + scol) = rk[i]; *(u32x4*)(wk + ATILE + (srow + 32 * i) * ARS + scol) = rv[i]; }
    }
    HBAR();
  }
  asm volatile("" ::: "memory");
  const int tid2 = otid() & 255, lane2 = tid2 & 63, hh2 = lane2 >> 5, qi2 = qb * 128 + __builtin_amdgcn_readfirstlane(tid2 >> 6) * 32 + (lane2 & 31);
  const float lam = p.lam[l];
  int lx = l; asm volatile("" : "+s"(lx));
  const float lam_init = (lx == 0) ? 0.2f : (lx == 1) ? 0.35550907f : (lx == 2) ? 0.47071302f : 0.55605820f;
  const float l1 = lrun[0] + xch32(lrun[0], x32), l2 = lrun[1] + xch32(lrun[1], x32);
  const float i1 = 1.f / l1, i2 = lam / l2;
  float ss = 0.f;
#pragma unroll
  for (int vb = 0; vb < 2; ++vb)
#pragma unroll
    for (int i = 0; i < 16; ++i) { const float o = O[0][vb][i] * i1 - O[1][vb][i] * i2; O[0][vb][i] = o; ss += o * o; }
  ss += xch32(ss, x32);
  const float rs = rsqrtf(ss * (1.f / 64.f) + EPS) * (1.f - lam_init);
  const float* sg = p.subln_g + l * 64;
  bf16_t* yrow = p.y + ((long)(b * SEQ + qi2)) * DM + head * 64;
#pragma unroll
  for (int vb = 0; vb < 2; ++vb)
#pragma unroll
    for (int g4 = 0; g4 < 4; ++g4) {
      const int vc = vb * 32 + 8 * g4 + 4 * hh2;
      const f32x4 gg = *(const f32x4*)(sg + vc);
      u32x2 w;
      w[0] = pk2(O[0][vb][4 * g4 + 0] * rs * gg[0], O[0][vb][4 * g4 + 1] * rs * gg[1]);
      w[1] = pk2(O[0][vb][4 * g4 + 2] * rs * gg[2], O[0][vb][4 * g4 + 3] * rs * gg[3]);
      *(u32x2*)(yrow + vc) = w;
    }
}

constexpr int ZRS = 264;
NI void conv_tile(int l, int id, LAS3 unsigned* cnt, unsigned& target) {
  KPARAMS;
  const int tidf = otid(), half = __builtin_amdgcn_readfirstlane(tidf >> 8), tid = tidf & 255, lane = tid & 63, wid = __builtin_amdgcn_readfirstlane(tid >> 6), x32 = ((lane ^ 32) << 2);
  bf16_t* smem = SMEM + half * HALF_E;
  const int b = id >> 6, t0 = (id & 63) * 64;
  for (int idx = tid; idx < 94 * 32; idx += 256) {
    const int row = idx >> 5, c8 = (idx & 31) * 8;
    const int tok = t0 - 15 + row;
    u32x4 w = (u32x4){0u, 0u, 0u, 0u};
    if (tok >= 0 && tok < SEQ) {
      const bf16_t* hp = p.h + ((long)(b * SEQ + tok)) * HC + 512 + c8;
      const u32x4 a = *(const u32x4*)hp, g = *(const u32x4*)(hp + 256);
#pragma unroll
      for (int j = 0; j < 4; ++j) {
        const float a0 = bflo(a[j]), a1 = bfhi(a[j]), g0 = bflo(g[j]), g1 = bfhi(g[j]);
        w[j] = pk2(a0 * __builtin_amdgcn_rcpf(1.f + __builtin_amdgcn_exp2f(-LOG2E * g0)), a1 * __builtin_amdgcn_rcpf(1.f + __builtin_amdgcn_exp2f(-LOG2E * g1)));
      }
    }
    *(u32x4*)(smem + row * ZRS + c8) = w;
  }
  HBAR();
  {
    const int c = tid;
    float wv[31];
#pragma unroll
    for (int j = 0; j < 31; ++j) wv[j] = p.conv_dw_w[((long)l * 31 + j) * 256 + c];
    const float cb = p.conv_dw_b[l * 256 + c], lg = p.conv_ln_g[l * 256 + c], lb = p.conv_ln_b[l * 256 + c];
#pragma unroll 1
    for (int ch = 0; ch < 8; ++ch) {
      float zw[38];
#pragma unroll
      for (int j = 0; j < 38; ++j) zw[j] = bf2f(smem[(ch * 8 + j) * ZRS + c]);
      float o[8];
#pragma unroll
      for (int tt = 0; tt < 8; ++tt) {
        float s = cb;
#pragma unroll
        for (int j = 0; j < 31; ++j) s = fmaf(wv[j], zw[tt + j], s);
        o[tt] = s;
      }
#pragma unroll
      for (int tt = 0; tt < 8; ++tt) {
        const float s1 = wave_sum(o[tt], x32), s2 = wave_sum(o[tt] * o[tt], x32);
        const float mu = s1 * (1.f / 64.f);
        const float var = fmaxf(s2 * (1.f / 64.f) - mu * mu, 0.f);
        const float yv = (o[tt] - mu) * rsqrtf(var + EPS) * lg + lb;
        const float sv = yv * __builtin_amdgcn_rcpf(1.f + __builtin_amdgcn_exp2f(-LOG2E * yv));
        smem[(ch * 8 + tt) * ZRS + c] = (bf16_t)(pk2(sv, 0.f) & 0xffffu);
      }
    }
  }
  HBAR();
  {
    const int fr = lane & 15, fq = lane >> 4;
    const bf16_t* W = p.pwT + (long)l * 65536 + (long)(wid * 64) * 256;
    f32x4 acc[4][4];
#pragma unroll
    for (int m = 0; m < 4; ++m)
#pragma unroll
      for (int n = 0; n < 4; ++n) acc[m][n] = (f32x4){0.f, 0.f, 0.f, 0.f};
#pragma unroll 2
    for (int ks = 0; ks < 8; ++ks) {
      bf16x8 af[4], bfr[4];
#pragma unroll
      for (int m = 0; m < 4; ++m) af[m] = *(const bf16x8*)(smem + (m * 16 + fr) * ZRS + ks * 32 + fq * 8);
#pragma unroll
      for (int n = 0; n < 4; ++n) bfr[n] = *(const bf16x8*)(W + (long)(n * 16 + fr) * 256 + ks * 32 + fq * 8);
#pragma unroll
      for (int m = 0; m < 4; ++m)
#pragma unroll
        for (int n = 0; n < 4; ++n) acc[m][n] = __builtin_amdgcn_mfma_f32_16x16x32_bf16(bfr[n], af[m], acc[m][n], 0, 0, 0);
    }
    const float* pb = p.conv_pw_b + l * 256;
#pragma unroll
    for (int m = 0; m < 4; ++m)
#pragma unroll
      for (int n = 0; n < 4; ++n) {
        const int tok = t0 + m * 16 + fr, col = wid * 64 + n * 16 + fq * 4;
        const f32x4 bv = *(const f32x4*)(pb + col);
        const f32x4 v = acc[m][n] + bv;
        u32x2 w; w[0] = pk2(v[0], v[1]); w[1] = pk2(v[2], v[3]);
        *(u32x2*)(p.y + ((long)(b * SEQ + tok)) * DM + 256 + col) = w;
      }
  }
  HBAR();
}

constexpr int VRS = 258;
NI void sgu_tile(int l, int id, LAS3 unsigned* cnt, unsigned& target) {
  KPARAMS;
  const int tidf = otid(), half = __builtin_amdgcn_readfirstlane(tidf >> 8), tid = tidf & 255, lane = tid & 63, wid = __builtin_amdgcn_readfirstlane(tid >> 6), x32 = ((lane ^ 32) << 2);
  bf16_t* smem = SMEM + half * HALF_E;
  const long T0 = (long)id * 128;
  {
    const f32x4 lg = *(const f32x4*)(p.sgu_ln_g + l * 256 + lane * 4), lb = *(const f32x4*)(p.sgu_ln_b + l * 256 + lane * 4);
#pragma unroll 4
    for (int i = 0; i < 32; ++i) {
      const int s = wid * 32 + i;
      const u32x2 raw = *(const u32x2*)(p.h + (T0 + s) * HC + 1280 + lane * 4);
      const float v0 = bflo(raw[0]), v1 = bfhi(raw[0]), v2 = bflo(raw[1]), v3 = bfhi(raw[1]);
      const float s1 = wave_sum(v0 + v1 + v2 + v3, x32);
      const float mu = s1 * (1.f / 256.f);
      const float d0 = v0 - mu, d1 = v1 - mu, d2 = v2 - mu, d3 = v3 - mu;
      const float s2 = wave_sum(d0 * d0 + d1 * d1 + d2 * d2 + d3 * d3, x32);
      const float rs = rsqrtf(s2 * (1.f / 256.f) + EPS);
      unsigned* dst = (unsigned*)(smem + s * VRS + lane * 4);
      dst[0] = pk2(d0 * rs * lg[0] + lb[0], d1 * rs * lg[1] + lb[1]);
      dst[1] = pk2(d2 * rs * lg[2] + lb[2], d3 * rs * lg[3] + lb[3]);
    }
  }
  HBAR();
  {
    const int fr = lane & 15, fq = lane >> 4, g = wid;
    const bf16_t* W = p.sguW + ((long)(l * 4 + g)) * 16384;
    const float* bs = p.sgu_b + ((long)(l * 4 + g)) * 128;
#pragma unroll 1
    for (int th = 0; th < 2; ++th) {
      f32x4 acc[4][4];
#pragma unroll
      for (int m = 0; m < 4; ++m)
#pragma unroll
        for (int n = 0; n < 4; ++n) acc[m][n] = (f32x4){0.f, 0.f, 0.f, 0.f};
#pragma unroll 1
      for (int ks = 0; ks < 4; ++ks) {
        bf16x8 vf[4], wf[4];
#pragma unroll
        for (int n = 0; n < 4; ++n) {
#pragma unroll
          for (int j = 0; j < 8; ++j) vf[n][j] = (short)smem[(ks * 32 + fq * 8 + j) * VRS + g * 64 + n * 16 + fr];
        }
#pragma unroll
        for (int m = 0; m < 4; ++m) wf[m] = *(const bf16x8*)(W + (long)(th * 64 + m * 16 + fr) * 128 + ks * 32 + fq * 8);
#pragma unroll
        for (int m = 0; m < 4; ++m)
#pragma unroll
          for (int n = 0; n < 4; ++n) acc[m][n] = __builtin_amdgcn_mfma_f32_16x16x32_bf16(vf[n], wf[m], acc[m][n], 0, 0, 0);
      }
#pragma unroll
      for (int m = 0; m < 4; ++m) {
        const int t = th * 64 + m * 16 + fr;
        const float bt = bs[t];
#pragma unroll
        for (int n = 0; n < 4; ++n) {
          const int c = g * 64 + n * 16 + fq * 4;
          const u32x2 ur = *(const u32x2*)(p.h + (T0 + t) * HC + 1024 + c);
          const f32x4 sv = acc[m][n] + bt;
          u32x2 w; w[0] = pk2(bflo(ur[0]) * sv[0], bfhi(ur[0]) * sv[1]); w[1] = pk2(bflo(ur[1]) * sv[2], bfhi(ur[1]) * sv[3]);
          *(u32x2*)(p.y + (T0 + t) * DM + 768 + c) = w;
        }
      }
    }
  }
  HBAR();
}

constexpr int FRS = 72, FPL = 64 * FRS, FCH = 2 * FPL + 64;
NI void fft_item(int l, int id, LAS3 unsigned* cnt, unsigned& target) {
  KPARAMS;
  const int tidf = otid(), half = __builtin_amdgcn_readfirstlane(tidf >> 8), tid = tidf & 255, lane = tid & 63, wid = __builtin_amdgcn_readfirstlane(tid >> 6);
  const int fr = lane & 15, fq = lane >> 4;
  bf16_t* smem = SMEM + half * HALF_E;
  const int b = id >> 7, ch0 = (id & 127) * 2;
  bf16_t* Ct = smem + 2 * FCH;
  unsigned* TWl = (unsigned*)(Ct + 2 * FPL);
  {
    u32x4 zv[8], cv[4], tv[4];
#pragma unroll
    for (int i = 0; i < 8; ++i) {
      const int chunk = tid + 256 * i, c = chunk >> 10, rem = chunk & 1023, ri = rem >> 9, s8 = rem & 511;
      zv[i] = *(const u32x4*)(p.PQt + ((long)(b * 256 + ch0 + c)) * 8192 + ri * 4096 + s8 * 8);
    }
#pragma unroll
    for (int i = 0; i < 4; ++i) {
      const int chunk = tid + 256 * i, tb = chunk >> 9, row = (chunk >> 3) & 63, c8 = chunk & 7;
      cv[i] = *(const u32x4*)(p.M1 + (tb * 64 + row) * 128 + c8 * 8);
      tv[i] = *(const u32x4*)((const unsigned*)p.TW + chunk * 4);
    }
#pragma unroll
    for (int i = 0; i < 8; ++i) {
      const int chunk = tid + 256 * i, c = chunk >> 10, rem = chunk & 1023, ri = rem >> 9, s8 = rem & 511;
      *(u32x4*)(smem + c * FCH + ri * FPL + (s8 >> 3) * FRS + (s8 & 7) * 8) = zv[i];
    }
#pragma unroll
    for (int i = 0; i < 4; ++i) {
      const int chunk = tid + 256 * i, tb = chunk >> 9, row = (chunk >> 3) & 63, c8 = chunk & 7;
      *(u32x4*)(Ct + tb * FPL + row * FRS + c8 * 8) = cv[i];
      *(u32x4*)(TWl + (chunk >> 4) * 68 + (chunk & 15) * 4) = tv[i];
    }
  }
  HBAR();
  {
    const int c = wid >> 1;
    bf16x8 zf[2][4];
#pragma unroll
    for (int nt = 0; nt < 2; ++nt)
#pragma unroll
      for (int ks = 0; ks < 4; ++ks) {
        const bf16_t* src = smem + c * FCH + (ks >> 1) * FPL + ((ks & 1) * 32 + fq * 8) * FRS + (wid & 1) * 32 + nt * 16 + fr;
#pragma unroll
        for (int j = 0; j < 8; ++j) zf[nt][ks][j] = (short)src[j * FRS];
      }
    f32x4 acc[2][8];
#pragma unroll
    for (int nt = 0; nt < 2; ++nt)
#pragma unroll
      for (int mt = 0; mt < 8; ++mt) acc[nt][mt] = (f32x4){0.f, 0.f, 0.f, 0.f};
#pragma unroll
    for (int mt = 0; mt < 8; ++mt)
#pragma unroll
      for (int ks = 0; ks < 4; ++ks) {
        u32x4 mw = *(const u32x4*)(Ct + (((mt >> 2) == (ks >> 1)) ? 0 : FPL) + ((mt & 3) * 16 + fr) * FRS + (ks & 1) * 32 + fq * 8);
        if ((mt >> 2) == 0 && (ks >> 1) == 1) mw = mw ^ 0x80008000u;
        const bf16x8 mf = __builtin_bit_cast(bf16x8, mw);
#pragma unroll
        for (int nt = 0; nt < 2; ++nt) acc[nt][mt] = __builtin_amdgcn_mfma_f32_16x16x32_bf16(zf[nt][ks], mf, acc[nt][mt], 0, 0, 0);
      }
#pragma unroll
    for (int nt = 0; nt < 2; ++nt)
#pragma unroll
      for (int m4 = 0; m4 < 4; ++m4) {
        const int k1 = m4 * 16 + fr, s2 = (wid & 1) * 32 + nt * 16 + fq * 4;
        const u32x4 tw = *(const u32x4*)(TWl + k1 * 68 + s2);
        const f32x4 yr = acc[nt][m4], yi = acc[nt][m4 + 4];
        const float cs[4] = {bflo(tw[0]), bflo(tw[1]), bflo(tw[2]), bflo(tw[3])}, sn[4] = {bfhi(tw[0]), bfhi(tw[1]), bfhi(tw[2]), bfhi(tw[3])};
        float tr[4], ti[4];
#pragma unroll
        for (int j = 0; j < 4; ++j) { tr[j] = yr[j] * cs[j] - yi[j] * sn[j]; ti[j] = yr[j] * sn[j] + yi[j] * cs[j]; }
        u32x2 wr_, wi_; wr_[0] = pk2(tr[0], tr[1]); wr_[1] = pk2(tr[2], tr[3]); wi_[0] = pk2(ti[0], ti[1]); wi_[1] = pk2(ti[2], ti[3]);
        *(u32x2*)(smem + c * FCH + k1 * FRS + s2) = wr_;
        *(u32x2*)(smem + c * FCH + FPL + k1 * FRS + s2) = wi_;
      }
  }
  HBAR();
  {
    f32x4 acc[2][4];
#pragma unroll
    for (int t = 0; t < 2; ++t)
#pragma unroll
      for (int mt = 0; mt < 4; ++mt) acc[t][mt] = (f32x4){0.f, 0.f, 0.f, 0.f};
#pragma unroll
    for (int ks = 0; ks < 4; ++ks) {
      bf16x8 tf[2];
#pragma unroll
      for (int t = 0; t < 2; ++t) {
        const int k1 = (wid * 2 + t) * 8 + (fr >> 1), c = fr & 1;
        tf[t] = *(const bf16x8*)(smem + c * FCH + (ks >> 1) * FPL + k1 * FRS + (ks & 1) * 32 + fq * 8);
      }
#pragma unroll
      for (int mt = 0; mt < 4; ++mt) {
        u32x4 mw = *(const u32x4*)(Ct + ((ks >> 1) ? FPL : 0) + (mt * 16 + fr) * FRS + (ks & 1) * 32 + fq * 8);
        if (ks >> 1) mw = mw ^ 0x80008000u;
        const bf16x8 mf = __builtin_bit_cast(bf16x8, mw);
#pragma unroll
        for (int t = 0; t < 2; ++t) acc[t][mt] = __builtin_amdgcn_mfma_f32_16x16x32_bf16(tf[t], mf, acc[t][mt], 0, 0, 0);
      }
    }
    const float b0 = p.fnet_b[l * 256 + ch0], b1 = p.fnet_b[l * 256 + ch0 + 1];
#pragma unroll
    for (int t = 0; t < 2; ++t)
#pragma unroll
      for (int mt = 0; mt < 4; ++mt)
#pragma unroll
        for (int jj = 0; jj < 2; ++jj) {
          const int k1 = (wid * 2 + t) * 8 + 2 * fq + jj, k2 = mt * 16 + fr;
          *(unsigned*)(p.y + ((long)(b * SEQ + k1 + 64 * k2)) * DM + 512 + ch0) = pk2(acc[t][mt][2 * jj] + b0, acc[t][mt][2 * jj + 1] + b1);
        }
  }
  HBAR();
}

NI void mixer_phase(int l, int rep) {
  KPARAMS;
  constexpr int NA = 1024, NF = 1024, NC = 512, ND = 256;
  const int tidf = otid(), half = __builtin_amdgcn_readfirstlane(tidf >> 8), tid = tidf & 255, lane = tid & 63;
  LAS3 unsigned* ctl = (LAS3 unsigned*)(LDSP + 2 * HALF_B);
  LAS3 unsigned* cnt = ctl + 8 + 4 * half;
  LAS3 unsigned* nx = ctl + 16 + 4 * half;
  if (tid == 0) *cnt = 0u;
  __syncthreads();
  unsigned target = 0u;
  for (int it = 0;; ++it) {
    if (tid == 0) nx[it & 1] = (unsigned)atomicAdd(p.ctr + l + 4 * rep, 1);
    HBAR();
    const int id = __builtin_amdgcn_readfirstlane((int)nx[it & 1]);
    if (id >= NA + NF + NC + ND) break;
    if (id < NA) attn_tile(l, id, cnt, target);
    else if (id < NA + NC) conv_tile(l, id - NA, cnt, target);
    else if (id < NA + NC + ND) sgu_tile(l, id - NA - NC, cnt, target);
    else fft_item(l, id - NA - NC - ND, cnt, target);
  }
}

#define LAS __attribute__((address_space(3)))
#define XB_TMO      128
#define XB_XCNT(j)  (256  + 64 * (j))
#define XB_XSUB(j)  (1280 + 64 * (j))
#define XB_XGEN(j)  (2304 + 64 * (j))
#define XB_TOP      3328
#define XB_TOPGEN   3392
#define XCD_BAR_WORDS 3456
#define XB_SPIN_CAP (1u << 18)

__device__ __forceinline__ unsigned xb_ld(unsigned* p)              { return __hip_atomic_load(p, __ATOMIC_RELAXED, __HIP_MEMORY_SCOPE_AGENT); }
__device__ __forceinline__ unsigned xb_add(unsigned* p, unsigned v) { return __hip_atomic_fetch_add(p, v, __ATOMIC_RELAXED, __HIP_MEMORY_SCOPE_AGENT); }
__device__ __forceinline__ unsigned xb_xcc_id() { return (unsigned)__builtin_amdgcn_s_getreg((3 << 11) | 20) & 0xFu; }
#define XB_SPIN(cond, bar) do { unsigned _sp = 0; while (cond) { __builtin_amdgcn_s_sleep(1); \
    if ((++_sp & 255u) == 0u) { if (xb_ld(&(bar)[XB_TMO])) break; if (_sp > XB_SPIN_CAP) { atomicAdd(&(bar)[XB_TMO], 1u); break; } } } } while (0)

struct XcdBarrier {
    unsigned* bar; unsigned x;
    volatile LAS unsigned* st;
};

__device__ __forceinline__ XcdBarrier xcd_barrier_post(unsigned* bar, volatile LAS unsigned* st) {
    XcdBarrier b; b.bar = bar; b.x = xb_xcc_id(); b.st = st;
    if (threadIdx.x == 0) (void)xb_add(&bar[XB_XCNT(b.x)], 1u);
    return b;
}
__device__ __forceinline__ void xcd_barrier_complete(unsigned* bar, unsigned x, unsigned& nloc, unsigned& nx) {
    const unsigned G = gridDim.x * gridDim.y * gridDim.z;
    unsigned sum, cnt, mine, sp = 0u;
    for (;;) {
        sum = 0u; cnt = 0u; mine = 0u;
#pragma unroll
        for (unsigned j = 0; j < 16; ++j) { const unsigned c = xb_ld(&bar[XB_XCNT(j)]); sum += c; cnt += (c > 0u) ? 1u : 0u; mine = (j == x) ? c : mine; }
        if (sum == G) break;
        __builtin_amdgcn_s_sleep(1);
        if ((++sp & 255u) == 0u) { if (xb_ld(&bar[XB_TMO])) break; if (sp > XB_SPIN_CAP) { atomicAdd(&bar[XB_TMO], 1u); break; } }
    }
    nloc = mine > 0u ? mine : 1u; nx = cnt > 0u ? cnt : 1u;
}

__device__ __forceinline__ void xcd_barrier(const XcdBarrier& b) {
    asm volatile("s_waitcnt vmcnt(0)" ::: "memory");
    __syncthreads();
    if (threadIdx.x == 0) {
        unsigned* bar = b.bar;
        __builtin_amdgcn_s_waitcnt(0);
        unsigned nloc = b.st[0], nx = b.st[1];
        if (nloc == 0u) { xcd_barrier_complete(bar, b.x, nloc, nx); b.st[0] = nloc; b.st[1] = nx; }
        const unsigned old = xb_add(&bar[XB_XSUB(b.x)], 1u);
        const unsigned gen = old / nloc;
        if (old + 1u == (gen + 1u) * nloc) {
            __builtin_amdgcn_fence(__ATOMIC_RELEASE, "agent");
            asm volatile("s_waitcnt vmcnt(0)" ::: "memory");
            const unsigned og = xb_add(&bar[XB_TOP], 1u);
            const unsigned tg = og / nx;
            if (og + 1u == (tg + 1u) * nx) xb_add(&bar[XB_TOPGEN], 1u);
            else XB_SPIN(xb_ld(&bar[XB_TOPGEN]) == tg, bar);
            __builtin_amdgcn_fence(__ATOMIC_ACQUIRE, "agent");
            xb_add(&bar[XB_XGEN(b.x)], 1u);
            asm volatile("s_waitcnt vmcnt(0)" ::: "memory");
        } else {
            XB_SPIN(xb_ld(&bar[XB_XGEN(b.x)]) == gen, bar);
            __builtin_amdgcn_fence(__ATOMIC_ACQUIRE, "agent");
            asm volatile("s_waitcnt vmcnt(0)" ::: "memory");
        }
    }
    __syncthreads();
}

constexpr int NPHASE = 2 + 5 * DEPTH;
__global__ void __launch_bounds__(512, 2) mk_fwd(Params p, int ph_lo, int ph_hi, int coop) {
  int rep = 0;
  volatile LAS unsigned* bst = (volatile LAS unsigned*)(LDSP + 2 * HALF_B + 16);
  if (otid() < 2) bst[otid()] = 0u;
  __syncthreads();
  XcdBarrier xbar = xcd_barrier_post(p.barw, bst);
  for (int ph = ph_lo; ph < ph_hi; ++ph) {
    if (ph == 0) {
      prep_phase();
      if (REP_PREP) { __syncthreads(); prep_phase(); }
    } else if (ph == NPHASE - 1) {
      final_rms_phase(p.xn, p.final_g, p.out);
    } else {
      const int l = (ph - 1) / 5, s = (ph - 1) % 5;
      if (s == 0) gemm_in_phase(l);
      else if (s == 1) mixer_phase(l, rep);
      else if (s == 2) gemm_out_phase(l, (REP_S == 2 && rep == 0) ? 0.f : 1.f);
      else if (s == 3) gemm_up_phase(l);
      else gemm_down_phase(l, (REP_S == 4 && rep == 0) ? 0.f : 1.f);
    }
    if (coop && ph + 1 < ph_hi) { if (ph_lo < 0) cg::this_grid().sync(); else xcd_barrier(xbar); }
    if (coop && ph == 1) for (int i = 0; i < EXTRA_SYNCS; ++i) xcd_barrier(xbar);
    if (REP_S >= 0 && rep == 0 && ph >= 1 && ph < NPHASE - 1 && ((ph - 1) % 5) == REP_S) { rep = 1; --ph; } else rep = 0;
  }
}

extern "C" void kernel_launch(void* const* d_in, const int* in_sizes, int n_in, void* d_out, int out_size, void* d_ws, size_t ws_size, hipStream_t stream) {
  Params p{};
  const float** pf = (const float**)&p;
  for (int i = 0; i < 25; ++i) pf[i] = (const float*)d_in[i];
  p.out = (float*)d_out;
  unsigned char* w = (unsigned char*)d_ws;
  size_t off = 0;
  auto take = [&](size_t bytes) { unsigned char* r = w + off; off += (bytes + 255) & ~(size_t)255; return r; };
  p.WallT = (bf16_t*)take((size_t)DEPTH * WALL_N * DM * 2);
  p.WoutT = (bf16_t*)take((size_t)DEPTH * DM * DM * 2);
  p.WupT = (bf16_t*)take((size_t)DEPTH * DFF * DM * 2);
  p.WdownT = (bf16_t*)take((size_t)DEPTH * DFF * DM * 2);
  p.pwT = (bf16_t*)take((size_t)DEPTH * 65536 * 2);
  p.sguW = (bf16_t*)take((size_t)DEPTH * 4 * 16384 * 2);
  p.lam = (float*)take(256);
  unsigned char* ctl = take(16384);
  p.ctr = (int*)ctl;
  p.barw = (unsigned*)(ctl + 256);
  p.M1 = (bf16_t*)take(128 * 128 * 2);
  p.M3 = (bf16_t*)take(64 * 128 * 2);
  p.TW = (float*)take(4096 * 2 * 4);
  p.part = (float*)take((size_t)NTOK * 16 * 4);
  p.xn = (bf16_t*)take((size_t)NTOK * DM * 2);
  unsigned char* region = take((size_t)NTOK * DFF * 2);
  p.hid = (bf16_t*)region;
  p.h = (bf16_t*)region;
  p.Vt = (bf16_t*)(region + (size_t)NTOK * HC * 2);
  p.PQt = (bf16_t*)(region + (size_t)NTOK * HC * 2 + (size_t)NTOK * 256 * 2);
  p.y = (bf16_t*)(region + (size_t)NTOK * HC * 2 + (size_t)NTOK * 256 * 2 + (size_t)BATCH * 256 * 8192 * 2);
  if (off > ws_size) { fprintf(stderr, "workspace too small: need %zu have %zu\n", off, ws_size); return; }

  static int grid_blocks = 0;
  if (!grid_blocks) {
    int dev = 0, cus = 0, per_cu = 0;
    hipGetDevice(&dev);
    hipDeviceGetAttribute(&cus, hipDeviceAttributeMultiprocessorCount, dev);
    hipOccupancyMaxActiveBlocksPerMultiprocessor(&per_cu, mk_fwd, 512, 0);
    if (per_cu < 1) per_cu = 1;
    grid_blocks = cus * per_cu;
  }
  hipMemsetAsync(ctl, 0, 16384, stream);
#if MK_ONE_LAUNCH
  int lo = 0, hi = NPHASE, coop = 1;
  void* args[] = {&p, &lo, &hi, &coop};
  hipError_t e = hipLaunchCooperativeKernel((void*)mk_fwd, dim3(grid_blocks), dim3(512), args, 0, stream);
  if (e != hipSuccess) fprintf(stderr, "cooperative launch failed: %s (grid %d)\n", hipGetErrorString(e), grid_blocks);
#else
  for (int ph = 0; ph < NPHASE; ++ph) mk_fwd<<<grid_blocks, 512, 0, stream>>>(p, ph, ph + 1, 0);
#endif
}
```

```cpp
#include <hip/hip_runtime.h>
#include <hip/hip_cooperative_groups.h>
#include <cstdint>
#include <cstdio>
#include <cmath>
namespace cg = cooperative_groups;

#ifndef EXTRA_SYNCS
#define EXTRA_SYNCS 0
#endif
#ifndef REP_PREP
#define REP_PREP 0
#endif
#ifndef REP_S
#define REP_S -1
#endif
#ifndef MK_ONE_LAUNCH
#define MK_ONE_LAUNCH 1
#endif

#define DI __device__ __forceinline__
typedef unsigned short bf16_t;
typedef short bf16x8 __attribute__((ext_vector_type(8)));
typedef float f32x4 __attribute__((ext_vector_type(4)));
typedef float f32x16 __attribute__((ext_vector_type(16)));
typedef float f32x2 __attribute__((ext_vector_type(2)));
typedef __bf16 bf16x2v __attribute__((ext_vector_type(2)));
typedef unsigned u32x4 __attribute__((ext_vector_type(4)));
typedef unsigned u32x2 __attribute__((ext_vector_type(2)));

constexpr int BATCH = 8, SEQ = 4096, DM = 1024, DEPTH = 4, NTOK = BATCH * SEQ;
constexpr int HC = 1536;
constexpr int WALL_N = 2304;
constexpr int DFF = 4096;
constexpr float EPS = 1e-6f;
constexpr float LOG2E = 1.4426950408889634f;

DI unsigned pk2(float lo, float hi) { f32x2 v = {lo, hi}; bf16x2v b = __builtin_convertvector(v, bf16x2v); return __builtin_bit_cast(unsigned, b); }
DI float bflo(unsigned u) { return __uint_as_float(u << 16); }
DI float bfhi(unsigned u) { return __uint_as_float(u & 0xffff0000u); }
DI float bf2f(bf16_t u) { return __uint_as_float(((unsigned)u) << 16); }
template <int CTRL> DI float dppf(float v) { return __builtin_bit_cast(float, __builtin_amdgcn_update_dpp(0, __builtin_bit_cast(int, v), CTRL, 0xf, 0xf, true)); }
DI float xch32(float v, int x32) { return __builtin_bit_cast(float, __builtin_amdgcn_ds_bpermute(x32, __builtin_bit_cast(int, v))); }
DI float wave_sum(float v, int x32) {
  v += dppf<0xB1>(v); v += dppf<0x4E>(v); v += dppf<0x141>(v); v += dppf<0x140>(v);
  v += __builtin_bit_cast(float, __builtin_amdgcn_ds_swizzle(__builtin_bit_cast(int, v), 0x401f));
  v += xch32(v, x32);
  return v;
}

#define LAS3 __attribute__((address_space(3)))
DI void half_bar(LAS3 unsigned* cnt, unsigned& target, int lane) {
  asm volatile("s_waitcnt lgkmcnt(0)" ::: "memory");
  target += 4u;
  if (lane == 0) __hip_atomic_fetch_add(cnt, 1u, __ATOMIC_RELAXED, __HIP_MEMORY_SCOPE_WORKGROUP);
  while (__hip_atomic_load(cnt, __ATOMIC_RELAXED, __HIP_MEMORY_SCOPE_WORKGROUP) < target) __builtin_amdgcn_s_sleep(1);
  asm volatile("" ::: "memory");
}
#define HBAR() half_bar(cnt, target, lane)

struct Params {
  const float *x, *norm1_g, *w_in, *lam_q1, *lam_k1, *lam_q2, *lam_k2, *subln_g, *conv_dw_w, *conv_dw_b, *conv_ln_g, *conv_ln_b,
      *conv_pw_w, *conv_pw_b, *fnet_w, *fnet_b, *sgu_ln_g, *sgu_ln_b, *sgu_w, *sgu_b, *w_out, *norm2_g, *w_up, *w_down, *final_g;
  float* out;
  bf16_t *WallT, *WoutT, *WupT, *WdownT, *pwT, *sguW, *M1, *M3, *xn, *h, *Vt, *PQt, *y, *hid;
  float* lam;
  float* TW;
  float* part;
  int* ctr;
  unsigned* barw;
};

constexpr int HALF_B = 72960;
constexpr int SMEM_BYTES = 2 * HALF_B + 256;
constexpr int HALF_E = HALF_B / 2;
__shared__ __attribute__((aligned(16))) unsigned char smem_raw[SMEM_BYTES];
#define SMEM ((bf16_t*)smem_raw)
#define NI __device__ __forceinline__
DI int otid() { int t = threadIdx.x; asm volatile("" : "+v"(t)); return t; }
#define KPARAMS const Params& p = *(const Params*)__builtin_amdgcn_kernarg_segment_ptr()

namespace pg8 {
#define PG8_LAS __attribute__((address_space(3)))
typedef unsigned short bf16_t;
typedef short bf16x8 __attribute__((ext_vector_type(8)));
typedef float f32x4 __attribute__((ext_vector_type(4)));
typedef unsigned u32x4 __attribute__((ext_vector_type(4)));
constexpr int BM = 256, BK = 64, HALF = 128, HTB = HALF * BK * 2  , STAGE_BYTES = 8 * HTB, NXCD = 8, WGM = 8;

__host__ __device__ __forceinline__ int lds_byte(int r, int c) { const int st = (r >> 4) * 2 + (c >> 5), rr = r & 15, cc = c & 31, ob = rr * 64 + cc * 2; return st * 1024 + (ob ^ (((ob >> 9) & 1) << 5)); }
__host__ __device__ __forceinline__ void stage_rc(int b, int& R, int& C) { const int st = b / 1024, sb = b % 1024, swz = sb ^ (((sb >> 9) & 1) << 5); R = (st >> 1) * 16 + swz / 64; C = (st & 1) * 32 + (swz % 64) / 2; }
__host__ __device__ __forceinline__ int perm32(int rho) { const int n = rho >> 4, i = rho & 15; return 8 * (i >> 2) + 4 * n + (i & 3); }

struct Unit { int pm, pn; };
struct Gemm { const bf16_t* A; const bf16_t* Bt; int M, N, K; };

struct StaticOrder {
    int nM, nN, nwg, G, c;
    __host__ __device__ void init(int M, int N, int G_, int c_) { nM = M / BM; nN = N / BM; nwg = nM * nN; G = G_; c = c_; }
    __host__ __device__ bool next(int i, Unit& u) const {
        const long L = (long)i * G + c; if (L >= nwg) return false;
        int wgid = (int)L; { const int q = nwg / NXCD, r = nwg % NXCD, xcd = wgid % NXCD, off = wgid / NXCD; wgid = (xcd < r ? xcd * (q + 1) : r * (q + 1) + (xcd - r) * q) + off; }
        const int nig = WGM * nN, gid = wgid / nig, fm = gid * WGM, gsz = (nM - fm) < WGM ? (nM - fm) : WGM;
        u.pm = fm + ((wgid % nig) % gsz); u.pn = (wgid % nig) / gsz; return true;
    }
    __device__ __forceinline__ void a_ready(const Unit&) const {}
    __device__ __forceinline__ void done(const Unit&) const {}
};
template <class Epi, class Sched, bool ALIGN_EPI = false, bool SP2 = false>
__device__ __forceinline__ void gemm_phase(PG8_LAS unsigned char* lds, const Gemm g, const Sched& S, const Epi& E) {
    const int tid = otid(), wid = __builtin_amdgcn_readfirstlane(tid >> 6), lane = tid & 63, wr = wid >> 2, wc = wid & 3, fr = lane & 15, fq = lane >> 4;
    const int K = g.K, nt = K / BK;
    unsigned voffA[2], voffB[2];
#pragma unroll
    for (int i = 0; i < 2; ++i) { int R, C; stage_rc(tid * 16 + i * 8192, R, C); const int Rb = Epi::PERM ? ((R & ~31) + perm32(R & 31)) : R;
        voffA[i] = (unsigned)(R * K + C) * 2u; voffB[i] = (unsigned)(Rb * K + C) * 2u; }
    const size_t kstep = (size_t)(BK * 2);
    const size_t hstep = (size_t)HALF * K * 2;
    const size_t tstep = 2 * hstep;
    const unsigned ldsw = (unsigned)wid * 1024u;
    const int aoff = lds_byte(wr * 64 + fr, fq * 8), boff = lds_byte(wc * 32 + fr, fq * 8);
#define PG8_SA(b, h) (((b) * 2 + (h)) * HTB)
#define PG8_SB(b, h) ((4 + (b) * 2 + (h)) * HTB)
#define PG8_STAGE(bufoff, gbase, voff) do { _Pragma("unroll") for (int _i = 0; _i < 2; ++_i) \
        __builtin_amdgcn_global_load_lds((const unsigned*)((const char*)(gbase) + (voff)[_i]), (PG8_LAS unsigned*)(lds + (bufoff) + ldsw + _i * 8192), 16, 0, 0); } while (0)
#define PG8_LDA(dst, b, h) do { _Pragma("unroll") for (int m = 0; m < 4; ++m) _Pragma("unroll") for (int k = 0; k < 2; ++k) dst[m][k] = *(const PG8_LAS bf16x8*)(lds + PG8_SA(b, h) + aoff + m * 2048 + k * 1024); } while (0)
#define PG8_LDB(dst, b, h) do { _Pragma("unroll") for (int n = 0; n < 2; ++n) _Pragma("unroll") for (int k = 0; k < 2; ++k) dst[n][k] = *(const PG8_LAS bf16x8*)(lds + PG8_SB(b, h) + boff + n * 2048 + k * 1024); } while (0)
#define PG8_MMA(ai, bj, At, Bt) do { __builtin_amdgcn_s_setprio(1); _Pragma("unroll") for (int m = 0; m < 4; ++m) _Pragma("unroll") for (int n = 0; n < 2; ++n) _Pragma("unroll") for (int k = 0; k < 2; ++k) \
        acc[ai][bj][m][n] = __builtin_amdgcn_mfma_f32_16x16x32_bf16(Bt[n][k], At[m][k], acc[ai][bj][m][n], 0, 0, 0); __builtin_amdgcn_s_setprio(0); } while (0)
#define PG8_WAIT_V(n) asm volatile("s_waitcnt vmcnt(" #n ")" ::: "memory")
#define PG8_WAIT_L(n) asm volatile("s_waitcnt lgkmcnt(" #n ")" ::: "memory")
#define PG8_BAR __builtin_amdgcn_s_barrier()
#define PG8_SCHED __builtin_amdgcn_sched_barrier(0)
    Unit cur, nxt; int ui = 0;
    if (!S.next(0, cur)) return;
    f32x4 acc[2][2][4][2];
#pragma unroll
    for (int a = 0; a < 2; ++a)
#pragma unroll
        for (int b = 0; b < 2; ++b)
#pragma unroll
            for (int m = 0; m < 4; ++m)
#pragma unroll
                for (int n = 0; n < 2; ++n) acc[a][b][m][n] = (f32x4){0.f, 0.f, 0.f, 0.f};
    bf16x8 At[4][2], B0[2][2], B1[2][2];
    const char* cA = (const char*)g.A + (size_t)cur.pm * tstep; const char* cB = (const char*)g.Bt + (size_t)cur.pn * tstep;
    S.a_ready(cur);
    if constexpr (SP2) {
        PG8_STAGE(PG8_SB(0, 0), cB, voffB); PG8_STAGE(PG8_SB(0, 1), cB + hstep, voffB); PG8_STAGE(PG8_SA(0, 0), cA, voffA); PG8_STAGE(PG8_SA(0, 1), cA + hstep, voffA);
        if (wr == 1) PG8_BAR;
        PG8_WAIT_V(2); PG8_BAR;
        PG8_STAGE(PG8_SB(1, 0), cB + kstep, voffB); PG8_STAGE(PG8_SA(1, 0), cA + kstep, voffA); PG8_STAGE(PG8_SB(1, 1), cB + hstep + kstep, voffB);
        PG8_WAIT_V(6); PG8_BAR;
    } else {
        PG8_STAGE(PG8_SB(0, 0), cB, voffB); PG8_STAGE(PG8_SA(0, 0), cA, voffA); PG8_STAGE(PG8_SB(0, 1), cB + hstep, voffB); PG8_STAGE(PG8_SA(0, 1), cA + hstep, voffA);
        if (wr == 1) PG8_BAR;
        PG8_WAIT_V(4); PG8_BAR;
        PG8_STAGE(PG8_SB(1, 0), cB + kstep, voffB); PG8_STAGE(PG8_SA(1, 0), cA + kstep, voffA); PG8_STAGE(PG8_SB(1, 1), cB + hstep + kstep, voffB);
        PG8_WAIT_V(6); PG8_BAR;
    }
    for (;;) {
        const bool has_next = S.next(ui + 1, nxt);
        const char* nA = has_next ? (const char*)g.A + (size_t)nxt.pm * tstep : cA; const char* nB = has_next ? (const char*)g.Bt + (size_t)nxt.pn * tstep : cB;
        for (int t = 0; t < nt; t += 2) {
            const bool last = (t == nt - 2);
            const char* a1 = cA + (size_t)(t + 1) * kstep;
            const char* a2 = last ? nA : cA + (size_t)(t + 2) * kstep; const char* b2 = last ? nB : cB + (size_t)(t + 2) * kstep;
            const char* a3 = a2 + kstep; const char* b3 = b2 + kstep;
            if (last && has_next) S.a_ready(nxt);
            if constexpr (SP2) {
            PG8_LDB(B0, 0, 0); PG8_LDB(B1, 0, 1); PG8_SCHED; PG8_LDA(At, 0, 0); PG8_STAGE(PG8_SA(1, 1), a1 + hstep, voffA);
            PG8_WAIT_V(8); PG8_WAIT_L(0); PG8_BAR; PG8_MMA(0, 0, At, B0); PG8_MMA(0, 1, At, B1); PG8_BAR; PG8_SCHED;
            PG8_LDA(At, 0, 1); PG8_STAGE(PG8_SB(0, 0), b2, voffB); PG8_STAGE(PG8_SB(0, 1), b2 + hstep, voffB); PG8_STAGE(PG8_SA(0, 0), a2, voffA);
            PG8_WAIT_V(8); PG8_WAIT_L(0); PG8_BAR; PG8_MMA(1, 0, At, B0); PG8_MMA(1, 1, At, B1); PG8_BAR; PG8_SCHED;
            PG8_LDB(B0, 1, 0); PG8_LDB(B1, 1, 1); PG8_SCHED; PG8_LDA(At, 1, 0); PG8_STAGE(PG8_SA(0, 1), a2 + hstep, voffA);
            PG8_WAIT_V(8); PG8_WAIT_L(0); PG8_BAR; PG8_MMA(0, 0, At, B0); PG8_MMA(0, 1, At, B1); PG8_BAR; PG8_SCHED;
            PG8_LDA(At, 1, 1); PG8_STAGE(PG8_SB(1, 0), b3, voffB); PG8_STAGE(PG8_SB(1, 1), b3 + hstep, voffB); PG8_STAGE(PG8_SA(1, 0), a3, voffA);
            PG8_WAIT_V(8); PG8_WAIT_L(0); PG8_BAR; PG8_MMA(1, 0, At, B0); PG8_MMA(1, 1, At, B1); PG8_BAR; PG8_SCHED;
            } else {
            PG8_LDB(B0, 0, 0); PG8_SCHED; PG8_LDA(At, 0, 0); PG8_STAGE(PG8_SA(1, 1), a1 + hstep, voffA);
            PG8_WAIT_L(8); PG8_BAR; PG8_WAIT_L(0); PG8_MMA(0, 0, At, B0); PG8_BAR; PG8_SCHED;
            PG8_LDB(B1, 0, 1); PG8_STAGE(PG8_SB(0, 0), b2, voffB);
            PG8_BAR; PG8_WAIT_L(0); PG8_MMA(0, 1, At, B1); PG8_BAR;
            PG8_LDA(At, 0, 1); PG8_STAGE(PG8_SA(0, 0), a2, voffA);
            PG8_BAR; PG8_WAIT_L(0); PG8_MMA(1, 0, At, B0); PG8_BAR; PG8_SCHED;
            PG8_STAGE(PG8_SB(0, 1), b2 + hstep, voffB);
            PG8_WAIT_V(6); PG8_BAR; PG8_MMA(1, 1, At, B1); PG8_BAR;
            PG8_LDB(B0, 1, 0); PG8_SCHED; PG8_LDA(At, 1, 0); PG8_STAGE(PG8_SA(0, 1), a2 + hstep, voffA);
            PG8_WAIT_L(8); PG8_BAR; PG8_WAIT_L(0); PG8_MMA(0, 0, At, B0); PG8_BAR; PG8_SCHED;
            PG8_LDB(B1, 1, 1); PG8_STAGE(PG8_SB(1, 0), b3, voffB);
            PG8_BAR; PG8_WAIT_L(0); PG8_MMA(0, 1, At, B1); PG8_BAR;
            PG8_LDA(At, 1, 1); PG8_STAGE(PG8_SA(1, 0), a3, voffA);
            PG8_BAR; PG8_WAIT_L(0); PG8_MMA(1, 0, At, B0); PG8_BAR; PG8_SCHED;
            PG8_STAGE(PG8_SB(1, 1), b3 + hstep, voffB);
            PG8_WAIT_V(6); PG8_BAR; PG8_MMA(1, 1, At, B1); PG8_BAR;
            }
        }
        if constexpr (ALIGN_EPI) { if (wr == 0) PG8_BAR; }
        if constexpr (!Epi::AFTER_DRAIN) { E(acc, cur, wr, wc, fr, fq); S.done(cur); }
        if (!has_next) break;
#pragma unroll
        for (int a = 0; a < 2; ++a)
#pragma unroll
            for (int b = 0; b < 2; ++b)
#pragma unroll
                for (int m = 0; m < 4; ++m)
#pragma unroll
                    for (int n = 0; n < 2; ++n) acc[a][b][m][n] = (f32x4){0.f, 0.f, 0.f, 0.f};
        cur = nxt; cA = nA; cB = nB; ++ui;
        if constexpr (ALIGN_EPI) { if (wr == 1) PG8_BAR; }
    }
    PG8_WAIT_V(0);
    if constexpr (!ALIGN_EPI) { if (wr == 0) PG8_BAR; }
    PG8_BAR;
    if constexpr (Epi::AFTER_DRAIN) { E.fused(acc, cur, wr, wc, fr, fq, lds, wid, lane); S.done(cur); }
#undef PG8_SA
#undef PG8_SB
#undef PG8_STAGE
#undef PG8_LDA
#undef PG8_LDB
#undef PG8_MMA
#undef PG8_WAIT_V
#undef PG8_WAIT_L
#undef PG8_BAR
#undef PG8_SCHED
}
}

template <class F> struct Epi8 {
  static constexpr bool PERM = true, AFTER_DRAIN = false;
  F f;
  DI void operator()(const pg8::f32x4 (&acc)[2][2][4][2], const pg8::Unit& u, int wr, int wc, int fr, int fq) const {
#pragma unroll
    for (int ai = 0; ai < 2; ++ai)
#pragma unroll
      for (int m = 0; m < 4; ++m) {
        const int row = u.pm * 256 + ai * 128 + wr * 64 + m * 16 + fr;
#pragma unroll
        for (int bj = 0; bj < 2; ++bj) f.st(row, u.pn * 256 + bj * 128 + wc * 32 + 8 * fq, acc[ai][bj][m][0], acc[ai][bj][m][1]);
      }
  }
};
#define LDSP ((__attribute__((address_space(3))) unsigned char*)smem_raw)
DI float row_rs(const float* __restrict__ part, int row) {
  const f32x4 a = *(const f32x4*)(part + (long)row * 16), b = *(const f32x4*)(part + (long)row * 16 + 4), c = *(const f32x4*)(part + (long)row * 16 + 8), d = *(const f32x4*)(part + (long)row * 16 + 12);
  const f32x4 s = (a + b) + (c + d);
  return rsqrtf(((s[0] + s[1]) + (s[2] + s[3])) * (1.f / 1024.f) + EPS);
}
template <class F> struct Epi8Rows {
  static constexpr bool PERM = true, AFTER_DRAIN = false;
  F f; const float* part;
  DI void operator()(const pg8::f32x4 (&acc)[2][2][4][2], const pg8::Unit& u, int wr, int wc, int fr, int fq) const {
    const int x32 = (((fq * 16 + fr) ^ 32) << 2);
#pragma unroll
    for (int ai = 0; ai < 2; ++ai)
#pragma unroll
      for (int m = 0; m < 4; ++m) {
        const int row = u.pm * 256 + ai * 128 + wr * 64 + m * 16 + fr;
        const f32x4 pp = *(const f32x4*)(part + (long)row * 16 + fq * 4);
        float sq = (pp[0] + pp[1]) + (pp[2] + pp[3]);
        sq += __builtin_bit_cast(float, __builtin_amdgcn_ds_swizzle(__builtin_bit_cast(int, sq), 0x401f));
        sq += xch32(sq, x32);
        const float rs = rsqrtf(sq * (1.f / 1024.f) + EPS);
#pragma unroll
        for (int bj = 0; bj < 2; ++bj) f.st(row, u.pn * 256 + bj * 128 + wc * 32 + 8 * fq, acc[ai][bj][m][0] * rs, acc[ai][bj][m][1] * rs);
      }
  }
};
template <class F> struct Epi8Cols {
  static constexpr bool PERM = true, AFTER_DRAIN = false;
  F f; const float* part;
  DI void operator()(const pg8::f32x4 (&acc)[2][2][4][2], const pg8::Unit& u, int wr, int wc, int fr, int fq) const {
    f32x4 r0[2], r1[2];
    const float rsl = row_rs(part, u.pn * 256 + (fr >> 3) * 128 + wc * 32 + 8 * fq + (fr & 7));
#pragma unroll
    for (int bj = 0; bj < 2; ++bj)
#pragma unroll
      for (int j = 0; j < 4; ++j) {
        r0[bj][j] = __builtin_bit_cast(float, __builtin_amdgcn_ds_bpermute(4 * (fq * 16 + bj * 8 + j), __builtin_bit_cast(int, rsl)));
        r1[bj][j] = __builtin_bit_cast(float, __builtin_amdgcn_ds_bpermute(4 * (fq * 16 + bj * 8 + 4 + j), __builtin_bit_cast(int, rsl)));
      }
#pragma unroll
    for (int ai = 0; ai < 2; ++ai)
#pragma unroll
      for (int m = 0; m < 4; ++m) {
        const int row = u.pm * 256 + ai * 128 + wr * 64 + m * 16 + fr;
#pragma unroll
        for (int bj = 0; bj < 2; ++bj) f.st(row, u.pn * 256 + bj * 128 + wc * 32 + 8 * fq, acc[ai][bj][m][0] * r0[bj], acc[ai][bj][m][1] * r1[bj]);
      }
  }
};
struct Epi8Res {
  static constexpr bool PERM = true, AFTER_DRAIN = false;
  bf16_t* xb; float* part; float accscale;
  DI void operator()(const pg8::f32x4 (&acc)[2][2][4][2], const pg8::Unit& u, int wr, int wc, int fr, int fq) const {
    const int x32 = (((fq * 16 + fr) ^ 32) << 2);
#pragma unroll
    for (int ai = 0; ai < 2; ++ai)
#pragma unroll
      for (int m = 0; m < 4; ++m) {
        const int row = u.pm * 256 + ai * 128 + wr * 64 + m * 16 + fr;
        float ss = 0.f;
#pragma unroll
        for (int bj = 0; bj < 2; ++bj) {
          const long o = (long)row * DM + u.pn * 256 + bj * 128 + wc * 32 + 8 * fq;
          const u32x4 xr = *(const u32x4*)(xb + o);
          f32x4 v0, v1;
          v0[0] = bflo(xr[0]); v0[1] = bfhi(xr[0]); v0[2] = bflo(xr[1]); v0[3] = bfhi(xr[1]);
          v1[0] = bflo(xr[2]); v1[1] = bfhi(xr[2]); v1[2] = bflo(xr[3]); v1[3] = bfhi(xr[3]);
          v0 = v0 + acc[ai][bj][m][0] * accscale; v1 = v1 + acc[ai][bj][m][1] * accscale;
          u32x4 w; w[0] = pk2(v0[0], v0[1]); w[1] = pk2(v0[2], v0[3]); w[2] = pk2(v1[0], v1[1]); w[3] = pk2(v1[2], v1[3]);
          *(u32x4*)(xb + o) = w;
          ss += (v0[0] * v0[0] + v0[1] * v0[1]) + (v0[2] * v0[2] + v0[3] * v0[3]) + (v1[0] * v1[0] + v1[1] * v1[1]) + (v1[2] * v1[2] + v1[3] * v1[3]);
        }
        ss += __builtin_bit_cast(float, __builtin_amdgcn_ds_swizzle(__builtin_bit_cast(int, ss), 0x401f));
        ss += xch32(ss, x32);
        if (fq == 0) part[(long)row * 16 + u.pn * 4 + wc] = ss;
      }
  }
};
template <class E> DI void run_gemm_e(const bf16_t* A, const bf16_t* Bt, int M, int N, int K, const E& e) {
  pg8::Gemm g{A, Bt, M, N, K};
  pg8::StaticOrder so; so.init(M, N, (int)gridDim.x, (int)blockIdx.x);
  pg8::gemm_phase<E, pg8::StaticOrder, true, true>(LDSP, g, so, e);
}
template <class F> DI void run_gemm(const bf16_t* A, const bf16_t* Bt, int M, int N, int K, const F& f) {
  pg8::Gemm g{A, Bt, M, N, K};
  pg8::StaticOrder so; so.init(M, N, (int)gridDim.x, (int)blockIdx.x);
  Epi8<F> e{f};
  pg8::gemm_phase<Epi8<F>, pg8::StaticOrder, true, true>(LDSP, g, so, e);
}
struct OneUnit { int pm, pn;
  DI bool next(int i, pg8::Unit& u) const { if (i) return false; u.pm = pm; u.pn = pn; return true; }
  DI void a_ready(const pg8::Unit&) const {}
  DI void done(const pg8::Unit&) const {} };

DI void tr_tile(const float* __restrict__ src, int lds_, int k0, int n0, bf16_t* __restrict__ dst, int ldd, int nd0, float scale, float* sm, const float* __restrict__ gk = nullptr) {
  const int t = otid() & 255;
  f32x4 v[8];
#pragma unroll
  for (int i = 0; i < 8; ++i) {
    const int kr = (t >> 4) + 16 * i, nc = (t & 15) * 4;
    v[i] = *(const f32x4*)(src + (long)(k0 + kr) * lds_ + n0 + nc);
    if (gk) v[i] = v[i] * gk[k0 + kr];
  }
#pragma unroll
  for (int i = 0; i < 8; ++i) {
    const int kr = (t >> 4) + 16 * i, nc = (t & 15) * 4;
    sm[kr * 65 + nc + 0] = v[i][0]; sm[kr * 65 + nc + 1] = v[i][1]; sm[kr * 65 + nc + 2] = v[i][2]; sm[kr * 65 + nc + 3] = v[i][3];
  }
  __syncthreads();
  const int n = t >> 2, ks = (t & 3) * 32;
  bf16_t* d = dst + (long)(nd0 + n) * ldd + k0 + ks;
#pragma unroll
  for (int q = 0; q < 4; ++q) {
    u32x4 w;
#pragma unroll
    for (int j = 0; j < 4; ++j) w[j] = pk2(sm[(ks + 8 * q + 2 * j) * 65 + n] * scale, sm[(ks + 8 * q + 2 * j + 1) * 65 + n] * scale);
    *(u32x4*)(d + 8 * q) = w;
  }
  __syncthreads();
}

constexpr int NT_ALL = DEPTH * 28 * 8, NT_OUT = DEPTH * 16 * 8, NT_UP = DEPTH * 64 * 8, NT_DOWN = DEPTH * 16 * 32, NT_PW = DEPTH * 4 * 2;
constexpr int N_FOLD = DEPTH * 2 * 4 * 16, N_SGU = 128, N_DM = 112, N_LAM = 1;
constexpr int PREP_ITEMS = NT_ALL + NT_OUT + NT_UP + NT_DOWN + NT_PW + N_FOLD + N_SGU + N_DM + N_LAM;

DI void prep_item(const Params& p, int it, float* sm) {
  const int t = otid() & 255;
  if (it < NT_ALL) {
    const int l = it / (28 * 8), rem = it % (28 * 8), nt = rem / 8, kt = rem % 8;
    const int nd = nt * 64;
    int nsrc; float scale = 1.f;
    if (nd < 512) { nsrc = nd; if (nd < 256) scale = 0.17677669529663687f * LOG2E; }
    else if (nd < 1024) nsrc = 768 + (nd - 512);
    else if (nd < 1536) nsrc = 1536 + (nd - 1024);
    else nsrc = 512 + (nd - 1536);
    tr_tile(p.w_in + (long)l * DM * 2048, 2048, kt * 128, nsrc, p.WallT + (long)l * WALL_N * DM, DM, nd, scale, sm, p.norm1_g + l * DM);
    return;
  }
  it -= NT_ALL;
  if (it < NT_OUT) {
    const int l = it / 128, rem = it % 128, nt = rem / 8, kt = rem % 8;
    tr_tile(p.w_out + (long)l * DM * DM, DM, kt * 128, nt * 64, p.WoutT + (long)l * DM * DM, DM, nt * 64, 1.f, sm);
    return;
  }
  it -= NT_OUT;
  if (it < NT_UP) {
    const int l = it / 512, rem = it % 512, nt = rem / 8, kt = rem % 8;
    tr_tile(p.w_up + (long)l * DM * DFF, DFF, kt * 128, nt * 64, p.WupT + (long)l * DFF * DM, DM, nt * 64, 1.f, sm, p.norm2_g + l * DM);
    return;
  }
  it -= NT_UP;
  if (it < NT_DOWN) {
    const int l = it / 512, rem = it % 512, nt = rem / 32, kt = rem % 32;
    tr_tile(p.w_down + (long)l * DFF * DM, DM, kt * 128, nt * 64, p.WdownT + (long)l * DM * DFF, DFF, nt * 64, 1.f, sm);
    return;
  }
  it -= NT_DOWN;
  if (it < NT_PW) {
    const int l = it / 8, rem = it % 8, nt = rem / 2, kt = rem % 2;
    tr_tile(p.conv_pw_w + (long)l * 65536, 256, kt * 128, nt * 64, p.pwT + (long)l * 65536, 256, nt * 64, 1.f, sm);
    return;
  }
  it -= NT_PW;
  if (it < N_FOLD) {
    const int l = it >> 7, pq = (it >> 6) & 1, g = (it >> 4) & 3, kcn = it & 15;
    const float* fw = p.fnet_w + ((long)l * 4 + g) * 4096;
    float* trig = sm + 4096;
    if (t < 64) trig[t] = pq ? sinpif((float)t * (1.f / 32.f)) : cospif((float)t * (1.f / 32.f));
    __syncthreads();
    for (int idx = t; idx < 4096; idx += 256) {
      const int c = idx >> 6, e = idx & 63;
      float s = 0.f;
      for (int kc = 0; kc < 64; ++kc) s += trig[(c * kc) & 63] * fw[kc * 64 + e];
      sm[idx] = s * (1.f / 512.f);
    }
    __syncthreads();
    const int k = kcn * 64 + (t & 63), e0 = (t >> 6) * 16;
    const float gk1 = p.norm1_g[l * DM + k];
    const float* wr = p.w_in + (long)l * DM * 2048 + (long)k * 2048 + 1280 + g * 64;
    f32x4 wv[16];
#pragma unroll
    for (int i = 0; i < 16; ++i) wv[i] = *(const f32x4*)(wr + 4 * i);
    bf16_t* dst = p.WallT + (long)l * WALL_N * DM + (long)(1792 + pq * 256 + g * 64) * DM + k;
#pragma unroll 1
    for (int e = e0; e < e0 + 16; ++e) {
      float s = 0.f;
#pragma unroll
      for (int i = 0; i < 16; ++i) {
        s += wv[i][0] * sm[(4 * i + 0) * 64 + e]; s += wv[i][1] * sm[(4 * i + 1) * 64 + e];
        s += wv[i][2] * sm[(4 * i + 2) * 64 + e]; s += wv[i][3] * sm[(4 * i + 3) * 64 + e];
      }
      dst[(long)e * DM] = (bf16_t)(pk2(s * gk1, 0.f) & 0xffffu);
    }
    __syncthreads();
    return;
  }
  it -= N_FOLD;
  if (it < N_SGU) {
    const long o = (long)it * 2048 + t * 8;
    const f32x4 a = *(const f32x4*)(p.sgu_w + o), b = *(const f32x4*)(p.sgu_w + o + 4);
    u32x4 w; w[0] = pk2(a[0], a[1]); w[1] = pk2(a[2], a[3]); w[2] = pk2(b[0], b[1]); w[3] = pk2(b[2], b[3]);
    *(u32x4*)(p.sguW + o) = w;
    return;
  }
  it -= N_SGU;
  if (it < N_DM) {
    const int e = it * 256 + t;
    if (e < 16384) {
      const int m = e >> 7, k = e & 127, ro = m >> 6, k1 = m & 63, ri = k >> 6, s1 = k & 63;
      const float ang = (float)((s1 * k1) & 63) * (1.f / 32.f);
      const float c = cospif(ang), sn = sinpif(ang);
      const float v = (ro == 0) ? (ri == 0 ? c : -sn) : (ri == 0 ? sn : c);
      p.M1[e] = (bf16_t)(pk2(v, 0.f) & 0xffffu);
    } else if (e < 16384 + 8192) {
      const int e2 = e - 16384, k2 = e2 >> 7, k = e2 & 127, ri = k >> 6, s2 = k & 63;
      const float ang = (float)((s2 * k2) & 63) * (1.f / 32.f);
      const float v = (ri == 0) ? cospif(ang) : -sinpif(ang);
      p.M3[e2] = (bf16_t)(pk2(v, 0.f) & 0xffffu);
    } else {
      const int e3 = e - 16384 - 8192, k1 = e3 >> 6, s2 = e3 & 63;
      const float ang = (float)(s2 * k1) * (1.f / 2048.f);
      ((unsigned*)p.TW)[e3] = pk2(cospif(ang), sinpif(ang));
    }
    return;
  }
  it -= N_DM;
  if (t < DEPTH) {
    const int l = t;
    float s1 = 0.f, s2 = 0.f;
    for (int i = 0; i < 32; ++i) { s1 += p.lam_q1[l * 32 + i] * p.lam_k1[l * 32 + i]; s2 += p.lam_q2[l * 32 + i] * p.lam_k2[l * 32 + i]; }
    const float lam_init = 0.8f - 0.6f * expf(-0.3f * (float)l);
    p.lam[l] = expf(s1) - expf(s2) + lam_init;
  }
}

NI void prep_phase() {
  KPARAMS;
  const int half = otid() >> 8;
  float* sm = (float*)smem_raw + half * (HALF_E / 2);
  for (int it0 = blockIdx.x * 2 + half; it0 < PREP_ITEMS; it0 += gridDim.x * 2) prep_item(p, it0, sm);
  const int tid_ = otid(); const int lane = tid_ & 63, wid = tid_ >> 6, x32 = ((lane ^ 32) << 2);
  for (int row0 = blockIdx.x * 8 + wid; row0 < NTOK; row0 += gridDim.x * 16) {
    f32x4 v[2][4];
#pragma unroll
    for (int rr = 0; rr < 2; ++rr) {
      const int row = row0 + rr * gridDim.x * 8;
#pragma unroll
      for (int i = 0; i < 4; ++i) v[rr][i] = (row < NTOK) ? *(const f32x4*)(p.x + (long)row * DM + lane * 4 + 256 * i) : (f32x4){0.f, 0.f, 0.f, 0.f};
    }
#pragma unroll
    for (int rr = 0; rr < 2; ++rr) {
      const int row = row0 + rr * gridDim.x * 8;
      float ss = 0.f;
#pragma unroll
      for (int i = 0; i < 4; ++i) ss += v[rr][i][0] * v[rr][i][0] + v[rr][i][1] * v[rr][i][1] + v[rr][i][2] * v[rr][i][2] + v[rr][i][3] * v[rr][i][3];
      ss = wave_sum(ss, x32);
      if (row < NTOK) {
#pragma unroll
        for (int i = 0; i < 4; ++i) { u32x2 w; w[0] = pk2(v[rr][i][0], v[rr][i][1]); w[1] = pk2(v[rr][i][2], v[rr][i][3]); *(u32x2*)(p.xn + (long)row * DM + lane * 4 + 256 * i) = w; }
        if (lane < 16) p.part[(long)row * 16 + lane] = (lane == 0) ? ss : 0.f;
      }
    }
  }
}

NI void final_rms_phase(const bf16_t* __restrict__ src, const float* __restrict__ g, float* __restrict__ dstf) {
  const int tid_ = otid(); const int lane = tid_ & 63, wid = tid_ >> 6, x32 = ((lane ^ 32) << 2);
  f32x4 gv[4];
#pragma unroll
  for (int i = 0; i < 4; ++i) gv[i] = *(const f32x4*)(g + lane * 4 + 256 * i);
  for (int row = blockIdx.x * 8 + wid; row < NTOK; row += gridDim.x * 8) {
    f32x4 v[4];
    float ss = 0.f;
#pragma unroll
    for (int i = 0; i < 4; ++i) {
      const u32x2 r = *(const u32x2*)(src + (long)row * DM + lane * 4 + 256 * i);
      v[i][0] = bflo(r[0]); v[i][1] = bfhi(r[0]); v[i][2] = bflo(r[1]); v[i][3] = bfhi(r[1]);
      ss += v[i][0] * v[i][0] + v[i][1] * v[i][1] + v[i][2] * v[i][2] + v[i][3] * v[i][3];
    }
    ss = wave_sum(ss, x32);
    const float rs = rsqrtf(ss * (1.f / 1024.f) + EPS);
#pragma unroll
    for (int i = 0; i < 4; ++i) *(f32x4*)(dstf + (long)row * DM + lane * 4 + 256 * i) = v[i] * rs * gv[i];
  }
}

DI u32x4 pk8(f32x4 a, f32x4 b) { u32x4 w; w[0] = pk2(a[0], a[1]); w[1] = pk2(a[2], a[3]); w[2] = pk2(b[0], b[1]); w[3] = pk2(b[2], b[3]); return w; }
struct StH { bf16_t* h; DI void st(int r, int c, f32x4 a, f32x4 b) const { *(u32x4*)(h + (long)r * HC + c) = pk8(a, b); } };
struct StT { bf16_t* Vt; bf16_t* PQt;
  DI void st(int n, int tok, f32x4 a, f32x4 b) const {
    const int bb = tok >> 12, s = tok & 4095; const u32x4 w = pk8(a, b);
    if (n < 256) *(u32x4*)(Vt + ((long)(bb * 256 + n)) * 4096 + s) = w;
    else { const int np = n - 256, pq = np >> 8, ch = np & 255; *(u32x4*)(PQt + ((long)(bb * 256 + ch)) * 8192 + pq * 4096 + s) = w; }
  } };
struct StRes { const float* xin; float* out;
  DI void st(int r, int c, f32x4 a, f32x4 b) const { const long o = (long)r * DM + c; const f32x4 x0 = *(const f32x4*)(xin + o), x1 = *(const f32x4*)(xin + o + 4); *(f32x4*)(out + o) = x0 + a; *(f32x4*)(out + o + 4) = x1 + b; } };
struct StUp { bf16_t* hid;
  DI void st(int r, int c, f32x4 a, f32x4 b) const {
#pragma unroll
    for (int j = 0; j < 4; ++j) { a[j] = fmaxf(a[j], 0.f); b[j] = fmaxf(b[j], 0.f); }
    *(u32x4*)(hid + (long)r * DFF + c) = pk8(a * a, b * b); } };

NI void gemm_in_phase(int l) {
  KPARAMS;
  const bf16_t* W = p.WallT + (long)l * WALL_N * DM;
  run_gemm_e(p.xn, W, NTOK, HC, DM, Epi8Rows<StH>{StH{p.h}, p.part});
  run_gemm_e(W + (long)HC * DM, p.xn, 768, NTOK, DM, Epi8Cols<StT>{StT{p.Vt, p.PQt}, p.part});
}
NI void gemm_out_phase(int l, float accscale) {
  KPARAMS;
  run_gemm_e(p.y, p.WoutT + (long)l * DM * DM, NTOK, DM, DM, Epi8Res{p.xn, p.part, accscale});
}
NI void gemm_up_phase(int l) {
  KPARAMS;
  run_gemm_e(p.xn, p.WupT + (long)l * DFF * DM, NTOK, DFF, DM, Epi8Rows<StUp>{StUp{p.hid}, p.part});
}
NI void gemm_down_phase(int l, float accscale) {
  KPARAMS;
  run_gemm_e(p.hid, p.WdownT + (long)l * DM * DFF, NTOK, DM, DFF, Epi8Res{p.xn, p.part, accscale});
}

constexpr int ARS = 72;
constexpr int ATILE = 64 * ARS;
NI void attn_tile(int l, int id, LAS3 unsigned* cnt, unsigned& target) {
  KPARAMS;
  const int tidf = otid(), half = __builtin_amdgcn_readfirstlane(tidf >> 8), tid = tidf & 255, lane = tid & 63, wid = __builtin_amdgcn_readfirstlane(tid >> 6), r = lane & 31, hh = lane >> 5, x32 = ((lane ^ 32) << 2);
  bf16_t* smem = SMEM + half * HALF_E;
  const int head = 3 - (id >> 8), b = (id >> 5) & 7, qb = id & 31;
  const float slope = (head == 0) ? 0.25f : (head == 1) ? 0.0625f : (head == 2) ? 0.015625f : 0.00390625f;
  const float ncs = -slope * LOG2E, cs = slope * LOG2E;
  const int qi = qb * 128 + wid * 32 + r;
  const bf16_t* qrow = p.h + ((long)(b * SEQ + qi)) * HC + head * 64;
  bf16x8 qf[2][2];
#pragma unroll
  for (int m = 0; m < 2; ++m)
#pragma unroll
    for (int s = 0; s < 2; ++s) qf[m][s] = *(const bf16x8*)(qrow + m * 32 + s * 16 + hh * 8);
  const bf16_t* kbase = p.h + ((long)(b * SEQ)) * HC + 256 + head * 64;
  const bf16_t* vbase = p.Vt + ((long)((b * 4 + head) * 64)) * SEQ;
  const int srow = tid >> 3, scol = (tid & 7) * 8;
  u32x4 rk[2], rv[2];
  f32x16 O[2][2];
#pragma unroll
  for (int m = 0; m < 2; ++m)
#pragma unroll
    for (int vb = 0; vb < 2; ++vb)
#pragma unroll
      for (int i = 0; i < 16; ++i) O[m][vb][i] = 0.f;
  float mrun[2] = {0.f, 0.f}, lrun[2] = {0.f, 0.f};
  const int kperm = (r & 19) | ((r & 4) << 1) | ((r & 8) >> 1);
  const int ktd = (qb * 128 + wid * 32) >> 6;
  unsigned csw, jrelw[2];
  { const unsigned h_ = pk2(cs, 0.f) & 0xffffu; csw = h_ | (pk2(cs - bflo(h_), 0.f) << 16); }
#pragma unroll
  for (int kb = 0; kb < 2; ++kb) { const float j_ = (float)(kb * 32 + kperm); jrelw[kb] = pk2(j_, j_); }

  const int wkeys = (head == 0) ? 305 : (head == 1) ? 1220 : SEQ;
  const int kt_lo = max(0, qb * 128 - wkeys) >> 6, kt_hi = min(SEQ, qb * 128 + 128 + wkeys + 63) >> 6;
#pragma unroll
  for (int i = 0; i < 2; ++i) {
    rk[i] = *(const u32x4*)(kbase + (long)(kt_lo * 64 + srow + 32 * i) * HC + scol);
    rv[i] = *(const u32x4*)(vbase + (long)(srow + 32 * i) * SEQ + kt_lo * 64 + scol);
  }
#pragma unroll
  for (int i = 0; i < 2; ++i) { *(u32x4*)(smem + (srow + 32 * i) * ARS + scol) = rk[i]; *(u32x4*)(smem + ATILE + (srow + 32 * i) * ARS + scol) = rv[i]; }
  asm volatile("" :: "v"(qf[0][0]), "v"(qf[0][1]), "v"(qf[1][0]), "v"(qf[1][1]));
  HBAR();
  for (int kt = kt_lo; kt < kt_hi; ++kt) {
    const bool more = (kt + 1) < kt_hi;
    if (more) {
#pragma unroll
      for (int i = 0; i < 2; ++i) {
        rk[i] = *(const u32x4*)(kbase + (long)((kt + 1) * 64 + srow + 32 * i) * HC + scol);
        rv[i] = *(const u32x4*)(vbase + (long)(srow + 32 * i) * SEQ + (kt + 1) * 64 + scol);
      }
    }
    const bf16_t* Ks = smem + ((kt - kt_lo) & 1) * 2 * ATILE;
    const bf16_t* Vs = Ks + ATILE;
    const float dbase = (float)(qi - kt * 64 - 8 * hh);
    const bool diag = (kt == ktd);
#pragma unroll
    for (int m = 0; m < 2; ++m) {
      __builtin_amdgcn_sched_barrier(0);
      f32x16 x[2];
      if (!diag) {
        const bool left = kt < ktd;
        const float C = fmaf(left ? cs : -cs, (float)(kt * 64 - qi), -mrun[m]);
        const unsigned wC = pk2(C, 0.f), wL = pk2(C - bflo(wC), 0.f);
        u32x4 qa; qa[0] = hh ? 0u : (left ? csw : (csw ^ 0x80008000u)); qa[1] = hh ? 0u : ((wC & 0xffffu) | (wL << 16)); qa[2] = 0u; qa[3] = 0u;
#pragma unroll
        for (int kb = 0; kb < 2; ++kb) {
          u32x4 ka; ka[0] = hh ? 0u : jrelw[kb]; ka[1] = hh ? 0u : 0x3f803f80u; ka[2] = 0u; ka[3] = 0u;
#pragma unroll
          for (int i = 0; i < 16; ++i) x[kb][i] = 0.f;
          x[kb] = __builtin_amdgcn_mfma_f32_32x32x16_bf16(__builtin_bit_cast(bf16x8, ka), __builtin_bit_cast(bf16x8, qa), x[kb], 0, 0, 0);
#pragma unroll
          for (int s = 0; s < 2; ++s) {
            const bf16x8 kf = *(const bf16x8*)(Ks + (kb * 32 + kperm) * ARS + m * 32 + s * 16 + hh * 8);
            x[kb] = __builtin_amdgcn_mfma_f32_32x32x16_bf16(kf, qf[m][s], x[kb], 0, 0, 0);
          }
        }
      } else {
#pragma unroll
        for (int kb = 0; kb < 2; ++kb) {
#pragma unroll
          for (int i = 0; i < 16; ++i) x[kb][i] = 0.f;
#pragma unroll
          for (int s = 0; s < 2; ++s) {
            const bf16x8 kf = *(const bf16x8*)(Ks + (kb * 32 + kperm) * ARS + m * 32 + s * 16 + hh * 8);
            x[kb] = __builtin_amdgcn_mfma_f32_32x32x16_bf16(kf, qf[m][s], x[kb], 0, 0, 0);
          }
        }
        const float nm = -mrun[m];
#pragma unroll
        for (int kb = 0; kb < 2; ++kb)
#pragma unroll
          for (int i = 0; i < 16; ++i) {
            const float off = (float)(kb * 32 + 16 * (i >> 3) + (i & 7));
            x[kb][i] = fmaf(ncs, fabsf(dbase - off), x[kb][i]) + nm;
          }
      }
      float mx = -1e30f;
#pragma unroll
      for (int kb = 0; kb < 2; ++kb)
#pragma unroll
        for (int i = 0; i < 16; ++i) mx = fmaxf(mx, x[kb][i]);
      mx = fmaxf(mx, xch32(mx, x32));
      if (__builtin_amdgcn_ballot_w64(mx > 8.f) != 0ull) {
        const float delta = fmaxf(mx, 0.f);
        const float alpha = __builtin_amdgcn_exp2f(-delta);
        mrun[m] += delta;
        lrun[m] *= alpha;
#pragma unroll
        for (int vb = 0; vb < 2; ++vb)
#pragma unroll
          for (int i = 0; i < 16; ++i) O[m][vb][i] *= alpha;
#pragma unroll
        for (int kb = 0; kb < 2; ++kb)
#pragma unroll
          for (int i = 0; i < 16; ++i) x[kb][i] -= delta;
      }
      float ps = 0.f;
#pragma unroll
      for (int kb = 0; kb < 2; ++kb)
#pragma unroll
        for (int i = 0; i < 16; ++i) { x[kb][i] = __builtin_amdgcn_exp2f(x[kb][i]); ps += x[kb][i]; }
      lrun[m] += ps;
#pragma unroll
      for (int kb = 0; kb < 2; ++kb)
#pragma unroll
        for (int s = 0; s < 2; ++s) {
          u32x4 pw;
#pragma unroll
          for (int j = 0; j < 4; ++j) pw[j] = pk2(x[kb][8 * s + 2 * j], x[kb][8 * s + 2 * j + 1]);
          const bf16x8 pf = __builtin_bit_cast(bf16x8, pw);
#pragma unroll
          for (int vb = 0; vb < 2; ++vb) {
            const bf16x8 vf = *(const bf16x8*)(Vs + (vb * 32 + r) * ARS + kb * 32 + s * 16 + hh * 8);
            O[m][vb] = __builtin_amdgcn_mfma_f32_32x32x16_bf16(vf, pf, O[m][vb], 0, 0, 0);
          }
        }
    }
    if (more) {
      bf16_t* wk = smem + ((kt + 1 - kt_lo) & 1) * 2 * ATILE;
#pragma unroll
      for (int i = 0; i < 2; ++i) { *(u32x4*)(wk + (srow + 32 * i) * ARS + scol) = rk[i]; *(u32x4*)(wk + ATILE + (srow + 32 * i) * ARS + scol) = rv[i]; }
    }
    HBAR();
  }
  asm volatile("" ::: "memory");
  const int tid2 = otid() & 255, lane2 = tid2 & 63, hh2 = lane2 >> 5, qi2 = qb * 128 + __builtin_amdgcn_readfirstlane(tid2 >> 6) * 32 + (lane2 & 31);
  const float lam = p.lam[l];
  int lx = l; asm volatile("" : "+s"(lx));
  const float lam_init = (lx == 0) ? 0.2f : (lx == 1) ? 0.35550907f : (lx == 2) ? 0.47071302f : 0.55605820f;
  const float l1 = lrun[0] + xch32(lrun[0], x32), l2 = lrun[1] + xch32(lrun[1], x32);
  const float i1 = 1.f / l1, i2 = lam / l2;
  float ss = 0.f;
#pragma unroll
  for (int vb = 0; vb < 2; ++vb)
#pragma unroll
    for (int i = 0; i < 16; ++i) { const float o = O[0][vb][i] * i1 - O[1][vb][i] * i2; O[0][vb][i] = o; ss += o * o; }
  ss += xch32(ss, x32);
  const float rs = rsqrtf(ss * (1.f / 64.f) + EPS) * (1.f - lam_init);
  const float* sg = p.subln_g + l * 64;
  bf16_t* yrow = p.y + ((long)(b * SEQ + qi2)) * DM + head * 64;
#pragma unroll
  for (int vb = 0; vb < 2; ++vb)
#pragma unroll
    for (int g4 = 0; g4 < 4; ++g4) {
      const int vc = vb * 32 + 8 * g4 + 4 * hh2;
      const f32x4 gg = *(const f32x4*)(sg + vc);
      u32x2 w;
      w[0] = pk2(O[0][vb][4 * g4 + 0] * rs * gg[0], O[0][vb][4 * g4 + 1] * rs * gg[1]);
      w[1] = pk2(O[0][vb][4 * g4 + 2] * rs * gg[2], O[0][vb][4 * g4 + 3] * rs * gg[3]);
      *(u32x2*)(yrow + vc) = w;
    }
}

constexpr int ZRS = 264;
NI void conv_tile(int l, int id, LAS3 unsigned* cnt, unsigned& target) {
  KPARAMS;
  const int tidf = otid(), half = __builtin_amdgcn_readfirstlane(tidf >> 8), tid = tidf & 255, lane = tid & 63, wid = __builtin_amdgcn_readfirstlane(tid >> 6), x32 = ((lane ^ 32) << 2);
  bf16_t* smem = SMEM + half * HALF_E;
  const int b = id >> 6, t0 = (id & 63) * 64;
  for (int idx = tid; idx < 94 * 32; idx += 256) {
    const int row = idx >> 5, c8 = (idx & 31) * 8;
    const int tok = t0 - 15 + row;
    u32x4 w = (u32x4){0u, 0u, 0u, 0u};
    if (tok >= 0 && tok < SEQ) {
      const bf16_t* hp = p.h + ((long)(b * SEQ + tok)) * HC + 512 + c8;
      const u32x4 a = *(const u32x4*)hp, g = *(const u32x4*)(hp + 256);
#pragma unroll
      for (int j = 0; j < 4; ++j) {
        const float a0 = bflo(a[j]), a1 = bfhi(a[j]), g0 = bflo(g[j]), g1 = bfhi(g[j]);
        w[j] = pk2(a0 * __builtin_amdgcn_rcpf(1.f + __builtin_amdgcn_exp2f(-LOG2E * g0)), a1 * __builtin_amdgcn_rcpf(1.f + __builtin_amdgcn_exp2f(-LOG2E * g1)));
      }
    }
    *(u32x4*)(smem + row * ZRS + c8) = w;
  }
  HBAR();
  {
    const int c = tid;
    float wv[31];
#pragma unroll
    for (int j = 0; j < 31; ++j) wv[j] = p.conv_dw_w[((long)l * 31 + j) * 256 + c];
    const float cb = p.conv_dw_b[l * 256 + c], lg = p.conv_ln_g[l * 256 + c], lb = p.conv_ln_b[l * 256 + c];
#pragma unroll 1
    for (int ch = 0; ch < 8; ++ch) {
      float zw[38];
#pragma unroll
      for (int j = 0; j < 38; ++j) zw[j] = bf2f(smem[(ch * 8 + j) * ZRS + c]);
      float o[8];
#pragma unroll
      for (int tt = 0; tt < 8; ++tt) {
        float s = cb;
#pragma unroll
        for (int j = 0; j < 31; ++j) s = fmaf(wv[j], zw[tt + j], s);
        o[tt] = s;
      }
#pragma unroll
      for (int tt = 0; tt < 8; ++tt) {
        const float s1 = wave_sum(o[tt], x32), s2 = wave_sum(o[tt] * o[tt], x32);
        const float mu = s1 * (1.f / 64.f);
        const float var = fmaxf(s2 * (1.f / 64.f) - mu * mu, 0.f);
        const float yv = (o[tt] - mu) * rsqrtf(var + EPS) * lg + lb;
        const float sv = yv * __builtin_amdgcn_rcpf(1.f + __builtin_amdgcn_exp2f(-LOG2E * yv));
        smem[(ch * 8 + tt) * ZRS + c] = (bf16_t)(pk2(sv, 0.f) & 0xffffu);
      }
    }
  }
  HBAR();
  {
    const int fr = lane & 15, fq = lane >> 4;
    const bf16_t* W = p.pwT + (long)l * 65536 + (long)(wid * 64) * 256;
    f32x4 acc[4][4];
#pragma unroll
    for (int m = 0; m < 4; ++m)
#pragma unroll
      for (int n = 0; n < 4; ++n) acc[m][n] = (f32x4){0.f, 0.f, 0.f, 0.f};
#pragma unroll 2
    for (int ks = 0; ks < 8; ++ks) {
      bf16x8 af[4], bfr[4];
#pragma unroll
      for (int m = 0; m < 4; ++m) af[m] = *(const bf16x8*)(smem + (m * 16 + fr) * ZRS + ks * 32 + fq * 8);
#pragma unroll
      for (int n = 0; n < 4; ++n) bfr[n] = *(const bf16x8*)(W + (long)(n * 16 + fr) * 256 + ks * 32 + fq * 8);
#pragma unroll
      for (int m = 0; m < 4; ++m)
#pragma unroll
        for (int n = 0; n < 4; ++n) acc[m][n] = __builtin_amdgcn_mfma_f32_16x16x32_bf16(bfr[n], af[m], acc[m][n], 0, 0, 0);
    }
    const float* pb = p.conv_pw_b + l * 256;
#pragma unroll
    for (int m = 0; m < 4; ++m)
#pragma unroll
      for (int n = 0; n < 4; ++n) {
        const int tok = t0 + m * 16 + fr, col = wid * 64 + n * 16 + fq * 4;
        const f32x4 bv = *(const f32x4*)(pb + col);
        const f32x4 v = acc[m][n] + bv;
        u32x2 w; w[0] = pk2(v[0], v[1]); w[1] = pk2(v[2], v[3]);
        *(u32x2*)(p.y + ((long)(b * SEQ + tok)) * DM + 256 + col) = w;
      }
  }
  HBAR();
}

constexpr int VRS = 258;
NI void sgu_tile(int l, int id, LAS3 unsigned* cnt, unsigned& target) {
  KPARAMS;
  const int tidf = otid(), half = __builtin_amdgcn_readfirstlane(tidf >> 8), tid = tidf & 255, lane = tid & 63, wid = __builtin_amdgcn_readfirstlane(tid >> 6), x32 = ((lane ^ 32) << 2);
  bf16_t* smem = SMEM + half * HALF_E;
  const long T0 = (long)id * 128;
  {
    const f32x4 lg = *(const f32x4*)(p.sgu_ln_g + l * 256 + lane * 4), lb = *(const f32x4*)(p.sgu_ln_b + l * 256 + lane * 4);
#pragma unroll 4
    for (int i = 0; i < 32; ++i) {
      const int s = wid * 32 + i;
      const u32x2 raw = *(const u32x2*)(p.h + (T0 + s) * HC + 1280 + lane * 4);
      const float v0 = bflo(raw[0]), v1 = bfhi(raw[0]), v2 = bflo(raw[1]), v3 = bfhi(raw[1]);
      const float s1 = wave_sum(v0 + v1 + v2 + v3, x32);
      const float mu = s1 * (1.f / 256.f);
      const float d0 = v0 - mu, d1 = v1 - mu, d2 = v2 - mu, d3 = v3 - mu;
      const float s2 = wave_sum(d0 * d0 + d1 * d1 + d2 * d2 + d3 * d3, x32);
      const float rs = rsqrtf(s2 * (1.f / 256.f) + EPS);
      unsigned* dst = (unsigned*)(smem + s * VRS + lane * 4);
      dst[0] = pk2(d0 * rs * lg[0] + lb[0], d1 * rs * lg[1] + lb[1]);
      dst[1] = pk2(d2 * rs * lg[2] + lb[2], d3 * rs * lg[3] + lb[3]);
    }
  }
  HBAR();
  {
    const int fr = lane & 15, fq = lane >> 4, g = wid;
    const bf16_t* W = p.sguW + ((long)(l * 4 + g)) * 16384;
    const float* bs = p.sgu_b + ((long)(l * 4 + g)) * 128;
#pragma unroll 1
    for (int th = 0; th < 2; ++th) {
      f32x4 acc[4][4];
#pragma unroll
      for (int m = 0; m < 4; ++m)
#pragma unroll
        for (int n = 0; n < 4; ++n) acc[m][n] = (f32x4){0.f, 0.f, 0.f, 0.f};
#pragma unroll 1
      for (int ks = 0; ks < 4; ++ks) {
        bf16x8 vf[4], wf[4];
#pragma unroll
        for (int n = 0; n < 4; ++n) {
#pragma unroll
          for (int j = 0; j < 8; ++j) vf[n][j] = (short)smem[(ks * 32 + fq * 8 + j) * VRS + g * 64 + n * 16 + fr];
        }
#pragma unroll
        for (int m = 0; m < 4; ++m) wf[m] = *(const bf16x8*)(W + (long)(th * 64 + m * 16 + fr) * 128 + ks * 32 + fq * 8);
#pragma unroll
        for (int m = 0; m < 4; ++m)
#pragma unroll
          for (int n = 0; n < 4; ++n) acc[m][n] = __builtin_amdgcn_mfma_f32_16x16x32_bf16(vf[n], wf[m], acc[m][n], 0, 0, 0);
      }
#pragma unroll
      for (int m = 0; m < 4; ++m) {
        const int t = th * 64 + m * 16 + fr;
        const float bt = bs[t];
#pragma unroll
        for (int n = 0; n < 4; ++n) {
          const int c = g * 64 + n * 16 + fq * 4;
          const u32x2 ur = *(const u32x2*)(p.h + (T0 + t) * HC + 1024 + c);
          const f32x4 sv = acc[m][n] + bt;
          u32x2 w; w[0] = pk2(bflo(ur[0]) * sv[0], bfhi(ur[0]) * sv[1]); w[1] = pk2(bflo(ur[1]) * sv[2], bfhi(ur[1]) * sv[3]);
          *(u32x2*)(p.y + (T0 + t) * DM + 768 + c) = w;
        }
      }
    }
  }
  HBAR();
}

constexpr int FRS = 72, FPL = 64 * FRS, FCH = 2 * FPL + 64;
NI void fft_item(int l, int id, LAS3 unsigned* cnt, unsigned& target) {
  KPARAMS;
  const int tidf = otid(), half = __builtin_amdgcn_readfirstlane(tidf >> 8), tid = tidf & 255, lane = tid & 63, wid = __builtin_amdgcn_readfirstlane(tid >> 6);
  const int fr = lane & 15, fq = lane >> 4;
  bf16_t* smem = SMEM + half * HALF_E;
  const int b = id >> 7, ch0 = (id & 127) * 2;
  bf16_t* Ct = smem + 2 * FCH;
  unsigned* TWl = (unsigned*)(Ct + 2 * FPL);
  {
    u32x4 zv[8], cv[4], tv[4];
#pragma unroll
    for (int i = 0; i < 8; ++i) {
      const int chunk = tid + 256 * i, c = chunk >> 10, rem = chunk & 1023, ri = rem >> 9, s8 = rem & 511;
      zv[i] = *(const u32x4*)(p.PQt + ((long)(b * 256 + ch0 + c)) * 8192 + ri * 4096 + s8 * 8);
    }
#pragma unroll
    for (int i = 0; i < 4; ++i) {
      const int chunk = tid + 256 * i, tb = chunk >> 9, row = (chunk >> 3) & 63, c8 = chunk & 7;
      cv[i] = *(const u32x4*)(p.M1 + (tb * 64 + row) * 128 + c8 * 8);
      tv[i] = *(const u32x4*)((const unsigned*)p.TW + chunk * 4);
    }
#pragma unroll
    for (int i = 0; i < 8; ++i) {
      const int chunk = tid + 256 * i, c = chunk >> 10, rem = chunk & 1023, ri = rem >> 9, s8 = rem & 511;
      *(u32x4*)(smem + c * FCH + ri * FPL + (s8 >> 3) * FRS + (s8 & 7) * 8) = zv[i];
    }
#pragma unroll
    for (int i = 0; i < 4; ++i) {
      const int chunk = tid + 256 * i, tb = chunk >> 9, row = (chunk >> 3) & 63, c8 = chunk & 7;
      *(u32x4*)(Ct + tb * FPL + row * FRS + c8 * 8) = cv[i];
      *(u32x4*)(TWl + (chunk >> 4) * 68 + (chunk & 15) * 4) = tv[i];
    }
  }
  HBAR();
  {
    const int c = wid >> 1;
    bf16x8 zf[2][4];
#pragma unroll
    for (int nt = 0; nt < 2; ++nt)
#pragma unroll
      for (int ks = 0; ks < 4; ++ks) {
        const bf16_t* src = smem + c * FCH + (ks >> 1) * FPL + ((ks & 1) * 32 + fq * 8) * FRS + (wid & 1) * 32 + nt * 16 + fr;
#pragma unroll
        for (int j = 0; j < 8; ++j) zf[nt][ks][j] = (short)src[j * FRS];
      }
    f32x4 acc[2][8];
#pragma unroll
    for (int nt = 0; nt < 2; ++nt)
#pragma unroll
      for (int mt = 0; mt < 8; ++mt) acc[nt][mt] = (f32x4){0.f, 0.f, 0.f, 0.f};
#pragma unroll
    for (int mt = 0; mt < 8; ++mt)
#pragma unroll
      for (int ks = 0; ks < 4; ++ks) {
        u32x4 mw = *(const u32x4*)(Ct + (((mt >> 2) == (ks >> 1)) ? 0 : FPL) + ((mt & 3) * 16 + fr) * FRS + (ks & 1) * 32 + fq * 8);
        if ((mt >> 2) == 0 && (ks >> 1) == 1) mw = mw ^ 0x80008000u;
        const bf16x8 mf = __builtin_bit_cast(bf16x8, mw);
#pragma unroll
        for (int nt = 0; nt < 2; ++nt) acc[nt][mt] = __builtin_amdgcn_mfma_f32_16x16x32_bf16(zf[nt][ks], mf, acc[nt][mt], 0, 0, 0);
      }
#pragma unroll
    for (int nt = 0; nt < 2; ++nt)
#pragma unroll
      for (int m4 = 0; m4 < 4; ++m4) {
        const int k1 = m4 * 16 + fr, s2 = (wid & 1) * 32 + nt * 16 + fq * 4;
        const u32x4 tw = *(const u32x4*)(TWl + k1 * 68 + s2);
        const f32x4 yr = acc[nt][m4], yi = acc[nt][m4 + 4];
        const float cs[4] = {bflo(tw[0]), bflo(tw[1]), bflo(tw[2]), bflo(tw[3])}, sn[4] = {bfhi(tw[0]), bfhi(tw[1]), bfhi(tw[2]), bfhi(tw[3])};
        float tr[4], ti[4];
#pragma unroll
        for (int j = 0; j < 4; ++j) { tr[j] = yr[j] * cs[j] - yi[j] * sn[j]; ti[j] = yr[j] * sn[j] + yi[j] * cs[j]; }
        u32x2 wr_, wi_; wr_[0] = pk2(tr[0], tr[1]); wr_[1] = pk2(tr[2], tr[3]); wi_[0] = pk2(ti[0], ti[1]); wi_[1] = pk2(ti[2], ti[3]);
        *(u32x2*)(smem + c * FCH + k1 * FRS + s2) = wr_;
        *(u32x2*)(smem + c * FCH + FPL + k1 * FRS + s2) = wi_;
      }
  }
  HBAR();
  {
    f32x4 acc[2][4];
#pragma unroll
    for (int t = 0; t < 2; ++t)
#pragma unroll
      for (int mt = 0; mt < 4; ++mt) acc[t][mt] = (f32x4){0.f, 0.f, 0.f, 0.f};
#pragma unroll
    for (int ks = 0; ks < 4; ++ks) {
      bf16x8 tf[2];
#pragma unroll
      for (int t = 0; t < 2; ++t) {
        const int k1 = (wid * 2 + t) * 8 + (fr >> 1), c = fr & 1;
        tf[t] = *(const bf16x8*)(smem + c * FCH + (ks >> 1) * FPL + k1 * FRS + (ks & 1) * 32 + fq * 8);
      }
#pragma unroll
      for (int mt = 0; mt < 4; ++mt) {
        u32x4 mw = *(const u32x4*)(Ct + ((ks >> 1) ? FPL : 0) + (mt * 16 + fr) * FRS + (ks & 1) * 32 + fq * 8);
        if (ks >> 1) mw = mw ^ 0x80008000u;
        const bf16x8 mf = __builtin_bit_cast(bf16x8, mw);
#pragma unroll
        for (int t = 0; t < 2; ++t) acc[t][mt] = __builtin_amdgcn_mfma_f32_16x16x32_bf16(tf[t], mf, acc[t][mt], 0, 0, 0);
      }
    }
    const float b0 = p.fnet_b[l * 256 + ch0], b1 = p.fnet_b[l * 256 + ch0 + 1];
#pragma unroll
    for (int t = 0; t < 2; ++t)
#pragma unroll
      for (int mt = 0; mt < 4; ++mt)
#pragma unroll
        for (int jj = 0; jj < 2; ++jj) {
          const int k1 = (wid * 2 + t) * 8 + 2 * fq + jj, k2 = mt * 16 + fr;
          *(unsigned*)(p.y + ((long)(b * SEQ + k1 + 64 * k2)) * DM + 512 + ch0) = pk2(acc[t][mt][2 * jj] + b0, acc[t][mt][2 * jj + 1] + b1);
        }
  }
  HBAR();
}

NI void mixer_phase(int l, int rep) {
  KPARAMS;
  constexpr int NA = 1024, NF = 1024, NC = 512, ND = 256;
  const int tidf = otid(), half = __builtin_amdgcn_readfirstlane(tidf >> 8), tid = tidf & 255, lane = tid & 63;
  LAS3 unsigned* ctl = (LAS3 unsigned*)(LDSP + 2 * HALF_B);
  LAS3 unsigned* cnt = ctl + 8 + 4 * half;
  LAS3 unsigned* nx = ctl + 16 + 4 * half;
  if (tid == 0) *cnt = 0u;
  __syncthreads();
  unsigned target = 0u;
  for (int it = 0;; ++it) {
    if (tid == 0) nx[it & 1] = (unsigned)atomicAdd(p.ctr + l + 4 * rep, 1);
    HBAR();
    const int id = __builtin_amdgcn_readfirstlane((int)nx[it & 1]);
    if (id >= NA + NF + NC + ND) break;
    if (id < NA) attn_tile(l, id, cnt, target);
    else if (id < NA + NC) conv_tile(l, id - NA, cnt, target);
    else if (id < NA + NC + ND) sgu_tile(l, id - NA - NC, cnt, target);
    else fft_item(l, id - NA - NC - ND, cnt, target);
  }
}

#define LAS __attribute__((address_space(3)))
#define XB_TMO      128
#define XB_XCNT(j)  (256  + 64 * (j))
#define XB_XSUB(j)  (1280 + 64 * (j))
#define XB_XGEN(j)  (2304 + 64 * (j))
#define XB_TOP      3328
#define XB_TOPGEN   3392
#define XCD_BAR_WORDS 3456
#define XB_SPIN_CAP (1u << 18)

__device__ __forceinline__ unsigned xb_ld(unsigned* p)              { return __hip_atomic_load(p, __ATOMIC_RELAXED, __HIP_MEMORY_SCOPE_AGENT); }
__device__ __forceinline__ unsigned xb_add(unsigned* p, unsigned v) { return __hip_atomic_fetch_add(p, v, __ATOMIC_RELAXED, __HIP_MEMORY_SCOPE_AGENT); }
__device__ __forceinline__ unsigned xb_xcc_id() { return (unsigned)__builtin_amdgcn_s_getreg((3 << 11) | 20) & 0xFu; }
#define XB_SPIN(cond, bar) do { unsigned _sp = 0; while (cond) { __builtin_amdgcn_s_sleep(1); \
    if ((++_sp & 255u) == 0u) { if (xb_ld(&(bar)[XB_TMO])) break; if (_sp > XB_SPIN_CAP) { atomicAdd(&(bar)[XB_TMO], 1u); break; } } } } while (0)

struct XcdBarrier {
    unsigned* bar; unsigned x;
    volatile LAS unsigned* st;
};

__device__ __forceinline__ XcdBarrier xcd_barrier_post(unsigned* bar, volatile LAS unsigned* st) {
    XcdBarrier b; b.bar = bar; b.x = xb_xcc_id(); b.st = st;
    if (threadIdx.x == 0) (void)xb_add(&bar[XB_XCNT(b.x)], 1u);
    return b;
}
__device__ __forceinline__ void xcd_barrier_complete(unsigned* bar, unsigned x, unsigned& nloc, unsigned& nx) {
    const unsigned G = gridDim.x * gridDim.y * gridDim.z;
    unsigned sum, cnt, mine, sp = 0u;
    for (;;) {
        sum = 0u; cnt = 0u; mine = 0u;
#pragma unroll
        for (unsigned j = 0; j < 16; ++j) { const unsigned c = xb_ld(&bar[XB_XCNT(j)]); sum += c; cnt += (c > 0u) ? 1u : 0u; mine = (j == x) ? c : mine; }
        if (sum == G) break;
        __builtin_amdgcn_s_sleep(1);
        if ((++sp & 255u) == 0u) { if (xb_ld(&bar[XB_TMO])) break; if (sp > XB_SPIN_CAP) { atomicAdd(&bar[XB_TMO], 1u); break; } }
    }
    nloc = mine > 0u ? mine : 1u; nx = cnt > 0u ? cnt : 1u;
}

__device__ __forceinline__ void xcd_barrier(const XcdBarrier& b) {
    asm volatile("s_waitcnt vmcnt(0)" ::: "memory");
    __syncthreads();
    if (threadIdx.x == 0) {
        unsigned* bar = b.bar;
        __builtin_amdgcn_s_waitcnt(0);
        unsigned nloc = b.st[0], nx = b.st[1];
        if (nloc == 0u) { xcd_barrier_complete(bar, b.x, nloc, nx); b.st[0] = nloc; b.st[1] = nx; }
        const unsigned old = xb_add(&bar[XB_XSUB(b.x)], 1u);
        const unsigned gen = old / nloc;
        if (old + 1u == (gen + 1u) * nloc) {
            __builtin_amdgcn_fence(__ATOMIC_RELEASE, "agent");
            asm volatile("s_waitcnt vmcnt(0)" ::: "memory");
            const unsigned og = xb_add(&bar[XB_TOP], 1u);
            const unsigned tg = og / nx;
            if (og + 1u == (tg + 1u) * nx) xb_add(&bar[XB_TOPGEN], 1u);
            else XB_SPIN(xb_ld(&bar[XB_TOPGEN]) == tg, bar);
            __builtin_amdgcn_fence(__ATOMIC_ACQUIRE, "agent");
            xb_add(&bar[XB_XGEN(b.x)], 1u);
            asm volatile("s_waitcnt vmcnt(0)" ::: "memory");
        } else {
            XB_SPIN(xb_ld(&bar[XB_XGEN(b.x)]) == gen, bar);
            __builtin_amdgcn_fence(__ATOMIC_ACQUIRE, "agent");
            asm volatile("s_waitcnt vmcnt(0)" ::: "memory");
        }
    }
    __syncthreads();
}

constexpr int NPHASE = 2 + 5 * DEPTH;
__global__ void __launch_bounds__(512, 2) mk_fwd(Params p, int ph_lo, int ph_hi, int coop) {
  int rep = 0;
  volatile LAS unsigned* bst = (volatile LAS unsigned*)(LDSP + 2 * HALF_B + 16);
  if (otid() < 2) bst[otid()] = 0u;
  __syncthreads();
  XcdBarrier xbar = xcd_barrier_post(p.barw, bst);
  for (int ph = ph_lo; ph < ph_hi; ++ph) {
    if (ph == 0) {
      prep_phase();
      if (REP_PREP) { __syncthreads(); prep_phase(); }
    } else if (ph == NPHASE - 1) {
      final_rms_phase(p.xn, p.final_g, p.out);
    } else {
      const int l = (ph - 1) / 5, s = (ph - 1) % 5;
      if (s == 0) gemm_in_phase(l);
      else if (s == 1) mixer_phase(l, rep);
      else if (s == 2) gemm_out_phase(l, (REP_S == 2 && rep == 0) ? 0.f : 1.f);
      else if (s == 3) gemm_up_phase(l);
      else gemm_down_phase(l, (REP_S == 4 && rep == 0) ? 0.f : 1.f);
    }
    if (coop && ph + 1 < ph_hi) { if (ph_lo < 0) cg::this_grid().sync(); else xcd_barrier(xbar); }
    if (coop && ph == 1) for (int i = 0; i < EXTRA_SYNCS; ++i) xcd_barrier(xbar);
    if (REP_S >= 0 && rep == 0 && ph >= 1 && ph < NPHASE - 1 && ((ph - 1) % 5) == REP_S) { rep = 1; --ph; } else rep = 0;
  }
}

extern "C" void kernel_launch(void* const* d_in, const int* in_sizes, int n_in, void* d_out, int out_size, void* d_ws, size_t ws_size, hipStream_t stream) {
  Params p{};
  const float** pf = (const float**)&p;
  for (int i = 0; i < 25; ++i) pf[i] = (const float*)d_in[i];
  p.out = (float*)d_out;
  unsigned char* w = (unsigned char*)d_ws;
  size_t off = 0;
  auto take = [&](size_t bytes) { unsigned char* r = w + off; off += (bytes + 255) & ~(size_t)255; return r; };
  p.WallT = (bf16_t*)take((size_t)DEPTH * WALL_N * DM * 2);
  p.WoutT = (bf16_t*)take((size_t)DEPTH * DM * DM * 2);
  p.WupT = (bf16_t*)take((size_t)DEPTH * DFF * DM * 2);
  p.WdownT = (bf16_t*)take((size_t)DEPTH * DFF * DM * 2);
  p.pwT = (bf16_t*)take((size_t)DEPTH * 65536 * 2);
  p.sguW = (bf16_t*)take((size_t)DEPTH * 4 * 16384 * 2);
  p.lam = (float*)take(256);
  unsigned char* ctl = take(16384);
  p.ctr = (int*)ctl;
  p.barw = (unsigned*)(ctl + 256);
  p.M1 = (bf16_t*)take(128 * 128 * 2);
  p.M3 = (bf16_t*)take(64 * 128 * 2);
  p.TW = (float*)take(4096 * 2 * 4);
  p.part = (float*)take((size_t)NTOK * 16 * 4);
  p.xn = (bf16_t*)take((size_t)NTOK * DM * 2);
  unsigned char* region = take((size_t)NTOK * DFF * 2);
  p.hid = (bf16_t*)region;
  p.h = (bf16_t*)region;
  p.Vt = (bf16_t*)(region + (size_t)NTOK * HC * 2);
  p.PQt = (bf16_t*)(region + (size_t)NTOK * HC * 2 + (size_t)NTOK * 256 * 2);
  p.y = (bf16_t*)(region + (size_t)NTOK * HC * 2 + (size_t)NTOK * 256 * 2 + (size_t)BATCH * 256 * 8192 * 2);
  if (off > ws_size) { fprintf(stderr, "workspace too small: need %zu have %zu\n", off, ws_size); return; }

  static int grid_blocks = 0;
  if (!grid_blocks) {
    int dev = 0, cus = 0, per_cu = 0;
    hipGetDevice(&dev);
    hipDeviceGetAttribute(&cus, hipDeviceAttributeMultiprocessorCount, dev);
    hipOccupancyMaxActiveBlocksPerMultiprocessor(&per_cu, mk_fwd, 512, 0);
    if (per_cu < 1) per_cu = 1;
    grid_blocks = cus * per_cu;
  }
  hipMemsetAsync(ctl, 0, 16384, stream);
#if MK_ONE_LAUNCH
  int lo = 0, hi = NPHASE, coop = 1;
  void* args[] = {&p, &lo, &hi, &coop};
  hipError_t e = hipLaunchCooperativeKernel((void*)mk_fwd, dim3(grid_blocks), dim3(512), args, 0, stream);
  if (e != hipSuccess) fprintf(stderr, "cooperative launch failed: %s (grid %d)\n", hipGetErrorString(e), grid_blocks);
#else
  for (int ph = 0; ph < NPHASE; ++ph) mk_fwd<<<grid_blocks, 512, 0, stream>>>(p, ph, ph + 1, 0);
#endif
}
```

```cpp
#include <hip/hip_runtime.h>
#include <hip/hip_cooperative_groups.h>
#include <cstdint>
#include <cstdio>
#include <cmath>
namespace cg = cooperative_groups;

#ifndef EXTRA_SYNCS
#define EXTRA_SYNCS 0
#endif
#ifndef REP_PREP
#define REP_PREP 0
#endif
#ifndef REP_S
#define REP_S -1
#endif
#ifndef MK_ONE_LAUNCH
#define MK_ONE_LAUNCH 1
#endif

#define DI __device__ __forceinline__
typedef unsigned short bf16_t;
typedef short bf16x8 __attribute__((ext_vector_type(8)));
typedef float f32x4 __attribute__((ext_vector_type(4)));
typedef float f32x16 __attribute__((ext_vector_type(16)));
typedef float f32x2 __attribute__((ext_vector_type(2)));
typedef __bf16 bf16x2v __attribute__((ext_vector_type(2)));
typedef unsigned u32x4 __attribute__((ext_vector_type(4)));
typedef unsigned u32x2 __attribute__((ext_vector_type(2)));

constexpr int BATCH = 8, SEQ = 4096, DM = 1024, DEPTH = 4, NTOK = BATCH * SEQ;
constexpr int HC = 1536;
constexpr int WALL_N = 2304;
constexpr int DFF = 4096;
constexpr float EPS = 1e-6f;
constexpr float LOG2E = 1.4426950408889634f;

DI unsigned pk2(float lo, float hi) { f32x2 v = {lo, hi}; bf16x2v b = __builtin_convertvector(v, bf16x2v); return __builtin_bit_cast(unsigned, b); }
DI float bflo(unsigned u) { return __uint_as_float(u << 16); }
DI float bfhi(unsigned u) { return __uint_as_float(u & 0xffff0000u); }
DI float bf2f(bf16_t u) { return __uint_as_float(((unsigned)u) << 16); }
template <int CTRL> DI float dppf(float v) { return __builtin_bit_cast(float, __builtin_amdgcn_update_dpp(0, __builtin_bit_cast(int, v), CTRL, 0xf, 0xf, true)); }
DI float xch32(float v, int x32) { return __builtin_bit_cast(float, __builtin_amdgcn_ds_bpermute(x32, __builtin_bit_cast(int, v))); }
DI float wave_sum(float v, int x32) {
  v += dppf<0xB1>(v); v += dppf<0x4E>(v); v += dppf<0x141>(v); v += dppf<0x140>(v);
  v += __builtin_bit_cast(float, __builtin_amdgcn_ds_swizzle(__builtin_bit_cast(int, v), 0x401f));
  v += xch32(v, x32);
  return v;
}

#define LAS3 __attribute__((address_space(3)))
DI void half_bar(LAS3 unsigned* cnt, unsigned& target, int lane) {
  asm volatile("s_waitcnt lgkmcnt(0)" ::: "memory");
  target += 4u;
  if (lane == 0) __hip_atomic_fetch_add(cnt, 1u, __ATOMIC_RELAXED, __HIP_MEMORY_SCOPE_WORKGROUP);
  while (__hip_atomic_load(cnt, __ATOMIC_RELAXED, __HIP_MEMORY_SCOPE_WORKGROUP) < target) __builtin_amdgcn_s_sleep(1);
  asm volatile("" ::: "memory");
}
#define HBAR() half_bar(cnt, target, lane)

struct Params {
  const float *x, *norm1_g, *w_in, *lam_q1, *lam_k1, *lam_q2, *lam_k2, *subln_g, *conv_dw_w, *conv_dw_b, *conv_ln_g, *conv_ln_b,
      *conv_pw_w, *conv_pw_b, *fnet_w, *fnet_b, *sgu_ln_g, *sgu_ln_b, *sgu_w, *sgu_b, *w_out, *norm2_g, *w_up, *w_down, *final_g;
  float* out;
  bf16_t *WallT, *WoutT, *WupT, *WdownT, *pwT, *sguW, *M1, *M3, *xn, *h, *Vt, *PQt, *y, *hid;
  float* lam;
  float* TW;
  float* part;
  int* ctr;
  unsigned* barw;
};

constexpr int HALF_B = 72960;
constexpr int SMEM_BYTES = 2 * HALF_B + 256;
constexpr int HALF_E = HALF_B / 2;
__shared__ __attribute__((aligned(16))) unsigned char smem_raw[SMEM_BYTES];
#define SMEM ((bf16_t*)smem_raw)
#define NI __device__ __forceinline__
DI int otid() { int t = threadIdx.x; asm volatile("" : "+v"(t)); return t; }
#define KPARAMS const Params& p = *(const Params*)__builtin_amdgcn_kernarg_segment_ptr()

namespace pg8 {
#define PG8_LAS __attribute__((address_space(3)))
typedef unsigned short bf16_t;
typedef short bf16x8 __attribute__((ext_vector_type(8)));
typedef float f32x4 __attribute__((ext_vector_type(4)));
typedef unsigned u32x4 __attribute__((ext_vector_type(4)));
constexpr int BM = 256, BK = 64, HALF = 128, HTB = HALF * BK * 2  , STAGE_BYTES = 8 * HTB, NXCD = 8, WGM = 8;

__host__ __device__ __forceinline__ int lds_byte(int r, int c) { const int st = (r >> 4) * 2 + (c >> 5), rr = r & 15, cc = c & 31, ob = rr * 64 + cc * 2; return st * 1024 + (ob ^ (((ob >> 9) & 1) << 5)); }
__host__ __device__ __forceinline__ void stage_rc(int b, int& R, int& C) { const int st = b / 1024, sb = b % 1024, swz = sb ^ (((sb >> 9) & 1) << 5); R = (st >> 1) * 16 + swz / 64; C = (st & 1) * 32 + (swz % 64) / 2; }
__host__ __device__ __forceinline__ int perm32(int rho) { const int n = rho >> 4, i = rho & 15; return 8 * (i >> 2) + 4 * n + (i & 3); }

struct Unit { int pm, pn; };
struct Gemm { const bf16_t* A; const bf16_t* Bt; int M, N, K; };

struct StaticOrder {
    int nM, nN, nwg, G, c;
    __host__ __device__ void init(int M, int N, int G_, int c_) { nM = M / BM; nN = N / BM; nwg = nM * nN; G = G_; c = c_; }
    __host__ __device__ bool next(int i, Unit& u) const {
        const long L = (long)i * G + c; if (L >= nwg) return false;
        int wgid = (int)L; { const int q = nwg / NXCD, r = nwg % NXCD, xcd = wgid % NXCD, off = wgid / NXCD; wgid = (xcd < r ? xcd * (q + 1) : r * (q + 1) + (xcd - r) * q) + off; }
        const int nig = WGM * nN, gid = wgid / nig, fm = gid * WGM, gsz = (nM - fm) < WGM ? (nM - fm) : WGM;
        u.pm = fm + ((wgid % nig) % gsz); u.pn = (wgid % nig) / gsz; return true;
    }
    __device__ __forceinline__ void a_ready(const Unit&) const {}
    __device__ __forceinline__ void done(const Unit&) const {}
};
template <class Epi, class Sched, bool ALIGN_EPI = false, bool SP2 = false>
__device__ __forceinline__ void gemm_phase(PG8_LAS unsigned char* lds, const Gemm g, const Sched& S, const Epi& E) {
    const int tid = otid(), wid = __builtin_amdgcn_readfirstlane(tid >> 6), lane = tid & 63, wr = wid >> 2, wc = wid & 3, fr = lane & 15, fq = lane >> 4;
    const int K = g.K, nt = K / BK;
    unsigned voffA[2], voffB[2];
#pragma unroll
    for (int i = 0; i < 2; ++i) { int R, C; stage_rc(tid * 16 + i * 8192, R, C); const int Rb = Epi::PERM ? ((R & ~31) + perm32(R & 31)) : R;
        voffA[i] = (unsigned)(R * K + C) * 2u; voffB[i] = (unsigned)(Rb * K + C) * 2u; }
    const size_t kstep = (size_t)(BK * 2);
    const size_t hstep = (size_t)HALF * K * 2;
    const size_t tstep = 2 * hstep;
    const unsigned ldsw = (unsigned)wid * 1024u;
    const int aoff = lds_byte(wr * 64 + fr, fq * 8), boff = lds_byte(wc * 32 + fr, fq * 8);
#define PG8_SA(b, h) (((b) * 2 + (h)) * HTB)
#define PG8_SB(b, h) ((4 + (b) * 2 + (h)) * HTB)
#define PG8_STAGE(bufoff, gbase, voff) do { _Pragma("unroll") for (int _i = 0; _i < 2; ++_i) \
        __builtin_amdgcn_global_load_lds((const unsigned*)((const char*)(gbase) + (voff)[_i]), (PG8_LAS unsigned*)(lds + (bufoff) + ldsw + _i * 8192), 16, 0, 0); } while (0)
#define PG8_LDA(dst, b, h) do { _Pragma("unroll") for (int m = 0; m < 4; ++m) _Pragma("unroll") for (int k = 0; k < 2; ++k) dst[m][k] = *(const PG8_LAS bf16x8*)(lds + PG8_SA(b, h) + aoff + m * 2048 + k * 1024); } while (0)
#define PG8_LDB(dst, b, h) do { _Pragma("unroll") for (int n = 0; n < 2; ++n) _Pragma("unroll") for (int k = 0; k < 2; ++k) dst[n][k] = *(const PG8_LAS bf16x8*)(lds + PG8_SB(b, h) + boff + n * 2048 + k * 1024); } while (0)
#define PG8_MMA(ai, bj, At, Bt) do { __builtin_amdgcn_s_setprio(1); _Pragma("unroll") for (int m = 0; m < 4; ++m) _Pragma("unroll") for (int n = 0; n < 2; ++n) _Pragma("unroll") for (int k = 0; k < 2; ++k) \
        acc[ai][bj][m][n] = __builtin_amdgcn_mfma_f32_16x16x32_bf16(Bt[n][k], At[m][k], acc[ai][bj][m][n], 0, 0, 0); __builtin_amdgcn_s_setprio(0); } while (0)
#define PG8_WAIT_V(n) asm volatile("s_waitcnt vmcnt(" #n ")" ::: "memory")
#define PG8_WAIT_L(n) asm volatile("s_waitcnt lgkmcnt(" #n ")" ::: "memory")
#define PG8_BAR __builtin_amdgcn_s_barrier()
#define PG8_SCHED __builtin_amdgcn_sched_barrier(0)
    Unit cur, nxt; int ui = 0;
    if (!S.next(0, cur)) return;
    f32x4 acc[2][2][4][2];
#pragma unroll
    for (int a = 0; a < 2; ++a)
#pragma unroll
        for (int b = 0; b < 2; ++b)
#pragma unroll
            for (int m = 0; m < 4; ++m)
#pragma unroll
                for (int n = 0; n < 2; ++n) acc[a][b][m][n] = (f32x4){0.f, 0.f, 0.f, 0.f};
    bf16x8 At[4][2], B0[2][2], B1[2][2];
    const char* cA = (const char*)g.A + (size_t)cur.pm * tstep; const char* cB = (const char*)g.Bt + (size_t)cur.pn * tstep;
    S.a_ready(cur);
    if constexpr (SP2) {
        PG8_STAGE(PG8_SB(0, 0), cB, voffB); PG8_STAGE(PG8_SB(0, 1), cB + hstep, voffB); PG8_STAGE(PG8_SA(0, 0), cA, voffA); PG8_STAGE(PG8_SA(0, 1), cA + hstep, voffA);
        if (wr == 1) PG8_BAR;
        PG8_WAIT_V(2); PG8_BAR;
        PG8_STAGE(PG8_SB(1, 0), cB + kstep, voffB); PG8_STAGE(PG8_SA(1, 0), cA + kstep, voffA); PG8_STAGE(PG8_SB(1, 1), cB + hstep + kstep, voffB);
        PG8_WAIT_V(6); PG8_BAR;
    } else {
        PG8_STAGE(PG8_SB(0, 0), cB, voffB); PG8_STAGE(PG8_SA(0, 0), cA, voffA); PG8_STAGE(PG8_SB(0, 1), cB + hstep, voffB); PG8_STAGE(PG8_SA(0, 1), cA + hstep, voffA);
        if (wr == 1) PG8_BAR;
        PG8_WAIT_V(4); PG8_BAR;
        PG8_STAGE(PG8_SB(1, 0), cB + kstep, voffB); PG8_STAGE(PG8_SA(1, 0), cA + kstep, voffA); PG8_STAGE(PG8_SB(1, 1), cB + hstep + kstep, voffB);
        PG8_WAIT_V(6); PG8_BAR;
    }
    for (;;) {
        const bool has_next = S.next(ui + 1, nxt);
        const char* nA = has_next ? (const char*)g.A + (size_t)nxt.pm * tstep : cA; const char* nB = has_next ? (const char*)g.Bt + (size_t)nxt.pn * tstep : cB;
        for (int t = 0; t < nt; t += 2) {
            const bool last = (t == nt - 2);
            const char* a1 = cA + (size_t)(t + 1) * kstep;
            const char* a2 = last ? nA : cA + (size_t)(t + 2) * kstep; const char* b2 = last ? nB : cB + (size_t)(t + 2) * kstep;
            const char* a3 = a2 + kstep; const char* b3 = b2 + kstep;
            if (last && has_next) S.a_ready(nxt);
            if constexpr (SP2) {
            PG8_LDB(B0, 0, 0); PG8_LDB(B1, 0, 1); PG8_SCHED; PG8_LDA(At, 0, 0); PG8_STAGE(PG8_SA(1, 1), a1 + hstep, voffA);
            PG8_WAIT_V(8); PG8_WAIT_L(0); PG8_BAR; PG8_MMA(0, 0, At, B0); PG8_MMA(0, 1, At, B1); PG8_BAR; PG8_SCHED;
            PG8_LDA(At, 0, 1); PG8_STAGE(PG8_SB(0, 0), b2, voffB); PG8_STAGE(PG8_SB(0, 1), b2 + hstep, voffB); PG8_STAGE(PG8_SA(0, 0), a2, voffA);
            PG8_WAIT_V(8); PG8_WAIT_L(0); PG8_BAR; PG8_MMA(1, 0, At, B0); PG8_MMA(1, 1, At, B1); PG8_BAR; PG8_SCHED;
            PG8_LDB(B0, 1, 0); PG8_LDB(B1, 1, 1); PG8_SCHED; PG8_LDA(At, 1, 0); PG8_STAGE(PG8_SA(0, 1), a2 + hstep, voffA);
            PG8_WAIT_V(8); PG8_WAIT_L(0); PG8_BAR; PG8_MMA(0, 0, At, B0); PG8_MMA(0, 1, At, B1); PG8_BAR; PG8_SCHED;
            PG8_LDA(At, 1, 1); PG8_STAGE(PG8_SB(1, 0), b3, voffB); PG8_STAGE(PG8_SB(1, 1), b3 + hstep, voffB); PG8_STAGE(PG8_SA(1, 0), a3, voffA);
            PG8_WAIT_V(8); PG8_WAIT_L(0); PG8_BAR; PG8_MMA(1, 0, At, B0); PG8_MMA(1, 1, At, B1); PG8_BAR; PG8_SCHED;
            } else {
            PG8_LDB(B0, 0, 0); PG8_SCHED; PG8_LDA(At, 0, 0); PG8_STAGE(PG8_SA(1, 1), a1 + hstep, voffA);
            PG8_WAIT_L(8); PG8_BAR; PG8_WAIT_L(0); PG8_MMA(0, 0, At, B0); PG8_BAR; PG8_SCHED;
            PG8_LDB(B1, 0, 1); PG8_STAGE(PG8_SB(0, 0), b2, voffB);
            PG8_BAR; PG8_WAIT_L(0); PG8_MMA(0, 1, At, B1); PG8_BAR;
            PG8_LDA(At, 0, 1); PG8_STAGE(PG8_SA(0, 0), a2, voffA);
            PG8_BAR; PG8_WAIT_L(0); PG8_MMA(1, 0, At, B0); PG8_BAR; PG8_SCHED;
            PG8_STAGE(PG8_SB(0, 1), b2 + hstep, voffB);
            PG8_WAIT_V(6); PG8_BAR; PG8_MMA(1, 1, At, B1); PG8_BAR;
            PG8_LDB(B0, 1, 0); PG8_SCHED; PG8_LDA(At, 1, 0); PG8_STAGE(PG8_SA(0, 1), a2 + hstep, voffA);
            PG8_WAIT_L(8); PG8_BAR; PG8_WAIT_L(0); PG8_MMA(0, 0, At, B0); PG8_BAR; PG8_SCHED;
            PG8_LDB(B1, 1, 1); PG8_STAGE(PG8_SB(1, 0), b3, voffB);
            PG8_BAR; PG8_WAIT_L(0); PG8_MMA(0, 1, At, B1); PG8_BAR;
            PG8_LDA(At, 1, 1); PG8_STAGE(PG8_SA(1, 0), a3, voffA);
            PG8_BAR; PG8_WAIT_L(0); PG8_MMA(1, 0, At, B0); PG8_BAR; PG8_SCHED;
            PG8_STAGE(PG8_SB(1, 1), b3 + hstep, voffB);
            PG8_WAIT_V(6); PG8_BAR; PG8_MMA(1, 1, At, B1); PG8_BAR;
            }
        }
        if constexpr (ALIGN_EPI) { if (wr == 0) PG8_BAR; }
        if constexpr (!Epi::AFTER_DRAIN) { E(acc, cur, wr, wc, fr, fq); S.done(cur); }
        if (!has_next) break;
#pragma unroll
        for (int a = 0; a < 2; ++a)
#pragma unroll
            for (int b = 0; b < 2; ++b)
#pragma unroll
                for (int m = 0; m < 4; ++m)
#pragma unroll
                    for (int n = 0; n < 2; ++n) acc[a][b][m][n] = (f32x4){0.f, 0.f, 0.f, 0.f};
        cur = nxt; cA = nA; cB = nB; ++ui;
        if constexpr (ALIGN_EPI) { if (wr == 1) PG8_BAR; }
    }
    PG8_WAIT_V(0);
    if constexpr (!ALIGN_EPI) { if (wr == 0) PG8_BAR; }
    PG8_BAR;
    if constexpr (Epi::AFTER_DRAIN) { E.fused(acc, cur, wr, wc, fr, fq, lds, wid, lane); S.done(cur); }
#undef PG8_SA
#undef PG8_SB
#undef PG8_STAGE
#undef PG8_LDA
#undef PG8_LDB
#undef PG8_MMA
#undef PG8_WAIT_V
#undef PG8_WAIT_L
#undef PG8_BAR
#undef PG8_SCHED
}
}

template <class F> struct Epi8 {
  static constexpr bool PERM = true, AFTER_DRAIN = false;
  F f;
  DI void operator()(const pg8::f32x4 (&acc)[2][2][4][2], const pg8::Unit& u, int wr, int wc, int fr, int fq) const {
#pragma unroll
    for (int ai = 0; ai < 2; ++ai)
#pragma unroll
      for (int m = 0; m < 4; ++m) {
        const int row = u.pm * 256 + ai * 128 + wr * 64 + m * 16 + fr;
#pragma unroll
        for (int bj = 0; bj < 2; ++bj) f.st(row, u.pn * 256 + bj * 128 + wc * 32 + 8 * fq, acc[ai][bj][m][0], acc[ai][bj][m][1]);
      }
  }
};
#define LDSP ((__attribute__((address_space(3))) unsigned char*)smem_raw)
DI float row_rs(const float* __restrict__ part, int row) {
  const f32x4 a = *(const f32x4*)(part + (long)row * 16), b = *(const f32x4*)(part + (long)row * 16 + 4), c = *(const f32x4*)(part + (long)row * 16 + 8), d = *(const f32x4*)(part + (long)row * 16 + 12);
  const f32x4 s = (a + b) + (c + d);
  return rsqrtf(((s[0] + s[1]) + (s[2] + s[3])) * (1.f / 1024.f) + EPS);
}
template <class F> struct Epi8Rows {
  static constexpr bool PERM = true, AFTER_DRAIN = false;
  F f; const float* part;
  DI void operator()(const pg8::f32x4 (&acc)[2][2][4][2], const pg8::Unit& u, int wr, int wc, int fr, int fq) const {
    const int x32 = (((fq * 16 + fr) ^ 32) << 2);
#pragma unroll
    for (int ai = 0; ai < 2; ++ai)
#pragma unroll
      for (int m = 0; m < 4; ++m) {
        const int row = u.pm * 256 + ai * 128 + wr * 64 + m * 16 + fr;
        const f32x4 pp = *(const f32x4*)(part + (long)row * 16 + fq * 4);
        float sq = (pp[0] + pp[1]) + (pp[2] + pp[3]);
        sq += __builtin_bit_cast(float, __builtin_amdgcn_ds_swizzle(__builtin_bit_cast(int, sq), 0x401f));
        sq += xch32(sq, x32);
        const float rs = rsqrtf(sq * (1.f / 1024.f) + EPS);
#pragma unroll
        for (int bj = 0; bj < 2; ++bj) f.st(row, u.pn * 256 + bj * 128 + wc * 32 + 8 * fq, acc[ai][bj][m][0] * rs, acc[ai][bj][m][1] * rs);
      }
  }
};
template <class F> struct Epi8Cols {
  static constexpr bool PERM = true, AFTER_DRAIN = false;
  F f; const float* part;
  DI void operator()(const pg8::f32x4 (&acc)[2][2][4][2], const pg8::Unit& u, int wr, int wc, int fr, int fq) const {
    f32x4 r0[2], r1[2];
    const float rsl = row_rs(part, u.pn * 256 + (fr >> 3) * 128 + wc * 32 + 8 * fq + (fr & 7));
#pragma unroll
    for (int bj = 0; bj < 2; ++bj)
#pragma unroll
      for (int j = 0; j < 4; ++j) {
        r0[bj][j] = __builtin_bit_cast(float, __builtin_amdgcn_ds_bpermute(4 * (fq * 16 + bj * 8 + j), __builtin_bit_cast(int, rsl)));
        r1[bj][j] = __builtin_bit_cast(float, __builtin_amdgcn_ds_bpermute(4 * (fq * 16 + bj * 8 + 4 + j), __builtin_bit_cast(int, rsl)));
      }
#pragma unroll
    for (int ai = 0; ai < 2; ++ai)
#pragma unroll
      for (int m = 0; m < 4; ++m) {
        const int row = u.pm * 256 + ai * 128 + wr * 64 + m * 16 + fr;
#pragma unroll
        for (int bj = 0; bj < 2; ++bj) f.st(row, u.pn * 256 + bj * 128 + wc * 32 + 8 * fq, acc[ai][bj][m][0] * r0[bj], acc[ai][bj][m][1] * r1[bj]);
      }
  }
};
struct Epi8Res {
  static constexpr bool PERM = true, AFTER_DRAIN = false;
  bf16_t* xb; float* part; float accscale;
  DI void operator()(const pg8::f32x4 (&acc)[2][2][4][2], const pg8::Unit& u, int wr, int wc, int fr, int fq) const {
    const int x32 = (((fq * 16 + fr) ^ 32) << 2);
#pragma unroll
    for (int ai = 0; ai < 2; ++ai)
#pragma unroll
      for (int m = 0; m < 4; ++m) {
        const int row = u.pm * 256 + ai * 128 + wr * 64 + m * 16 + fr;
        float ss = 0.f;
#pragma unroll
        for (int bj = 0; bj < 2; ++bj) {
          const long o = (long)row * DM + u.pn * 256 + bj * 128 + wc * 32 + 8 * fq;
          const u32x4 xr = *(const u32x4*)(xb + o);
          f32x4 v0, v1;
          v0[0] = bflo(xr[0]); v0[1] = bfhi(xr[0]); v0[2] = bflo(xr[1]); v0[3] = bfhi(xr[1]);
          v1[0] = bflo(xr[2]); v1[1] = bfhi(xr[2]); v1[2] = bflo(xr[3]); v1[3] = bfhi(xr[3]);
          v0 = v0 + acc[ai][bj][m][0] * accscale; v1 = v1 + acc[ai][bj][m][1] * accscale;
          u32x4 w; w[0] = pk2(v0[0], v0[1]); w[1] = pk2(v0[2], v0[3]); w[2] = pk2(v1[0], v1[1]); w[3] = pk2(v1[2], v1[3]);
          *(u32x4*)(xb + o) = w;
          ss += (v0[0] * v0[0] + v0[1] * v0[1]) + (v0[2] * v0[2] + v0[3] * v0[3]) + (v1[0] * v1[0] + v1[1] * v1[1]) + (v1[2] * v1[2] + v1[3] * v1[3]);
        }
        ss += __builtin_bit_cast(float, __builtin_amdgcn_ds_swizzle(__builtin_bit_cast(int, ss), 0x401f));
        ss += xch32(ss, x32);
        if (fq == 0) part[(long)row * 16 + u.pn * 4 + wc] = ss;
      }
  }
};
template <class E> DI void run_gemm_e(const bf16_t* A, const bf16_t* Bt, int M, int N, int K, const E& e) {
  pg8::Gemm g{A, Bt, M, N, K};
  pg8::StaticOrder so; so.init(M, N, (int)gridDim.x, (int)blockIdx.x);
  pg8::gemm_phase<E, pg8::StaticOrder, true, true>(LDSP, g, so, e);
}
template <class F> DI void run_gemm(const bf16_t* A, const bf16_t* Bt, int M, int N, int K, const F& f) {
  pg8::Gemm g{A, Bt, M, N, K};
  pg8::StaticOrder so; so.init(M, N, (int)gridDim.x, (int)blockIdx.x);
  Epi8<F> e{f};
  pg8::gemm_phase<Epi8<F>, pg8::StaticOrder, true, true>(LDSP, g, so, e);
}
struct OneUnit { int pm, pn;
  DI bool next(int i, pg8::Unit& u) const { if (i) return false; u.pm = pm; u.pn = pn; return true; }
  DI void a_ready(const pg8::Unit&) const {}
  DI void done(const pg8::Unit&) const {} };

DI void tr_tile(const float* __restrict__ src, int lds_, int k0, int n0, bf16_t* __restrict__ dst, int ldd, int nd0, float scale, float* sm, const float* __restrict__ gk = nullptr) {
  const int t = otid() & 255;
  f32x4 v[8];
#pragma unroll
  for (int i = 0; i < 8; ++i) {
    const int kr = (t >> 4) + 16 * i, nc = (t & 15) * 4;
    v[i] = *(const f32x4*)(src + (long)(k0 + kr) * lds_ + n0 + nc);
    if (gk) v[i] = v[i] * gk[k0 + kr];
  }
#pragma unroll
  for (int i = 0; i < 8; ++i) {
    const int kr = (t >> 4) + 16 * i, nc = (t & 15) * 4;
    sm[kr * 65 + nc + 0] = v[i][0]; sm[kr * 65 + nc + 1] = v[i][1]; sm[kr * 65 + nc + 2] = v[i][2]; sm[kr * 65 + nc + 3] = v[i][3];
  }
  __syncthreads();
  const int n = t >> 2, ks = (t & 3) * 32;
  bf16_t* d = dst + (long)(nd0 + n) * ldd + k0 + ks;
#pragma unroll
  for (int q = 0; q < 4; ++q) {
    u32x4 w;
#pragma unroll
    for (int j = 0; j < 4; ++j) w[j] = pk2(sm[(ks + 8 * q + 2 * j) * 65 + n] * scale, sm[(ks + 8 * q + 2 * j + 1) * 65 + n] * scale);
    *(u32x4*)(d + 8 * q) = w;
  }
  __syncthreads();
}

constexpr int NT_ALL = DEPTH * 28 * 8, NT_OUT = DEPTH * 16 * 8, NT_UP = DEPTH * 64 * 8, NT_DOWN = DEPTH * 16 * 32, NT_PW = DEPTH * 4 * 2;
constexpr int N_FOLD = DEPTH * 2 * 4 * 16, N_SGU = 128, N_DM = 112, N_LAM = 1;
constexpr int PREP_ITEMS = NT_ALL + NT_OUT + NT_UP + NT_DOWN + NT_PW + N_FOLD + N_SGU + N_DM + N_LAM;

DI void prep_item(const Params& p, int it, float* sm) {
  const int t = otid() & 255;
  if (it < NT_ALL) {
    const int l = it / (28 * 8), rem = it % (28 * 8), nt = rem / 8, kt = rem % 8;
    const int nd = nt * 64;
    int nsrc; float scale = 1.f;
    if (nd < 512) { nsrc = nd; if (nd < 256) scale = 0.17677669529663687f * LOG2E; }
    else if (nd < 1024) nsrc = 768 + (nd - 512);
    else if (nd < 1536) nsrc = 1536 + (nd - 1024);
    else nsrc = 512 + (nd - 1536);
    tr_tile(p.w_in + (long)l * DM * 2048, 2048, kt * 128, nsrc, p.WallT + (long)l * WALL_N * DM, DM, nd, scale, sm, p.norm1_g + l * DM);
    return;
  }
  it -= NT_ALL;
  if (it < NT_OUT) {
    const int l = it / 128, rem = it % 128, nt = rem / 8, kt = rem % 8;
    tr_tile(p.w_out + (long)l * DM * DM, DM, kt * 128, nt * 64, p.WoutT + (long)l * DM * DM, DM, nt * 64, 1.f, sm);
    return;
  }
  it -= NT_OUT;
  if (it < NT_UP) {
    const int l = it / 512, rem = it % 512, nt = rem / 8, kt = rem % 8;
    tr_tile(p.w_up + (long)l * DM * DFF, DFF, kt * 128, nt * 64, p.WupT + (long)l * DFF * DM, DM, nt * 64, 1.f, sm, p.norm2_g + l * DM);
    return;
  }
  it -= NT_UP;
  if (it < NT_DOWN) {
    const int l = it / 512, rem = it % 512, nt = rem / 32, kt = rem % 32;
    tr_tile(p.w_down + (long)l * DFF * DM, DM, kt * 128, nt * 64, p.WdownT + (long)l * DM * DFF, DFF, nt * 64, 1.f, sm);
    return;
  }
  it -= NT_DOWN;
  if (it < NT_PW) {
    const int l = it / 8, rem = it % 8, nt = rem / 2, kt = rem % 2;
    tr_tile(p.conv_pw_w + (long)l * 65536, 256, kt * 128, nt * 64, p.pwT + (long)l * 65536, 256, nt * 64, 1.f, sm);
    return;
  }
  it -= NT_PW;
  if (it < N_FOLD) {
    const int l = it >> 7, pq = (it >> 6) & 1, g = (it >> 4) & 3, kcn = it & 15;
    const float* fw = p.fnet_w + ((long)l * 4 + g) * 4096;
    float* trig = sm + 4096;
    if (t < 64) trig[t] = pq ? sinpif((float)t * (1.f / 32.f)) : cospif((float)t * (1.f / 32.f));
    __syncthreads();
    for (int idx = t; idx < 4096; idx += 256) {
      const int c = idx >> 6, e = idx & 63;
      float s = 0.f;
      for (int kc = 0; kc < 64; ++kc) s += trig[(c * kc) & 63] * fw[kc * 64 + e];
      sm[idx] = s * (1.f / 512.f);
    }
    __syncthreads();
    const int k = kcn * 64 + (t & 63), e0 = (t >> 6) * 16;
    const float gk1 = p.norm1_g[l * DM + k];
    const float* wr = p.w_in + (long)l * DM * 2048 + (long)k * 2048 + 1280 + g * 64;
    f32x4 wv[16];
#pragma unroll
    for (int i = 0; i < 16; ++i) wv[i] = *(const f32x4*)(wr + 4 * i);
    bf16_t* dst = p.WallT + (long)l * WALL_N * DM + (long)(1792 + pq * 256 + g * 64) * DM + k;
#pragma unroll 1
    for (int e = e0; e < e0 + 16; ++e) {
      float s = 0.f;
#pragma unroll
      for (int i = 0; i < 16; ++i) {
        s += wv[i][0] * sm[(4 * i + 0) * 64 + e]; s += wv[i][1] * sm[(4 * i + 1) * 64 + e];
        s += wv[i][2] * sm[(4 * i + 2) * 64 + e]; s += wv[i][3] * sm[(4 * i + 3) * 64 + e];
      }
      dst[(long)e * DM] = (bf16_t)(pk2(s * gk1, 0.f) & 0xffffu);
    }
    __syncthreads();
    return;
  }
  it -= N_FOLD;
  if (it < N_SGU) {
    const long o = (long)it * 2048 + t * 8;
    const f32x4 a = *(const f32x4*)(p.sgu_w + o), b = *(const f32x4*)(p.sgu_w + o + 4);
    u32x4 w; w[0] = pk2(a[0], a[1]); w[1] = pk2(a[2], a[3]); w[2] = pk2(b[0], b[1]); w[3] = pk2(b[2], b[3]);
    *(u32x4*)(p.sguW + o) = w;
    return;
  }
  it -= N_SGU;
  if (it < N_DM) {
    const int e = it * 256 + t;
    if (e < 16384) {
      const int m = e >> 7, k = e & 127, ro = m >> 6, k1 = m & 63, ri = k >> 6, s1 = k & 63;
      const float ang = (float)((s1 * k1) & 63) * (1.f / 32.f);
      const float c = cospif(ang), sn = sinpif(ang);
      const float v = (ro == 0) ? (ri == 0 ? c : -sn) : (ri == 0 ? sn : c);
      p.M1[e] = (bf16_t)(pk2(v, 0.f) & 0xffffu);
    } else if (e < 16384 + 8192) {
      const int e2 = e - 16384, k2 = e2 >> 7, k = e2 & 127, ri = k >> 6, s2 = k & 63;
      const float ang = (float)((s2 * k2) & 63) * (1.f / 32.f);
      const float v = (ri == 0) ? cospif(ang) : -sinpif(ang);
      p.M3[e2] = (bf16_t)(pk2(v, 0.f) & 0xffffu);
    } else {
      const int e3 = e - 16384 - 8192, k1 = e3 >> 6, s2 = e3 & 63;
      const float ang = (float)(s2 * k1) * (1.f / 2048.f);
      ((unsigned*)p.TW)[e3] = pk2(cospif(ang), sinpif(ang));
    }
    return;
  }
  it -= N_DM;
  if (t < DEPTH) {
    const int l = t;
    float s1 = 0.f, s2 = 0.f;
    for (int i = 0; i < 32; ++i) { s1 += p.lam_q1[l * 32 + i] * p.lam_k1[l * 32 + i]; s2 += p.lam_q2[l * 32 + i] * p.lam_k2[l * 32 + i]; }
    const float lam_init = 0.8f - 0.6f * expf(-0.3f * (float)l);
    p.lam[l] = expf(s1) - expf(s2) + lam_init;
  }
}

NI void prep_phase() {
  KPARAMS;
  const int half = otid() >> 8;
  float* sm = (float*)smem_raw + half * (HALF_E / 2);
  for (int it0 = blockIdx.x * 2 + half; it0 < PREP_ITEMS; it0 += gridDim.x * 2) prep_item(p, it0, sm);
  const int tid_ = otid(); const int lane = tid_ & 63, wid = tid_ >> 6, x32 = ((lane ^ 32) << 2);
  for (int row0 = blockIdx.x * 8 + wid; row0 < NTOK; row0 += gridDim.x * 16) {
    f32x4 v[2][4];
#pragma unroll
    for (int rr = 0; rr < 2; ++rr) {
      const int row = row0 + rr * gridDim.x * 8;
#pragma unroll
      for (int i = 0; i < 4; ++i) v[rr][i] = (row < NTOK) ? *(const f32x4*)(p.x + (long)row * DM + lane * 4 + 256 * i) : (f32x4){0.f, 0.f, 0.f, 0.f};
    }
#pragma unroll
    for (int rr = 0; rr < 2; ++rr) {
      const int row = row0 + rr * gridDim.x * 8;
      float ss = 0.f;
#pragma unroll
      for (int i = 0; i < 4; ++i) ss += v[rr][i][0] * v[rr][i][0] + v[rr][i][1] * v[rr][i][1] + v[rr][i][2] * v[rr][i][2] + v[rr][i][3] * v[rr][i][3];
      ss = wave_sum(ss, x32);
      if (row < NTOK) {
#pragma unroll
        for (int i = 0; i < 4; ++i) { u32x2 w; w[0] = pk2(v[rr][i][0], v[rr][i][1]); w[1] = pk2(v[rr][i][2], v[rr][i][3]); *(u32x2*)(p.xn + (long)row * DM + lane * 4 + 256 * i) = w; }
        if (lane < 16) p.part[(long)row * 16 + lane] = (lane == 0) ? ss : 0.f;
      }
    }
  }
}

NI void final_rms_phase(const bf16_t* __restrict__ src, const float* __restrict__ g, float* __restrict__ dstf) {
  const int tid_ = otid(); const int lane = tid_ & 63, wid = tid_ >> 6, x32 = ((lane ^ 32) << 2);
  f32x4 gv[4];
#pragma unroll
  for (int i = 0; i < 4; ++i) gv[i] = *(const f32x4*)(g + lane * 4 + 256 * i);
  for (int row = blockIdx.x * 8 + wid; row < NTOK; row += gridDim.x * 8) {
    f32x4 v[4];
    float ss = 0.f;
#pragma unroll
    for (int i = 0; i < 4; ++i) {
      const u32x2 r = *(const u32x2*)(src + (long)row * DM + lane * 4 + 256 * i);
      v[i][0] = bflo(r[0]); v[i][1] = bfhi(r[0]); v[i][2] = bflo(r[1]); v[i][3] = bfhi(r[1]);
      ss += v[i][0] * v[i][0] + v[i][1] * v[i][1] + v[i][2] * v[i][2] + v[i][3] * v[i][3];
    }
    ss = wave_sum(ss, x32);
    const float rs = rsqrtf(ss * (1.f / 1024.f) + EPS);
#pragma unroll
    for (int i = 0; i < 4; ++i) *(f32x4*)(dstf + (long)row * DM + lane * 4 + 256 * i) = v[i] * rs * gv[i];
  }
}

DI u32x4 pk8(f32x4 a, f32x4 b) { u32x4 w; w[0] = pk2(a[0], a[1]); w[1] = pk2(a[2], a[3]); w[2] = pk2(b[0], b[1]); w[3] = pk2(b[2], b[3]); return w; }
struct StH { bf16_t* h; DI void st(int r, int c, f32x4 a, f32x4 b) const { *(u32x4*)(h + (long)r * HC + c) = pk8(a, b); } };
struct StT { bf16_t* Vt; bf16_t* PQt;
  DI void st(int n, int tok, f32x4 a, f32x4 b) const {
    const int bb = tok >> 12, s = tok & 4095; const u32x4 w = pk8(a, b);
    if (n < 256) *(u32x4*)(Vt + ((long)(bb * 256 + n)) * 4096 + s) = w;
    else { const int np = n - 256, pq = np >> 8, ch = np & 255; *(u32x4*)(PQt + ((long)(bb * 256 + ch)) * 8192 + pq * 4096 + s) = w; }
  } };
struct StRes { const float* xin; float* out;
  DI void st(int r, int c, f32x4 a, f32x4 b) const { const long o = (long)r * DM + c; const f32x4 x0 = *(const f32x4*)(xin + o), x1 = *(const f32x4*)(xin + o + 4); *(f32x4*)(out + o) = x0 + a; *(f32x4*)(out + o + 4) = x1 + b; } };
struct StUp { bf16_t* hid;
  DI void st(int r, int c, f32x4 a, f32x4 b) const {
#pragma unroll
    for (int j = 0; j < 4; ++j) { a[j] = fmaxf(a[j], 0.f); b[j] = fmaxf(b[j], 0.f); }
    __builtin_nontemporal_store(pk8(a * a, b * b), (u32x4*)(hid + (long)r * DFF + c)); } };

NI void gemm_in_phase(int l) {
  KPARAMS;
  const bf16_t* W = p.WallT + (long)l * WALL_N * DM;
  run_gemm_e(p.xn, W, NTOK, HC, DM, Epi8Rows<StH>{StH{p.h}, p.part});
  run_gemm_e(W + (long)HC * DM, p.xn, 768, NTOK, DM, Epi8Cols<StT>{StT{p.Vt, p.PQt}, p.part});
}
NI void gemm_out_phase(int l, float accscale) {
  KPARAMS;
  run_gemm_e(p.y, p.WoutT + (long)l * DM * DM, NTOK, DM, DM, Epi8Res{p.xn, p.part, accscale});
}
NI void gemm_up_phase(int l) {
  KPARAMS;
  run_gemm_e(p.xn, p.WupT + (long)l * DFF * DM, NTOK, DFF, DM, Epi8Rows<StUp>{StUp{p.hid}, p.part});
}
NI void gemm_down_phase(int l, float accscale) {
  KPARAMS;
  run_gemm_e(p.hid, p.WdownT + (long)l * DM * DFF, NTOK, DM, DFF, Epi8Res{p.xn, p.part, accscale});
}

constexpr int ARS = 72;
constexpr int ATILE = 64 * ARS;
NI void attn_tile(int l, int id, LAS3 unsigned* cnt, unsigned& target) {
  KPARAMS;
  const int tidf = otid(), half = __builtin_amdgcn_readfirstlane(tidf >> 8), tid = tidf & 255, lane = tid & 63, wid = __builtin_amdgcn_readfirstlane(tid >> 6), r = lane & 31, hh = lane >> 5, x32 = ((lane ^ 32) << 2);
  bf16_t* smem = SMEM + half * HALF_E;
  const int head = 3 - (id >> 8), b = (id >> 5) & 7, qb = id & 31;
  const float slope = (head == 0) ? 0.25f : (head == 1) ? 0.0625f : (head == 2) ? 0.015625f : 0.00390625f;
  const float ncs = -slope * LOG2E, cs = slope * LOG2E;
  const int qi = qb * 128 + wid * 32 + r;
  const bf16_t* qrow = p.h + ((long)(b * SEQ + qi)) * HC + head * 64;
  bf16x8 qf[2][2];
#pragma unroll
  for (int m = 0; m < 2; ++m)
#pragma unroll
    for (int s = 0; s < 2; ++s) qf[m][s] = *(const bf16x8*)(qrow + m * 32 + s * 16 + hh * 8);
  const bf16_t* kbase = p.h + ((long)(b * SEQ)) * HC + 256 + head * 64;
  const bf16_t* vbase = p.Vt + ((long)((b * 4 + head) * 64)) * SEQ;
  const int srow = tid >> 3, scol = (tid & 7) * 8;
  u32x4 rk[2], rv[2];
  f32x16 O[2][2];
#pragma unroll
  for (int m = 0; m < 2; ++m)
#pragma unroll
    for (int vb = 0; vb < 2; ++vb)
#pragma unroll
      for (int i = 0; i < 16; ++i) O[m][vb][i] = 0.f;
  float mrun[2] = {0.f, 0.f}, lrun[2] = {0.f, 0.f};
  const int kperm = (r & 19) | ((r & 4) << 1) | ((r & 8) >> 1);
  const int ktd = (qb * 128 + wid * 32) >> 6;
  unsigned csw, jrelw[2];
  { const unsigned h_ = pk2(cs, 0.f) & 0xffffu; csw = h_ | (pk2(cs - bflo(h_), 0.f) << 16); }
#pragma unroll
  for (int kb = 0; kb < 2; ++kb) { const float j_ = (float)(kb * 32 + kperm); jrelw[kb] = pk2(j_, j_); }

  const int wkeys = (head == 0) ? 305 : (head == 1) ? 1220 : SEQ;
  const int kt_lo = max(0, qb * 128 - wkeys) >> 6, kt_hi = min(SEQ, qb * 128 + 128 + wkeys + 63) >> 6;
#pragma unroll
  for (int i = 0; i < 2; ++i) {
    rk[i] = *(const u32x4*)(kbase + (long)(kt_lo * 64 + srow + 32 * i) * HC + scol);
    rv[i] = *(const u32x4*)(vbase + (long)(srow + 32 * i) * SEQ + kt_lo * 64 + scol);
  }
#pragma unroll
  for (int i = 0; i < 2; ++i) { *(u32x4*)(smem + (srow + 32 * i) * ARS + scol) = rk[i]; *(u32x4*)(smem + ATILE + (srow + 32 * i) * ARS + scol) = rv[i]; }
  asm volatile("" :: "v"(qf[0][0]), "v"(qf[0][1]), "v"(qf[1][0]), "v"(qf[1][1]));
  HBAR();
  for (int kt = kt_lo; kt < kt_hi; ++kt) {
    const bool more = (kt + 1) < kt_hi;
    if (more) {
#pragma unroll
      for (int i = 0; i < 2; ++i) {
        rk[i] = *(const u32x4*)(kbase + (long)((kt + 1) * 64 + srow + 32 * i) * HC + scol);
        rv[i] = *(const u32x4*)(vbase + (long)(srow + 32 * i) * SEQ + (kt + 1) * 64 + scol);
      }
    }
    const bf16_t* Ks = smem + ((kt - kt_lo) & 1) * 2 * ATILE;
    const bf16_t* Vs = Ks + ATILE;
    const float dbase = (float)(qi - kt * 64 - 8 * hh);
    const bool diag = (kt == ktd);
#pragma unroll
    for (int m = 0; m < 2; ++m) {
      __builtin_amdgcn_sched_barrier(0);
      f32x16 x[2];
      if (!diag) {
        const bool left = kt < ktd;
        const float C = fmaf(left ? cs : -cs, (float)(kt * 64 - qi), -mrun[m]);
        const unsigned wC = pk2(C, 0.f), wL = pk2(C - bflo(wC), 0.f);
        u32x4 qa; qa[0] = hh ? 0u : (left ? csw : (csw ^ 0x80008000u)); qa[1] = hh ? 0u : ((wC & 0xffffu) | (wL << 16)); qa[2] = 0u; qa[3] = 0u;
#pragma unroll
        for (int kb = 0; kb < 2; ++kb) {
          u32x4 ka; ka[0] = hh ? 0u : jrelw[kb]; ka[1] = hh ? 0u : 0x3f803f80u; ka[2] = 0u; ka[3] = 0u;
#pragma unroll
          for (int i = 0; i < 16; ++i) x[kb][i] = 0.f;
          x[kb] = __builtin_amdgcn_mfma_f32_32x32x16_bf16(__builtin_bit_cast(bf16x8, ka), __builtin_bit_cast(bf16x8, qa), x[kb], 0, 0, 0);
#pragma unroll
          for (int s = 0; s < 2; ++s) {
            const bf16x8 kf = *(const bf16x8*)(Ks + (kb * 32 + kperm) * ARS + m * 32 + s * 16 + hh * 8);
            x[kb] = __builtin_amdgcn_mfma_f32_32x32x16_bf16(kf, qf[m][s], x[kb], 0, 0, 0);
          }
        }
      } else {
#pragma unroll
        for (int kb = 0; kb < 2; ++kb) {
#pragma unroll
          for (int i = 0; i < 16; ++i) x[kb][i] = 0.f;
#pragma unroll
          for (int s = 0; s < 2; ++s) {
            const bf16x8 kf = *(const bf16x8*)(Ks + (kb * 32 + kperm) * ARS + m * 32 + s * 16 + hh * 8);
            x[kb] = __builtin_amdgcn_mfma_f32_32x32x16_bf16(kf, qf[m][s], x[kb], 0, 0, 0);
          }
        }
        const float nm = -mrun[m];
#pragma unroll
        for (int kb = 0; kb < 2; ++kb)
#pragma unroll
          for (int i = 0; i < 16; ++i) {
            const float off = (float)(kb * 32 + 16 * (i >> 3) + (i & 7));
            x[kb][i] = fmaf(ncs, fabsf(dbase - off), x[kb][i]) + nm;
          }
      }
      float mx = -1e30f;
#pragma unroll
      for (int kb = 0; kb < 2; ++kb)
#pragma unroll
        for (int i = 0; i < 16; ++i) mx = fmaxf(mx, x[kb][i]);
      mx = fmaxf(mx, xch32(mx, x32));
      if (__builtin_amdgcn_ballot_w64(mx > 8.f) != 0ull) {
        const float delta = fmaxf(mx, 0.f);
        const float alpha = __builtin_amdgcn_exp2f(-delta);
        mrun[m] += delta;
        lrun[m] *= alpha;
#pragma unroll
        for (int vb = 0; vb < 2; ++vb)
#pragma unroll
          for (int i = 0; i < 16; ++i) O[m][vb][i] *= alpha;
#pragma unroll
        for (int kb = 0; kb < 2; ++kb)
#pragma unroll
          for (int i = 0; i < 16; ++i) x[kb][i] -= delta;
      }
      float ps = 0.f;
#pragma unroll
      for (int kb = 0; kb < 2; ++kb)
#pragma unroll
        for (int i = 0; i < 16; ++i) { x[kb][i] = __builtin_amdgcn_exp2f(x[kb][i]); ps += x[kb][i]; }
      lrun[m] += ps;
#pragma unroll
      for (int kb = 0; kb < 2; ++kb)
#pragma unroll
        for (int s = 0; s < 2; ++s) {
          u32x4 pw;
#pragma unroll
          for (int j = 0; j < 4; ++j) pw[j] = pk2(x[kb][8 * s + 2 * j], x[kb][8 * s + 2 * j + 1]);
          const bf16x8 pf = __builtin_bit_cast(bf16x8, pw);
#pragma unroll
          for (int vb = 0; vb < 2; ++vb) {
            const bf16x8 vf = *(const bf16x8*)(Vs + (vb * 32 + r) * ARS + kb * 32 + s * 16 + hh * 8);
            O[m][vb] = __builtin_amdgcn_mfma_f32_32x32x16_bf16(vf, pf, O[m][vb], 0, 0, 0);
          }
        }
    }
    if (more) {
      bf16_t* wk = smem + ((kt + 1 - kt_lo) & 1) * 2 * ATILE;
#pragma unroll
      for (int i = 0; i < 2; ++i) { *(u32x4*)(wk + (srow + 32 * i) * ARS + scol) = rk[i]; *(u32x4*)(wk + ATILE + (srow + 32 * i) * ARS + scol) = rv[i]; }
    }
    HBAR();
  }
  asm volatile("" ::: "memory");
  const int tid2 = otid() & 255, lane2 = tid2 & 63, hh2 = lane2 >> 5, qi2 = qb * 128 + __builtin_amdgcn_readfirstlane(tid2 >> 6) * 32 + (lane2 & 31);
  const float lam = p.lam[l];
  int lx = l; asm volatile("" : "+s"(lx));
  const float lam_init = (lx == 0) ? 0.2f : (lx == 1) ? 0.35550907f : (lx == 2) ? 0.47071302f : 0.55605820f;
  const float l1 = lrun[0] + xch32(lrun[0], x32), l2 = lrun[1] + xch32(lrun[1], x32);
  const float i1 = 1.f / l1, i2 = lam / l2;
  float ss = 0.f;
#pragma unroll
  for (int vb = 0; vb < 2; ++vb)
#pragma unroll
    for (int i = 0; i < 16; ++i) { const float o = O[0][vb][i] * i1 - O[1][vb][i] * i2; O[0][vb][i] = o; ss += o * o; }
  ss += xch32(ss, x32);
  const float rs = rsqrtf(ss * (1.f / 64.f) + EPS) * (1.f - lam_init);
  const float* sg = p.subln_g + l * 64;
  bf16_t* yrow = p.y + ((long)(b * SEQ + qi2)) * DM + head * 64;
#pragma unroll
  for (int vb = 0; vb < 2; ++vb)
#pragma unroll
    for (int g4 = 0; g4 < 4; ++g4) {
      const int vc = vb * 32 + 8 * g4 + 4 * hh2;
      const f32x4 gg = *(const f32x4*)(sg + vc);
      u32x2 w;
      w[0] = pk2(O[0][vb][4 * g4 + 0] * rs * gg[0], O[0][vb][4 * g4 + 1] * rs * gg[1]);
      w[1] = pk2(O[0][vb][4 * g4 + 2] * rs * gg[2], O[0][vb][4 * g4 + 3] * rs * gg[3]);
      *(u32x2*)(yrow + vc) = w;
    }
}

constexpr int ZRS = 264;
NI void conv_tile(int l, int id, LAS3 unsigned* cnt, unsigned& target) {
  KPARAMS;
  const int tidf = otid(), half = __builtin_amdgcn_readfirstlane(tidf >> 8), tid = tidf & 255, lane = tid & 63, wid = __builtin_amdgcn_readfirstlane(tid >> 6), x32 = ((lane ^ 32) << 2);
  bf16_t* smem = SMEM + half * HALF_E;
  const int b = id >> 6, t0 = (id & 63) * 64;
  for (int idx = tid; idx < 94 * 32; idx += 256) {
    const int row = idx >> 5, c8 = (idx & 31) * 8;
    const int tok = t0 - 15 + row;
    u32x4 w = (u32x4){0u, 0u, 0u, 0u};
    if (tok >= 0 && tok < SEQ) {
      const bf16_t* hp = p.h + ((long)(b * SEQ + tok)) * HC + 512 + c8;
      const u32x4 a = *(const u32x4*)hp, g = *(const u32x4*)(hp + 256);
#pragma unroll
      for (int j = 0; j < 4; ++j) {
        const float a0 = bflo(a[j]), a1 = bfhi(a[j]), g0 = bflo(g[j]), g1 = bfhi(g[j]);
        w[j] = pk2(a0 * __builtin_amdgcn_rcpf(1.f + __builtin_amdgcn_exp2f(-LOG2E * g0)), a1 * __builtin_amdgcn_rcpf(1.f + __builtin_amdgcn_exp2f(-LOG2E * g1)));
      }
    }
    *(u32x4*)(smem + row * ZRS + c8) = w;
  }
  HBAR();
  {
    const int c = tid;
    float wv[31];
#pragma unroll
    for (int j = 0; j < 31; ++j) wv[j] = p.conv_dw_w[((long)l * 31 + j) * 256 + c];
    const float cb = p.conv_dw_b[l * 256 + c], lg = p.conv_ln_g[l * 256 + c], lb = p.conv_ln_b[l * 256 + c];
#pragma unroll 1
    for (int ch = 0; ch < 8; ++ch) {
      float zw[38];
#pragma unroll
      for (int j = 0; j < 38; ++j) zw[j] = bf2f(smem[(ch * 8 + j) * ZRS + c]);
      float o[8];
#pragma unroll
      for (int tt = 0; tt < 8; ++tt) {
        float s = cb;
#pragma unroll
        for (int j = 0; j < 31; ++j) s = fmaf(wv[j], zw[tt + j], s);
        o[tt] = s;
      }
#pragma unroll
      for (int tt = 0; tt < 8; ++tt) {
        const float s1 = wave_sum(o[tt], x32), s2 = wave_sum(o[tt] * o[tt], x32);
        const float mu = s1 * (1.f / 64.f);
        const float var = fmaxf(s2 * (1.f / 64.f) - mu * mu, 0.f);
        const float yv = (o[tt] - mu) * rsqrtf(var + EPS) * lg + lb;
        const float sv = yv * __builtin_amdgcn_rcpf(1.f + __builtin_amdgcn_exp2f(-LOG2E * yv));
        smem[(ch * 8 + tt) * ZRS + c] = (bf16_t)(pk2(sv, 0.f) & 0xffffu);
      }
    }
  }
  HBAR();
  {
    const int fr = lane & 15, fq = lane >> 4;
    const bf16_t* W = p.pwT + (long)l * 65536 + (long)(wid * 64) * 256;
    f32x4 acc[4][4];
#pragma unroll
    for (int m = 0; m < 4; ++m)
#pragma unroll
      for (int n = 0; n < 4; ++n) acc[m][n] = (f32x4){0.f, 0.f, 0.f, 0.f};
#pragma unroll 2
    for (int ks = 0; ks < 8; ++ks) {
      bf16x8 af[4], bfr[4];
#pragma unroll
      for (int m = 0; m < 4; ++m) af[m] = *(const bf16x8*)(smem + (m * 16 + fr) * ZRS + ks * 32 + fq * 8);
#pragma unroll
      for (int n = 0; n < 4; ++n) bfr[n] = *(const bf16x8*)(W + (long)(n * 16 + fr) * 256 + ks * 32 + fq * 8);
#pragma unroll
      for (int m = 0; m < 4; ++m)
#pragma unroll
        for (int n = 0; n < 4; ++n) acc[m][n] = __builtin_amdgcn_mfma_f32_16x16x32_bf16(bfr[n], af[m], acc[m][n], 0, 0, 0);
    }
    const float* pb = p.conv_pw_b + l * 256;
#pragma unroll
    for (int m = 0; m < 4; ++m)
#pragma unroll
      for (int n = 0; n < 4; ++n) {
        const int tok = t0 + m * 16 + fr, col = wid * 64 + n * 16 + fq * 4;
        const f32x4 bv = *(const f32x4*)(pb + col);
        const f32x4 v = acc[m][n] + bv;
        u32x2 w; w[0] = pk2(v[0], v[1]); w[1] = pk2(v[2], v[3]);
        *(u32x2*)(p.y + ((long)(b * SEQ + tok)) * DM + 256 + col) = w;
      }
  }
  HBAR();
}

constexpr int VRS = 258;
NI void sgu_tile(int l, int id, LAS3 unsigned* cnt, unsigned& target) {
  KPARAMS;
  const int tidf = otid(), half = __builtin_amdgcn_readfirstlane(tidf >> 8), tid = tidf & 255, lane = tid & 63, wid = __builtin_amdgcn_readfirstlane(tid >> 6), x32 = ((lane ^ 32) << 2);
  bf16_t* smem = SMEM + half * HALF_E;
  const long T0 = (long)id * 128;
  {
    const f32x4 lg = *(const f32x4*)(p.sgu_ln_g + l * 256 + lane * 4), lb = *(const f32x4*)(p.sgu_ln_b + l * 256 + lane * 4);
#pragma unroll 4
    for (int i = 0; i < 32; ++i) {
      const int s = wid * 32 + i;
      const u32x2 raw = *(const u32x2*)(p.h + (T0 + s) * HC + 1280 + lane * 4);
      const float v0 = bflo(raw[0]), v1 = bfhi(raw[0]), v2 = bflo(raw[1]), v3 = bfhi(raw[1]);
      const float s1 = wave_sum(v0 + v1 + v2 + v3, x32);
      const float mu = s1 * (1.f / 256.f);
      const float d0 = v0 - mu, d1 = v1 - mu, d2 = v2 - mu, d3 = v3 - mu;
      const float s2 = wave_sum(d0 * d0 + d1 * d1 + d2 * d2 + d3 * d3, x32);
      const float rs = rsqrtf(s2 * (1.f / 256.f) + EPS);
      unsigned* dst = (unsigned*)(smem + s * VRS + lane * 4);
      dst[0] = pk2(d0 * rs * lg[0] + lb[0], d1 * rs * lg[1] + lb[1]);
      dst[1] = pk2(d2 * rs * lg[2] + lb[2], d3 * rs * lg[3] + lb[3]);
    }
  }
  HBAR();
  {
    const int fr = lane & 15, fq = lane >> 4, g = wid;
    const bf16_t* W = p.sguW + ((long)(l * 4 + g)) * 16384;
    const float* bs = p.sgu_b + ((long)(l * 4 + g)) * 128;
#pragma unroll 1
    for (int th = 0; th < 2; ++th) {
      f32x4 acc[4][4];
#pragma unroll
      for (int m = 0; m < 4; ++m)
#pragma unroll
        for (int n = 0; n < 4; ++n) acc[m][n] = (f32x4){0.f, 0.f, 0.f, 0.f};
#pragma unroll 1
      for (int ks = 0; ks < 4; ++ks) {
        bf16x8 vf[4], wf[4];
#pragma unroll
        for (int n = 0; n < 4; ++n) {
#pragma unroll
          for (int j = 0; j < 8; ++j) vf[n][j] = (short)smem[(ks * 32 + fq * 8 + j) * VRS + g * 64 + n * 16 + fr];
        }
#pragma unroll
        for (int m = 0; m < 4; ++m) wf[m] = *(const bf16x8*)(W + (long)(th * 64 + m * 16 + fr) * 128 + ks * 32 + fq * 8);
#pragma unroll
        for (int m = 0; m < 4; ++m)
#pragma unroll
          for (int n = 0; n < 4; ++n) acc[m][n] = __builtin_amdgcn_mfma_f32_16x16x32_bf16(vf[n], wf[m], acc[m][n], 0, 0, 0);
      }
#pragma unroll
      for (int m = 0; m < 4; ++m) {
        const int t = th * 64 + m * 16 + fr;
        const float bt = bs[t];
#pragma unroll
        for (int n = 0; n < 4; ++n) {
          const int c = g * 64 + n * 16 + fq * 4;
          const u32x2 ur = *(const u32x2*)(p.h + (T0 + t) * HC + 1024 + c);
          const f32x4 sv = acc[m][n] + bt;
          u32x2 w; w[0] = pk2(bflo(ur[0]) * sv[0], bfhi(ur[0]) * sv[1]); w[1] = pk2(bflo(ur[1]) * sv[2], bfhi(ur[1]) * sv[3]);
          *(u32x2*)(p.y + (T0 + t) * DM + 768 + c) = w;
        }
      }
    }
  }
  HBAR();
}

constexpr int FRS = 72, FPL = 64 * FRS, FCH = 2 * FPL + 64;
NI void fft_item(int l, int id, LAS3 unsigned* cnt, unsigned& target) {
  KPARAMS;
  const int tidf = otid(), half = __builtin_amdgcn_readfirstlane(tidf >> 8), tid = tidf & 255, lane = tid & 63, wid = __builtin_amdgcn_readfirstlane(tid >> 6);
  const int fr = lane & 15, fq = lane >> 4;
  bf16_t* smem = SMEM + half * HALF_E;
  const int b = id >> 7, ch0 = (id & 127) * 2;
  bf16_t* Ct = smem + 2 * FCH;
  unsigned* TWl = (unsigned*)(Ct + 2 * FPL);
  {
    u32x4 zv[8], cv[4], tv[4];
#pragma unroll
    for (int i = 0; i < 8; ++i) {
      const int chunk = tid + 256 * i, c = chunk >> 10, rem = chunk & 1023, ri = rem >> 9, s8 = rem & 511;
      zv[i] = *(const u32x4*)(p.PQt + ((long)(b * 256 + ch0 + c)) * 8192 + ri * 4096 + s8 * 8);
    }
#pragma unroll
    for (int i = 0; i < 4; ++i) {
      const int chunk = tid + 256 * i, tb = chunk >> 9, row = (chunk >> 3) & 63, c8 = chunk & 7;
      cv[i] = *(const u32x4*)(p.M1 + (tb * 64 + row) * 128 + c8 * 8);
      tv[i] = *(const u32x4*)((const unsigned*)p.TW + chunk * 4);
    }
#pragma unroll
    for (int i = 0; i < 8; ++i) {
      const int chunk = tid + 256 * i, c = chunk >> 10, rem = chunk & 1023, ri = rem >> 9, s8 = rem & 511;
      *(u32x4*)(smem + c * FCH + ri * FPL + (s8 >> 3) * FRS + (s8 & 7) * 8) = zv[i];
    }
#pragma unroll
    for (int i = 0; i < 4; ++i) {
      const int chunk = tid + 256 * i, tb = chunk >> 9, row = (chunk >> 3) & 63, c8 = chunk & 7;
      *(u32x4*)(Ct + tb * FPL + row * FRS + c8 * 8) = cv[i];
      *(u32x4*)(TWl + (chunk >> 4) * 68 + (chunk & 15) * 4) = tv[i];
    }
  }
  HBAR();
  {
    const int c = wid >> 1;
    bf16x8 zf[2][4];
#pragma unroll
    for (int nt = 0; nt < 2; ++nt)
#pragma unroll
      for (int ks = 0; ks < 4; ++ks) {
        const bf16_t* src = smem + c * FCH + (ks >> 1) * FPL + ((ks & 1) * 32 + fq * 8) * FRS + (wid & 1) * 32 + nt * 16 + fr;
#pragma unroll
        for (int j = 0; j < 8; ++j) zf[nt][ks][j] = (short)src[j * FRS];
      }
    f32x4 acc[2][8];
#pragma unroll
    for (int nt = 0; nt < 2; ++nt)
#pragma unroll
      for (int mt = 0; mt < 8; ++mt) acc[nt][mt] = (f32x4){0.f, 0.f, 0.f, 0.f};
#pragma unroll
    for (int mt = 0; mt < 8; ++mt)
#pragma unroll
      for (int ks = 0; ks < 4; ++ks) {
        u32x4 mw = *(const u32x4*)(Ct + (((mt >> 2) == (ks >> 1)) ? 0 : FPL) + ((mt & 3) * 16 + fr) * FRS + (ks & 1) * 32 + fq * 8);
        if ((mt >> 2) == 0 && (ks >> 1) == 1) mw = mw ^ 0x80008000u;
        const bf16x8 mf = __builtin_bit_cast(bf16x8, mw);
#pragma unroll
        for (int nt = 0; nt < 2; ++nt) acc[nt][mt] = __builtin_amdgcn_mfma_f32_16x16x32_bf16(zf[nt][ks], mf, acc[nt][mt], 0, 0, 0);
      }
#pragma unroll
    for (int nt = 0; nt < 2; ++nt)
#pragma unroll
      for (int m4 = 0; m4 < 4; ++m4) {
        const int k1 = m4 * 16 + fr, s2 = (wid & 1) * 32 + nt * 16 + fq * 4;
        const u32x4 tw = *(const u32x4*)(TWl + k1 * 68 + s2);
        const f32x4 yr = acc[nt][m4], yi = acc[nt][m4 + 4];
        const float cs[4] = {bflo(tw[0]), bflo(tw[1]), bflo(tw[2]), bflo(tw[3])}, sn[4] = {bfhi(tw[0]), bfhi(tw[1]), bfhi(tw[2]), bfhi(tw[3])};
        float tr[4], ti[4];
#pragma unroll
        for (int j = 0; j < 4; ++j) { tr[j] = yr[j] * cs[j] - yi[j] * sn[j]; ti[j] = yr[j] * sn[j] + yi[j] * cs[j]; }
        u32x2 wr_, wi_; wr_[0] = pk2(tr[0], tr[1]); wr_[1] = pk2(tr[2], tr[3]); wi_[0] = pk2(ti[0], ti[1]); wi_[1] = pk2(ti[2], ti[3]);
        *(u32x2*)(smem + c * FCH + k1 * FRS + s2) = wr_;
        *(u32x2*)(smem + c * FCH + FPL + k1 * FRS + s2) = wi_;
      }
  }
  HBAR();
  {
    f32x4 acc[2][4];
#pragma unroll
    for (int t = 0; t < 2; ++t)
#pragma unroll
      for (int mt = 0; mt < 4; ++mt) acc[t][mt] = (f32x4){0.f, 0.f, 0.f, 0.f};
#pragma unroll
    for (int ks = 0; ks < 4; ++ks) {
      bf16x8 tf[2];
#pragma unroll
      for (int t = 0; t < 2; ++t) {
        const int k1 = (wid * 2 + t) * 8 + (fr >> 1), c = fr & 1;
        tf[t] = *(const bf16x8*)(smem + c * FCH + (ks >> 1) * FPL + k1 * FRS + (ks & 1) * 32 + fq * 8);
      }
#pragma unroll
      for (int mt = 0; mt < 4; ++mt) {
        u32x4 mw = *(const u32x4*)(Ct + ((ks >> 1) ? FPL : 0) + (mt * 16 + fr) * FRS + (ks & 1) * 32 + fq * 8);
        if (ks >> 1) mw = mw ^ 0x80008000u;
        const bf16x8 mf = __builtin_bit_cast(bf16x8, mw);
#pragma unroll
        for (int t = 0; t < 2; ++t) acc[t][mt] = __builtin_amdgcn_mfma_f32_16x16x32_bf16(tf[t], mf, acc[t][mt], 0, 0, 0);
      }
    }
    const float b0 = p.fnet_b[l * 256 + ch0], b1 = p.fnet_b[l * 256 + ch0 + 1];
#pragma unroll
    for (int t = 0; t < 2; ++t)
#pragma unroll
      for (int mt = 0; mt < 4; ++mt)
#pragma unroll
        for (int jj = 0; jj < 2; ++jj) {
          const int k1 = (wid * 2 + t) * 8 + 2 * fq + jj, k2 = mt * 16 + fr;
          *(unsigned*)(p.y + ((long)(b * SEQ + k1 + 64 * k2)) * DM + 512 + ch0) = pk2(acc[t][mt][2 * jj] + b0, acc[t][mt][2 * jj + 1] + b1);
        }
  }
  HBAR();
}

NI void mixer_phase(int l, int rep) {
  KPARAMS;
  constexpr int NA = 1024, NF = 1024, NC = 512, ND = 256;
  const int tidf = otid(), half = __builtin_amdgcn_readfirstlane(tidf >> 8), tid = tidf & 255, lane = tid & 63;
  LAS3 unsigned* ctl = (LAS3 unsigned*)(LDSP + 2 * HALF_B);
  LAS3 unsigned* cnt = ctl + 8 + 4 * half;
  LAS3 unsigned* nx = ctl + 16 + 4 * half;
  if (tid == 0) *cnt = 0u;
  __syncthreads();
  unsigned target = 0u;
  for (int it = 0;; ++it) {
    if (tid == 0) nx[it & 1] = (unsigned)atomicAdd(p.ctr + l + 4 * rep, 1);
    HBAR();
    const int id = __builtin_amdgcn_readfirstlane((int)nx[it & 1]);
    if (id >= NA + NF + NC + ND) break;
    if (id < NA) attn_tile(l, id, cnt, target);
    else if (id < NA + NC) conv_tile(l, id - NA, cnt, target);
    else if (id < NA + NC + ND) sgu_tile(l, id - NA - NC, cnt, target);
    else fft_item(l, id - NA - NC - ND, cnt, target);
  }
}

#define LAS __attribute__((address_space(3)))
#define XB_TMO      128
#define XB_XCNT(j)  (256  + 64 * (j))
#define XB_XSUB(j)  (1280 + 64 * (j))
#define XB_XGEN(j)  (2304 + 64 * (j))
#define XB_TOP      3328
#define XB_TOPGEN   3392
#define XCD_BAR_WORDS 3456
#define XB_SPIN_CAP (1u << 18)

__device__ __forceinline__ unsigned xb_ld(unsigned* p)              { return __hip_atomic_load(p, __ATOMIC_RELAXED, __HIP_MEMORY_SCOPE_AGENT); }
__device__ __forceinline__ unsigned xb_add(unsigned* p, unsigned v) { return __hip_atomic_fetch_add(p, v, __ATOMIC_RELAXED, __HIP_MEMORY_SCOPE_AGENT); }
__device__ __forceinline__ unsigned xb_xcc_id() { return (unsigned)__builtin_amdgcn_s_getreg((3 << 11) | 20) & 0xFu; }
#define XB_SPIN(cond, bar) do { unsigned _sp = 0; while (cond) { __builtin_amdgcn_s_sleep(1); \
    if ((++_sp & 255u) == 0u) { if (xb_ld(&(bar)[XB_TMO])) break; if (_sp > XB_SPIN_CAP) { atomicAdd(&(bar)[XB_TMO], 1u); break; } } } } while (0)

struct XcdBarrier {
    unsigned* bar; unsigned x;
    volatile LAS unsigned* st;
};

__device__ __forceinline__ XcdBarrier xcd_barrier_post(unsigned* bar, volatile LAS unsigned* st) {
    XcdBarrier b; b.bar = bar; b.x = xb_xcc_id(); b.st = st;
    if (threadIdx.x == 0) (void)xb_add(&bar[XB_XCNT(b.x)], 1u);
    return b;
}
__device__ __forceinline__ void xcd_barrier_complete(unsigned* bar, unsigned x, unsigned& nloc, unsigned& nx) {
    const unsigned G = gridDim.x * gridDim.y * gridDim.z;
    unsigned sum, cnt, mine, sp = 0u;
    for (;;) {
        sum = 0u; cnt = 0u; mine = 0u;
#pragma unroll
        for (unsigned j = 0; j < 16; ++j) { const unsigned c = xb_ld(&bar[XB_XCNT(j)]); sum += c; cnt += (c > 0u) ? 1u : 0u; mine = (j == x) ? c : mine; }
        if (sum == G) break;
        __builtin_amdgcn_s_sleep(1);
        if ((++sp & 255u) == 0u) { if (xb_ld(&bar[XB_TMO])) break; if (sp > XB_SPIN_CAP) { atomicAdd(&bar[XB_TMO], 1u); break; } }
    }
    nloc = mine > 0u ? mine : 1u; nx = cnt > 0u ? cnt : 1u;
}

__device__ __forceinline__ void xcd_barrier(const XcdBarrier& b) {
    asm volatile("s_waitcnt vmcnt(0)" ::: "memory");
    __syncthreads();
    if (threadIdx.x == 0) {
        unsigned* bar = b.bar;
        __builtin_amdgcn_s_waitcnt(0);
        unsigned nloc = b.st[0], nx = b.st[1];
        if (nloc == 0u) { xcd_barrier_complete(bar, b.x, nloc, nx); b.st[0] = nloc; b.st[1] = nx; }
        const unsigned old = xb_add(&bar[XB_XSUB(b.x)], 1u);
        const unsigned gen = old / nloc;
        if (old + 1u == (gen + 1u) * nloc) {
            __builtin_amdgcn_fence(__ATOMIC_RELEASE, "agent");
            asm volatile("s_waitcnt vmcnt(0)" ::: "memory");
            const unsigned og = xb_add(&bar[XB_TOP], 1u);
            const unsigned tg = og / nx;
            if (og + 1u == (tg + 1u) * nx) xb_add(&bar[XB_TOPGEN], 1u);
            else XB_SPIN(xb_ld(&bar[XB_TOPGEN]) == tg, bar);
            __builtin_amdgcn_fence(__ATOMIC_ACQUIRE, "agent");
            xb_add(&bar[XB_XGEN(b.x)], 1u);
            asm volatile("s_waitcnt vmcnt(0)" ::: "memory");
        } else {
            XB_SPIN(xb_ld(&bar[XB_XGEN(b.x)]) == gen, bar);
            __builtin_amdgcn_fence(__ATOMIC_ACQUIRE, "agent");
            asm volatile("s_waitcnt vmcnt(0)" ::: "memory");
        }
    }
    __syncthreads();
}

constexpr int NPHASE = 2 + 5 * DEPTH;
__global__ void __launch_bounds__(512, 2) mk_fwd(Params p, int ph_lo, int ph_hi, int coop) {
  int rep = 0;
  volatile LAS unsigned* bst = (volatile LAS unsigned*)(LDSP + 2 * HALF_B + 16);
  if (otid() < 2) bst[otid()] = 0u;
  __syncthreads();
  XcdBarrier xbar = xcd_barrier_post(p.barw, bst);
  for (int ph = ph_lo; ph < ph_hi; ++ph) {
    if (ph == 0) {
      prep_phase();
      if (REP_PREP) { __syncthreads(); prep_phase(); }
    } else if (ph == NPHASE - 1) {
      final_rms_phase(p.xn, p.final_g, p.out);
    } else {
      const int l = (ph - 1) / 5, s = (ph - 1) % 5;
      if (s == 0) gemm_in_phase(l);
      else if (s == 1) mixer_phase(l, rep);
      else if (s == 2) gemm_out_phase(l, (REP_S == 2 && rep == 0) ? 0.f : 1.f);
      else if (s == 3) gemm_up_phase(l);
      else gemm_down_phase(l, (REP_S == 4 && rep == 0) ? 0.f : 1.f);
    }
    if (coop && ph + 1 < ph_hi) { if (ph_lo < 0) cg::this_grid().sync(); else xcd_barrier(xbar); }
    if (coop && ph == 1) for (int i = 0; i < EXTRA_SYNCS; ++i) xcd_barrier(xbar);
    if (REP_S >= 0 && rep == 0 && ph >= 1 && ph < NPHASE - 1 && ((ph - 1) % 5) == REP_S) { rep = 1; --ph; } else rep = 0;
  }
}

extern "C" void kernel_launch(void* const* d_in, const int* in_sizes, int n_in, void* d_out, int out_size, void* d_ws, size_t ws_size, hipStream_t stream) {
  Params p{};
  const float** pf = (const float**)&p;
  for (int i = 0; i < 25; ++i) pf[i] = (const float*)d_in[i];
  p.out = (float*)d_out;
  unsigned char* w = (unsigned char*)d_ws;
  size_t off = 0;
  auto take = [&](size_t bytes) { unsigned char* r = w + off; off += (bytes + 255) & ~(size_t)255; return r; };
  p.WallT = (bf16_t*)take((size_t)DEPTH * WALL_N * DM * 2);
  p.WoutT = (bf16_t*)take((size_t)DEPTH * DM * DM * 2);
  p.WupT = (bf16_t*)take((size_t)DEPTH * DFF * DM * 2);
  p.WdownT = (bf16_t*)take((size_t)DEPTH * DFF * DM * 2);
  p.pwT = (bf16_t*)take((size_t)DEPTH * 65536 * 2);
  p.sguW = (bf16_t*)take((size_t)DEPTH * 4 * 16384 * 2);
  p.lam = (float*)take(256);
  unsigned char* ctl = take(16384);
  p.ctr = (int*)ctl;
  p.barw = (unsigned*)(ctl + 256);
  p.M1 = (bf16_t*)take(128 * 128 * 2);
  p.M3 = (bf16_t*)take(64 * 128 * 2);
  p.TW = (float*)take(4096 * 2 * 4);
  p.part = (float*)take((size_t)NTOK * 16 * 4);
  p.xn = (bf16_t*)take((size_t)NTOK * DM * 2);
  unsigned char* region = take((size_t)NTOK * DFF * 2);
  p.hid = (bf16_t*)region;
  p.h = (bf16_t*)region;
  p.Vt = (bf16_t*)(region + (size_t)NTOK * HC * 2);
  p.PQt = (bf16_t*)(region + (size_t)NTOK * HC * 2 + (size_t)NTOK * 256 * 2);
  p.y = (bf16_t*)(region + (size_t)NTOK * HC * 2 + (size_t)NTOK * 256 * 2 + (size_t)BATCH * 256 * 8192 * 2);
  if (off > ws_size) { fprintf(stderr, "workspace too small: need %zu have %zu\n", off, ws_size); return; }

  static int grid_blocks = 0;
  if (!grid_blocks) {
    int dev = 0, cus = 0, per_cu = 0;
    hipGetDevice(&dev);
    hipDeviceGetAttribute(&cus, hipDeviceAttributeMultiprocessorCount, dev);
    hipOccupancyMaxActiveBlocksPerMultiprocessor(&per_cu, mk_fwd, 512, 0);
    if (per_cu < 1) per_cu = 1;
    grid_blocks = cus * per_cu;
  }
  hipMemsetAsync(ctl, 0, 16384, stream);
#if MK_ONE_LAUNCH
  int lo = 0, hi = NPHASE, coop = 1;
  void* args[] = {&p, &lo, &hi, &coop};
  hipError_t e = hipLaunchCooperativeKernel((void*)mk_fwd, dim3(grid_blocks), dim3(512), args, 0, stream);
  if (e != hipSuccess) fprintf(stderr, "cooperative launch failed: %s (grid %d)\n", hipGetErrorString(e), grid_blocks);
#else
  for (int ph = 0; ph < NPHASE; ++ph) mk_fwd<<<grid_blocks, 512, 0, stream>>>(p, ph, ph + 1, 0);
#endif
}
```
